# Optimizing an MI355X kernel written in HIP

```python
import math
import jax, jax.numpy as jnp
from jax import lax
import numpy as np

D_MODEL = 2048
BATCH = 4
SEQ = 2048
DEPTH = 2

GRID_W = 64
CTX_LEN = 256
HEAD_DIM = 128
N_MIX_HEADS = D_MODEL // HEAD_DIM
NA_HEADS = N_MIX_HEADS // 2
NA_WIN_R = 8
NA_WIN_C = 16
NA_WIDTH = NA_HEADS * HEAD_DIM
HG_HEADS = N_MIX_HEADS // 2
HG_DK = 128
HG_DV = HEAD_DIM
HG_KWIDTH = HG_HEADS * HG_DK
HG_VWIDTH = HG_HEADS * HG_DV
HG_CHUNK = 16
EVEN_IN = 3 * NA_WIDTH + 3 * HG_KWIDTH + 2 * HG_VWIDTH
EVEN_OUT = NA_WIDTH + HG_VWIDTH
DIFF_HEADS = D_MODEL // (2 * HEAD_DIM)
DIFF_DK = HEAD_DIM
DIFF_DV = 2 * HEAD_DIM
DIFF_QK_WIDTH = DIFF_HEADS * 2 * DIFF_DK
DIFF_V_WIDTH = DIFF_HEADS * DIFF_DV
ODD_IN = 2 * DIFF_QK_WIDTH + DIFF_V_WIDTH
ODD_OUT = DIFF_V_WIDTH
D_FF = 4 * D_MODEL
N_MOD = 6
ROPE_THETA = 10000.0
Q_BLOCK = 128
EPS = 1e-6
N_EVEN = (DEPTH + 1) // 2
N_ODD = DEPTH // 2

kernel_name = "hybrid_natten_hgrn2_diffattn_dit"


def rms_norm(x, g):
    xf = x.astype(jnp.float32)
    y = xf * lax.rsqrt(jnp.mean(xf * xf, axis=-1, keepdims=True) + EPS)
    return (y * g).astype(x.dtype)


def modulate(h, mod, i):
    return h * (1.0 + mod[:, i + 1, None, :]) + mod[:, i, None, :]


def split_cols(p, sizes):
    out, start = [], 0
    for s in sizes:
        out.append(p[..., start:start + s])
        start += s
    return out


def merge_heads(o):
    b, h, n, d = o.shape
    return o.transpose(0, 2, 1, 3).reshape(b, n, h * d)


def flip_t(t):
    return jnp.flip(t, axis=2)


def sq_relu_mlp(h, w1, w2):
    return jnp.square(jax.nn.relu(h @ w1)) @ w2


def axial_rope_tables(n_tokens):
    t = jnp.arange(n_tokens)
    row = (t // GRID_W).astype(jnp.float32)
    col = (t % GRID_W).astype(jnp.float32)
    n_freq = DIFF_DK // 4
    inv = ROPE_THETA ** (-jnp.arange(n_freq, dtype=jnp.float32) / n_freq)
    ang = jnp.concatenate([row[:, None] * inv, col[:, None] * inv], axis=-1)
    return jnp.cos(ang), jnp.sin(ang)


def apply_axial_rope(x, cos, sin):
    half = x.shape[-1] // 2
    x1, x2 = x[..., :half], x[..., half:]
    return jnp.concatenate([x1 * cos - x2 * sin, x1 * sin + x2 * cos], axis=-1).astype(x.dtype)


def dense_attention(q, k, v):
    s = jnp.einsum('bhqd,bhkd->bhqk', q, k).astype(jnp.float32) * q.shape[-1] ** -0.5
    return jnp.einsum('bhqk,bhkd->bhqd', jax.nn.softmax(s, axis=-1).astype(v.dtype), v)


def neighbourhood_attention(q, k, v, kc, vc, rpb):
    b, H, S, dh = q.shape
    rows = S // GRID_W
    wr = min(NA_WIN_R, rows)
    r = jnp.arange(rows)
    r0 = jnp.clip(r - wr // 2, 0, rows - wr)
    key_rows = r0[:, None] + jnp.arange(wr)[None, :]
    col = jnp.arange(GRID_W)
    c0 = jnp.clip(col - NA_WIN_C // 2, 0, GRID_W - NA_WIN_C)
    in_win = (col[None, :] >= c0[:, None]) & (col[None, :] < c0[:, None] + NA_WIN_C)
    dr = key_rows - r[:, None] + (NA_WIN_R - 1)
    dc = jnp.clip(col[None, :] - col[:, None] + (NA_WIN_C - 1), 0, 2 * NA_WIN_C - 2)
    bias = rpb[:, dr[:, None, :, None], dc[None, :, None, :]].astype(jnp.float32)
    bias = jnp.where(in_win[None, None, :, None, :], bias, -jnp.inf).reshape(H, rows, GRID_W, wr * GRID_W)
    qg = q.reshape(b, H, rows, GRID_W, dh)
    kb = k.reshape(b, H, rows, GRID_W, dh)[:, :, key_rows].reshape(b, H, rows, wr * GRID_W, dh)
    vb = v.reshape(b, H, rows, GRID_W, dh)[:, :, key_rows].reshape(b, H, rows, wr * GRID_W, dh)
    scale = dh ** -0.5
    s_lat = jnp.einsum('bhrqd,bhrkd->bhrqk', qg, kb).astype(jnp.float32) * scale + bias[None]
    s_ctx = jnp.einsum('bhrqd,bhld->bhrql', qg, kc).astype(jnp.float32) * scale
    p = jax.nn.softmax(jnp.concatenate([s_lat, s_ctx], axis=-1), axis=-1).astype(v.dtype)
    nk = wr * GRID_W
    o = (jnp.einsum('bhrqk,bhrkd->bhrqd', p[..., :nk], vb)
         + jnp.einsum('bhrql,bhld->bhrqd', p[..., nk:], vc))
    return o.reshape(b, H, S, dh)


def hgrn2_forget(z, lb):
    lb = lb.reshape(HG_HEADS, 1, HG_DK)
    f = lb + (1.0 - lb) * jax.nn.sigmoid(z.astype(jnp.float32))
    return jnp.log(f), 1.0 - f


def hgrn2_chunk_scan(q, k, log_f, v, s0, with_output):
    b, H, T, dk = q.shape
    dv = v.shape[-1]
    C = HG_CHUNK
    n = T // C
    f32 = jnp.float32
    qc = q.astype(f32).reshape(b, H, n, C, dk)
    kc = k.astype(f32).reshape(b, H, n, C, dk)
    vc = v.astype(f32).reshape(b, H, n, C, dv)
    cum = jnp.cumsum(log_f.astype(f32).reshape(b, H, n, C, dk), axis=3)
    last = cum[..., -1:, :]
    u = jnp.einsum('bhnsk,bhnsv->bhnkv', kc * jnp.exp(last - cum), vc)
    g = jnp.exp(last[..., 0, :])

    def step(S, inp):
        g_n, u_n = inp
        return g_n[..., None] * S + u_n, (S if with_output else None)

    s_final, s_prev = lax.scan(step, s0, (jnp.moveaxis(g, 2, 0), jnp.moveaxis(u, 2, 0)))
    if not with_output:
        return None, s_final
    s_prev = jnp.moveaxis(s_prev, 0, 2)
    tri = jnp.tril(jnp.ones((C, C), dtype=bool))[:, :, None]
    decay = jnp.exp(jnp.where(tri, cum[..., :, None, :] - cum[..., None, :, :], -jnp.inf))
    att = jnp.einsum('bhntk,bhnsk,bhntsk->bhnts', qc, kc, decay)
    o = (jnp.einsum('bhnts,bhnsv->bhntv', att, vc)
         + jnp.einsum('bhntk,bhnkv->bhntv', qc * jnp.exp(cum), s_prev))
    return o.reshape(b, H, T, dv).astype(v.dtype), s_final


def even_mixer(h, hc, w_in, w_out, q_g, k_g, rpb, lb_fwd, lb_bwd, gn_g, need_ctx):
    def project(t):
        p = t @ w_in
        bsz, n, _ = p.shape
        qa, ka, va, qb, zf, zb, ib, gb = split_cols(
            p, (NA_WIDTH,) * 3 + (HG_KWIDTH,) * 3 + (HG_VWIDTH,) * 2)
        hd = lambda z, H: z.reshape(bsz, n, H, -1).transpose(0, 2, 1, 3)
        return (rms_norm(hd(qa, NA_HEADS), q_g), rms_norm(hd(ka, NA_HEADS), k_g), hd(va, NA_HEADS),
                jax.nn.silu(hd(qb, HG_HEADS)), hd(zf, HG_HEADS), hd(zb, HG_HEADS),
                hd(ib, HG_HEADS), hd(gb, HG_HEADS))

    qa, ka, va, qb, zf, zb, ib, gb = project(h)
    qac, kac, vac, qbc, zfc, zbc, ibc, gbc = project(hc)
    o_na = neighbourhood_attention(qa, ka, va, kac, vac, rpb)
    logf_f, k_f = hgrn2_forget(zf, lb_fwd)
    logf_b, k_b = hgrn2_forget(zb, lb_bwd)
    logfc_f, kc_f = hgrn2_forget(zfc, lb_fwd)
    logfc_b, kc_b = hgrn2_forget(zbc, lb_bwd)
    s0 = jnp.zeros((hc.shape[0], HG_HEADS, HG_DK, HG_DV), jnp.float32)
    oc_f, sc_f = hgrn2_chunk_scan(qbc, kc_f, logfc_f, ibc, s0, need_ctx)
    oc_b, sc_b = hgrn2_chunk_scan(flip_t(qbc), flip_t(kc_b), flip_t(logfc_b), flip_t(ibc), s0, need_ctx)
    o_f, _ = hgrn2_chunk_scan(qb, k_f, logf_f, ib, sc_f, True)
    o_b, _ = hgrn2_chunk_scan(flip_t(qb), flip_t(k_b), flip_t(logf_b), flip_t(ib), sc_b, True)
    o_hg = rms_norm(o_f + flip_t(o_b), gn_g) * jax.nn.silu(gb)
    y = jnp.concatenate([merge_heads(o_na), merge_heads(o_hg)], axis=-1) @ w_out
    if not need_ctx:
        return y, None
    oc_na = dense_attention(qac, kac, vac)
    oc_hg = rms_norm(oc_f + flip_t(oc_b), gn_g) * jax.nn.silu(gbc)
    yc = jnp.concatenate([merge_heads(oc_na), merge_heads(oc_hg)], axis=-1) @ w_out
    return y, yc


def diff_weights(s, lam, dtype):
    p = jax.nn.softmax(s, axis=-1)
    return (p[:, :, 0] - lam * p[:, :, 1]).astype(dtype)


def diff_attention_latent(q, k, v, kc, vc, lam):
    b, H, _, S, dk = q.shape
    dv = v.shape[-1]
    nb = S // Q_BLOCK
    qb = jnp.moveaxis(q.reshape(b, H, 2, nb, Q_BLOCK, dk), 3, 0)
    scale = dk ** -0.5

    def one_block(qblk):
        s = jnp.concatenate([jnp.einsum('bhiqd,bhikd->bhiqk', qblk, k),
                             jnp.einsum('bhiqd,bhikd->bhiqk', qblk, kc)], axis=-1).astype(jnp.float32) * scale
        a = diff_weights(s, lam, v.dtype)
        return (jnp.einsum('bhqk,bhkd->bhqd', a[..., :S], v)
                + jnp.einsum('bhqk,bhkd->bhqd', a[..., S:], vc))

    o = lax.map(one_block, qb)
    return jnp.moveaxis(o, 0, 2).reshape(b, H, S, dv)


def odd_mixer(h, hc, w_in, w_out, q_g, k_g, lam_p, subln_g, layer_idx, cos, sin, need_ctx):
    def project(t):
        p = t @ w_in
        bsz, n, _ = p.shape
        q, k, v = split_cols(p, (DIFF_QK_WIDTH, DIFF_QK_WIDTH, DIFF_V_WIDTH))
        qk = lambda z, g: rms_norm(z.reshape(bsz, n, DIFF_HEADS, 2, DIFF_DK), g).transpose(0, 2, 3, 1, 4)
        return qk(q, q_g), qk(k, k_g), v.reshape(bsz, n, DIFF_HEADS, DIFF_DV).transpose(0, 2, 1, 3)

    q, k, v = project(h)
    q, k = apply_axial_rope(q, cos, sin), apply_axial_rope(k, cos, sin)
    qc, kc, vc = project(hc)
    lam_init = 0.8 - 0.6 * math.exp(-0.3 * layer_idx)
    lp = lam_p.astype(jnp.float32)
    lam = jnp.exp(jnp.sum(lp[0] * lp[1])) - jnp.exp(jnp.sum(lp[2] * lp[3])) + lam_init

    def finish(o):
        return merge_heads(rms_norm(o, subln_g) * (1.0 - lam_init)) @ w_out

    y = finish(diff_attention_latent(q, k, v, kc, vc, lam))
    if not need_ctx:
        return y, None
    s_c = jnp.einsum('bhiqd,bhikd->bhiqk', qc, kc).astype(jnp.float32) * DIFF_DK ** -0.5
    yc = finish(jnp.einsum('bhqk,bhkd->bhqd', diff_weights(s_c, lam, vc.dtype), vc))
    return y, yc


def setup_inputs(seed: int = 0) -> dict:
    key = jax.random.key(seed)
    ks = jax.random.split(key, 24)
    nrm = lambda k, shape, s: s * jax.random.normal(k, shape, jnp.float32)
    gain = lambda k, shape: 1.0 + 0.02 * jax.random.normal(k, shape, jnp.float32)
    return {
        "x": nrm(ks[0], (BATCH, SEQ, D_MODEL), 1.0),
        "c": nrm(ks[1], (BATCH, D_MODEL), 1.0),
        "ctx": nrm(ks[2], (BATCH, CTX_LEN, D_MODEL), 1.0),
        "c_ctx": nrm(ks[3], (D_MODEL,), 1.0),
        "ada_w": nrm(ks[4], (DEPTH, D_MODEL, N_MOD * D_MODEL), 0.5 * D_MODEL ** -0.5),
        "ada_b": nrm(ks[5], (DEPTH, N_MOD * D_MODEL), 0.01),
        "norm_mix_g": gain(ks[6], (DEPTH, D_MODEL)),
        "norm_mlp_g": gain(ks[7], (DEPTH, D_MODEL)),
        "mlp_w1": nrm(ks[8], (DEPTH, D_MODEL, D_FF), D_MODEL ** -0.5),
        "mlp_w2": nrm(ks[9], (DEPTH, D_FF, D_MODEL), D_FF ** -0.5),
        "ev_w_in": nrm(ks[10], (N_EVEN, D_MODEL, EVEN_IN), D_MODEL ** -0.5),
        "ev_w_out": nrm(ks[11], (N_EVEN, EVEN_OUT, D_MODEL), EVEN_OUT ** -0.5),
        "na_q_g": gain(ks[12], (N_EVEN, HEAD_DIM)),
        "na_k_g": gain(ks[13], (N_EVEN, HEAD_DIM)),
        "na_rpb": nrm(ks[14], (N_EVEN, NA_HEADS, 2 * NA_WIN_R - 1, 2 * NA_WIN_C - 1), 0.1),
        "hg_lb_logits": nrm(ks[15], (2, DEPTH + 1, HG_KWIDTH), 0.5),
        "hg_gnorm_g": gain(ks[16], (N_EVEN, HG_DV)),
        "od_w_in": nrm(ks[17], (N_ODD, D_MODEL, ODD_IN), D_MODEL ** -0.5),
        "od_w_out": nrm(ks[18], (N_ODD, ODD_OUT, D_MODEL), ODD_OUT ** -0.5),
        "df_q_g": gain(ks[19], (N_ODD, DIFF_DK)),
        "df_k_g": gain(ks[20], (N_ODD, DIFF_DK)),
        "df_lambda": nrm(ks[21], (N_ODD, 4, DIFF_DK), 0.1),
        "df_subln_g": gain(ks[22], (N_ODD, DIFF_DV)),
    }


def reference(x, c, ctx, c_ctx, ada_w, ada_b, norm_mix_g, norm_mlp_g, mlp_w1, mlp_w2,
              ev_w_in, ev_w_out, na_q_g, na_k_g, na_rpb, hg_lb_logits, hg_gnorm_g,
              od_w_in, od_w_out, df_q_g, df_k_g, df_lambda, df_subln_g):
    b, n_lat, _ = x.shape
    cos, sin = axial_rope_tables(n_lat)
    lb_all = jnp.cumsum(jax.nn.softmax(hg_lb_logits.astype(jnp.float32), axis=1), axis=1)
    silu_c = jax.nn.silu(c)
    silu_cc = jax.nn.silu(c_ctx)[None]
    for l in range(DEPTH):
        need_ctx = l < DEPTH - 1
        mod = (silu_c @ ada_w[l] + ada_b[l]).reshape(b, N_MOD, D_MODEL)
        modc = (silu_cc @ ada_w[l] + ada_b[l]).reshape(1, N_MOD, D_MODEL)
        h = modulate(rms_norm(x, norm_mix_g[l]), mod, 0)
        hc = modulate(rms_norm(ctx, norm_mix_g[l]), modc, 0)
        if l % 2 == 0:
            e = l // 2
            y, yc = even_mixer(h, hc, ev_w_in[e], ev_w_out[e], na_q_g[e], na_k_g[e], na_rpb[e],
                               lb_all[0, l], lb_all[1, l], hg_gnorm_g[e], need_ctx)
        else:
            o = l // 2
            y, yc = odd_mixer(h, hc, od_w_in[o], od_w_out[o], df_q_g[o], df_k_g[o], df_lambda[o],
                              df_subln_g[o], l, cos, sin, need_ctx)
        x = x + mod[:, 2, None, :] * y
        h2 = modulate(rms_norm(x, norm_mlp_g[l]), mod, 3)
        x = x + mod[:, 5, None, :] * sq_relu_mlp(h2, mlp_w1[l], mlp_w2[l])
        if need_ctx:
            ctx = ctx + modc[:, 2, None, :] * yc
            hc2 = modulate(rms_norm(ctx, norm_mlp_g[l]), modc, 3)
            ctx = ctx + modc[:, 5, None, :] * sq_relu_mlp(hc2, mlp_w1[l], mlp_w2[l])
    return x
```

```cpp
#include <hip/hip_runtime.h>
#include <hip/hip_cooperative_groups.h>
#include <cstdio>
#include <cstdint>
#include <cmath>
namespace cg = cooperative_groups;

typedef unsigned short bf16_t;
typedef short bf16x8 __attribute__((ext_vector_type(8)));
typedef short s16x4 __attribute__((ext_vector_type(4)));
typedef float f32x2 __attribute__((ext_vector_type(2)));
typedef float f32x4 __attribute__((ext_vector_type(4)));
typedef float f32x16 __attribute__((ext_vector_type(16)));
typedef unsigned u32x2 __attribute__((ext_vector_type(2)));
typedef unsigned u32x4 __attribute__((ext_vector_type(4)));

#ifndef EMU
#define LAS __attribute__((address_space(3)))
#define SMEM_DECL extern __shared__ __attribute__((aligned(16))) unsigned char smem_raw[]
#define BAR() __builtin_amdgcn_s_barrier()
#define WAIT_V(n) asm volatile("s_waitcnt vmcnt(" #n ")" ::: "memory")
#define WAIT_L(n) asm volatile("s_waitcnt lgkmcnt(" #n ")" ::: "memory")
#define CFENCE() asm volatile("" ::: "memory")
#define SCHED() __builtin_amdgcn_sched_barrier(0)
#define SETPRIO(n) __builtin_amdgcn_s_setprio(n)
#define GLDS16(g, l) __builtin_amdgcn_global_load_lds((const unsigned*)(g), (LAS unsigned*)(l), 16, 0, 0)
#define RFL(x) __builtin_amdgcn_readfirstlane(x)
#define OPAQUE(x) asm volatile("" : "+v"(x))
#define WSYNC() __builtin_amdgcn_wave_barrier()
typedef unsigned ldsaddr_t;
#define LDSADDR(p) ((ldsaddr_t)(uintptr_t)(p))
#define AT_LD(p) __hip_atomic_load((p), __ATOMIC_RELAXED, __HIP_MEMORY_SCOPE_AGENT)
#define AT_ADD(p, v) __hip_atomic_fetch_add((p), (v), __ATOMIC_RELAXED, __HIP_MEMORY_SCOPE_AGENT)
#define FENCE_REL() __builtin_amdgcn_fence(__ATOMIC_RELEASE, "agent")
#define FENCE_ACQ() __builtin_amdgcn_fence(__ATOMIC_ACQUIRE, "agent")
#define SLEEP1() __builtin_amdgcn_s_sleep(1)
#define ST_WT16(p, v) asm volatile("global_store_dwordx4 %0, %1, off sc1\n\ts_nop 1" :: "v"(p), "v"(v) : "memory")
#define XCC_ID() ((unsigned)__builtin_amdgcn_s_getreg((3 << 11) | 20) & 0xFu)
#define LANE_ID() ((int)(__builtin_amdgcn_mbcnt_hi(~0u, __builtin_amdgcn_mbcnt_lo(~0u, 0u)) & 63u))
#define SHFL_XOR_LN(v, m, ln) __builtin_bit_cast(float, __builtin_amdgcn_ds_bpermute(((ln) ^ (m)) << 2, __builtin_bit_cast(int, (v))))
__device__ __forceinline__ f32x4 mfma16(bf16x8 a, bf16x8 b, f32x4 c) { return __builtin_amdgcn_mfma_f32_16x16x32_bf16(a, b, c, 0, 0, 0); }
__device__ __forceinline__ f32x16 mfma32(bf16x8 a, bf16x8 b, f32x16 c) { return __builtin_amdgcn_mfma_f32_32x32x16_bf16(a, b, c, 0, 0, 0); }
typedef __bf16 bf16x2_t __attribute__((ext_vector_type(2)));
__device__ __forceinline__ unsigned cvtpk(float lo, float hi) { f32x2 v = {lo, hi}; bf16x2_t b = __builtin_convertvector(v, bf16x2_t); return __builtin_bit_cast(unsigned, b); }
template <int OFF> __device__ __forceinline__ s16x4 tr_read(ldsaddr_t vb) { s16x4 r; asm volatile("ds_read_b64_tr_b16 %0, %1 offset:%2" : "=&v"(r) : "v"(vb), "i"(OFF) : "memory"); return r; }
typedef short v4i16_t __attribute__((ext_vector_type(4)));
__device__ __forceinline__ s16x4 tr_read_p(const LAS void* p) { return __builtin_bit_cast(s16x4, __builtin_amdgcn_ds_read_tr16_b64_v4i16((LAS v4i16_t*)p)); }
__device__ __forceinline__ void plswap(unsigned a, unsigned b, unsigned& r0, unsigned& r1) { auto rr = __builtin_amdgcn_permlane32_swap(a, b, false, false); r0 = rr[0]; r1 = rr[1]; }
__device__ __forceinline__ float exp2_fast(float x) { return __builtin_amdgcn_exp2f(x); }
__device__ __forceinline__ float rcp_fast(float x) { return __builtin_amdgcn_rcpf(x); }
__device__ __forceinline__ float rsq_fast(float x) { return __builtin_amdgcn_rsqf(x); }
#else
#define LAS
#define SMEM_DECL unsigned char* smem_raw = emu::cur->blk->smem
#define BAR() __syncthreads()
#define WAIT_V(n) do { } while (0)
#define WAIT_L(n) do { } while (0)
#define CFENCE() do { } while (0)
#define SCHED() do { } while (0)
#define SETPRIO(n) do { } while (0)
#define GLDS16(g, l) memcpy((unsigned char*)(l) + 16 * emu::cur->lane, (const void*)(g), 16)
#define RFL(x) (x)
#define OPAQUE(x) do { } while (0)
#define WSYNC() do { int z_ = 0; (void)emu::collective(&z_, 4, 20, [](unsigned char (*)[160]) {}); } while (0)
typedef uintptr_t ldsaddr_t;
#define LDSADDR(p) ((ldsaddr_t)(uintptr_t)(p))
#define AT_LD(p) (*(volatile unsigned*)(p))
static inline unsigned emu_at_add(unsigned* p, unsigned v) { unsigned o = *p; *p = o + v; return o; }
#define AT_ADD(p, v) emu_at_add((p), (v))
#define FENCE_REL() do { } while (0)
#define FENCE_ACQ() do { } while (0)
#define SLEEP1() emu::poll_yield()
#define ST_WT16(p, v) (*(f32x4*)(p) = (v))
#define XCC_ID() ((unsigned)(emu::cur->blk->bid.x & 7u))
#define LANE_ID() (emu::cur->lane)
#define SHFL_XOR_LN(v, m, ln) __shfl_xor((v), (m))
static inline float bf2f_(short s) { unsigned u = ((unsigned)(unsigned short)s) << 16; float f; memcpy(&f, &u, 4); return f; }
static inline unsigned f2bf_(float f) { unsigned u; memcpy(&u, &f, 4); if ((u & 0x7fffffffu) > 0x7f800000u) return 0x7fc0u; return (u + 0x7fffu + ((u >> 16) & 1u)) >> 16; }
static inline f32x4 mfma16(bf16x8 a, bf16x8 b, f32x4 c) {
  struct In { bf16x8 a, b; f32x4 c; } in{a, b, c};
  int p = emu::collective(&in, sizeof(in), 10, [](unsigned char (*buf)[160]) {
    static float A[16][32], B[32][16];
    for (int l = 0; l < 64; ++l) { In x; memcpy(&x, buf[l], sizeof(x)); for (int j = 0; j < 8; ++j) { A[l & 15][8 * (l >> 4) + j] = bf2f_(x.a[j]); B[8 * (l >> 4) + j][l & 15] = bf2f_(x.b[j]); } }
    for (int l = 0; l < 64; ++l) { In x; memcpy(&x, buf[l], sizeof(x)); f32x4 d;
      for (int r = 0; r < 4; ++r) { const int row = 4 * (l >> 4) + r, col = l & 15; float acc = x.c[r]; for (int k = 0; k < 32; ++k) acc += A[row][k] * B[k][col]; d[r] = acc; }
      memcpy(buf[l] + 64, &d, 16); } });
  f32x4 d; memcpy(&d, emu::cur->wave->xbuf[p][emu::cur->lane] + 64, 16); return d;
}
static inline f32x16 mfma32(bf16x8 a, bf16x8 b, f32x16 c) {
  struct In { bf16x8 a, b; f32x16 c; } in{a, b, c};
  int p = emu::collective(&in, sizeof(in), 11, [](unsigned char (*buf)[160]) {
    static float A[32][16], B[16][32];
    for (int l = 0; l < 64; ++l) { In x; memcpy(&x, buf[l], sizeof(x)); for (int j = 0; j < 8; ++j) { A[l & 31][8 * (l >> 5) + j] = bf2f_(x.a[j]); B[8 * (l >> 5) + j][l & 31] = bf2f_(x.b[j]); } }
    for (int l = 0; l < 64; ++l) { In x; memcpy(&x, buf[l], sizeof(x)); f32x16 d;
      for (int r = 0; r < 16; ++r) { const int row = (r & 3) + 8 * (r >> 2) + 4 * (l >> 5), col = l & 31; float acc = x.c[r]; for (int k = 0; k < 16; ++k) acc += A[row][k] * B[k][col]; d[r] = acc; }
      memcpy(buf[l] + 96, &d, 64); } });
  f32x16 d; memcpy(&d, emu::cur->wave->xbuf[p][emu::cur->lane] + 96, 64); return d;
}
static inline unsigned cvtpk(float lo, float hi) { return f2bf_(lo) | (f2bf_(hi) << 16); }
template <int OFF> static inline s16x4 tr_read(ldsaddr_t vb) {
  ldsaddr_t a = vb + OFF;
  if (a & 7) { fprintf(stderr, "emu: tr_read misaligned\n"); abort(); }
  int p = emu::collective(&a, sizeof(a), 12, [](unsigned char (*)[160]) {});
  const int lane = emu::cur->lane, g = lane >> 4, i = lane & 15; s16x4 r;
  for (int q = 0; q < 4; ++q) { ldsaddr_t h; memcpy(&h, emu::cur->wave->xbuf[p][16 * g + 4 * q + (i >> 2)], sizeof(h)); r[q] = *(const short*)(h + 2 * (i & 3)); }
  return r;
}
static inline s16x4 tr_read_p(const void* p) { return tr_read<0>((ldsaddr_t)(uintptr_t)p); }
static inline void plswap(unsigned a, unsigned b, unsigned& r0, unsigned& r1) {
  unsigned in[2] = {a, b};
  int p = emu::collective(in, 8, 13, [](unsigned char (*)[160]) {});
  const int lane = emu::cur->lane; unsigned o[2]; memcpy(o, emu::cur->wave->xbuf[p][lane ^ 32], 8);
  if (lane < 32) { r0 = a; r1 = o[0]; } else { r0 = o[1]; r1 = b; }
}
static inline float exp2_fast(float x) { return exp2f(x); }
static inline float rcp_fast(float x) { return 1.0f / x; }
static inline float rsq_fast(float x) { return 1.0f / sqrtf(x); }
#endif

#define DEVI __device__ __forceinline__
DEVI float silu_f(float x) { return x * rcp_fast(1.0f + __expf(-x)); }
DEVI float bflo(unsigned w) { return __builtin_bit_cast(float, w << 16); }
DEVI float bfhi(unsigned w) { return __builtin_bit_cast(float, w & 0xffff0000u); }
DEVI float bf1(bf16_t h) { return __builtin_bit_cast(float, ((unsigned)h) << 16); }
DEVI bf16_t f2bf1(float f) { return (bf16_t)(cvtpk(f, 0.f) & 0xffffu); }
DEVI float wave_sum(float v) {
#pragma unroll
  for (int o = 1; o < 64; o <<= 1) v += __shfl_xor(v, o);
  return v;
}

#ifndef CFG_D
#define CFG_D 2048
#endif
#ifndef CFG_B
#define CFG_B 4
#endif
#ifndef CFG_SEQ
#define CFG_SEQ 2048
#endif
constexpr int DM = CFG_D, NB = CFG_B, SEQ = CFG_SEQ, CTX = 256, GW = 64;
constexpr int NAH = DM / 256, HGH = DM / 256, DIFFH = DM / 256;
constexpr int NAW = DM / 2;
constexpr int EVEN_IN = 4 * DM, ODD_IN = 3 * DM, DFF = 4 * DM;
constexpr int TPB = CTX + SEQ;
constexpr int MTOK = NB * TPB, TILES_PB = TPB / 256, GROWS = SEQ / GW;
constexpr int CHUNK = 64, NCH = TPB / CHUNK, NCH_CTX = CTX / CHUNK;
constexpr float EPS = 1e-6f;
constexpr float LAM_INIT = 0.35550906759f;
constexpr int C_QA = 0, C_KA = NAW, C_VA = 2 * NAW, C_QB = 3 * NAW, C_ZF = 4 * NAW, C_ZB = 5 * NAW, C_IB = 6 * NAW, C_GB = 7 * NAW;
static_assert(SEQ % 256 == 0 && DM % 256 == 0 && GROWS >= 8, "shape");

constexpr size_t al256(size_t x) { return (x + 255) / 256 * 256; }
constexpr size_t WS_CTL = 0;
constexpr size_t WS_CNT = 16384;
constexpr size_t WS_MODS = 16384 + 5 * 2048 * 4;
constexpr size_t WS_LB = WS_MODS + al256((size_t)2 * (NB + 1) * 6 * DM * 4);
constexpr size_t WS_ROPE = WS_LB + al256((size_t)2 * NAW * 4);
constexpr size_t WS_MISC = WS_ROPE + al256((size_t)2 * SEQ * 64 * 4);
constexpr size_t WS_WT_EVIN = WS_MISC + 4096;
constexpr size_t WS_WT_EVOUT = WS_WT_EVIN + (size_t)EVEN_IN * DM * 2;
constexpr size_t WS_WT_ODIN = WS_WT_EVOUT + (size_t)DM * DM * 2;
constexpr size_t WS_WT_ODOUT = WS_WT_ODIN + (size_t)ODD_IN * DM * 2;
constexpr size_t WS_WT_W1 = WS_WT_ODOUT + (size_t)DM * DM * 2;
constexpr size_t WS_WT_W2 = WS_WT_W1 + (size_t)2 * DFF * DM * 2;
constexpr size_t WS_XRES = WS_WT_W2 + (size_t)2 * DFF * DM * 2;
constexpr size_t WS_XN = WS_XRES + (size_t)MTOK * DM * 4;
constexpr size_t WS_P = WS_XN + (size_t)MTOK * DM * 2;
constexpr size_t WS_AO = WS_P + (size_t)MTOK * 4 * DM * 2;
constexpr size_t WS_HGS = WS_AO + (size_t)MTOK * DM * 2;
constexpr size_t WS_STASH = WS_HGS + (size_t)NB * HGH * 2 * NCH * 128 * 128 * 2;
constexpr size_t WS_END = WS_STASH + (size_t)512 * 512 * 128 * 4;

constexpr int LDS_RING = 131072;
constexpr int LDS_X = LDS_RING;
constexpr int LDS_BYTES = 163840;
constexpr int LDS_CTLW = LDS_BYTES;
constexpr int NTHR = 512, NWAVE = 8;

struct Params {
  const float* in[23];
  float* out;
  unsigned char* ws;
  int ph_lo, ph_hi;
};
enum { I_X = 0, I_C, I_CTX, I_CCTX, I_ADAW, I_ADAB, I_NMIXG, I_NMLPG, I_W1, I_W2, I_EVIN, I_EVOUT, I_NAQG, I_NAKG, I_RPB, I_LBL, I_GNG, I_ODIN, I_ODOUT, I_DFQG, I_DFKG, I_DFLAM, I_SUBG };

struct Ctx {
  LAS unsigned char* lds;
  int wave, G, bid, vcu;
};
#define CTX_IDS const int lane = LANE_ID(); const int tid = C.wave * 64 + lane; (void)tid

#define XB_TMO      128
#define XB_XCNT(j)  (256  + 64 * (j))
#define XB_XSUB(j)  (1280 + 64 * (j))
#define XB_XGEN(j)  (2304 + 64 * (j))
#define XB_TOP      3328
#define XB_TOPGEN   3392
#define XCD_BAR_WORDS 3456
#define XB_SPIN_CAP (1u << 22)
#define XB_SPIN(cond, bar) do { unsigned _sp = 0; while (cond) { SLEEP1(); \
    if ((++_sp & 255u) == 0u) { if (AT_LD(&(bar)[XB_TMO])) break; if (_sp > XB_SPIN_CAP) { AT_ADD(&(bar)[XB_TMO], 1u); break; } } } } while (0)
struct XcdBarrier { unsigned* bar; unsigned x; unsigned nloc, nx; int wave; };
DEVI XcdBarrier xcd_barrier_post(unsigned* bar, int wave) {
  XcdBarrier b; b.bar = bar; b.x = XCC_ID(); b.nloc = 0u; b.nx = 0u; b.wave = wave;
  if (wave == 0 && LANE_ID() == 0) (void)AT_ADD(&bar[XB_XCNT(b.x)], 1u);
  return b;
}
DEVI void xcd_barrier_complete(unsigned* bar, unsigned x, unsigned& nloc, unsigned& nx) {
  const unsigned G = gridDim.x;
  unsigned sum, cnt, mine, sp = 0u;
  for (;;) {
    sum = 0u; cnt = 0u; mine = 0u;
#pragma unroll
    for (unsigned j = 0; j < 16; ++j) { const unsigned c = AT_LD(&bar[XB_XCNT(j)]); sum += c; cnt += (c > 0u) ? 1u : 0u; mine = (j == x) ? c : mine; }
    if (sum == G) break;
    SLEEP1();
    if ((++sp & 255u) == 0u) { if (AT_LD(&bar[XB_TMO])) break; if (sp > XB_SPIN_CAP) { AT_ADD(&bar[XB_TMO], 1u); break; } }
  }
  nloc = mine > 0u ? mine : 1u; nx = cnt > 0u ? cnt : 1u;
}
DEVI void xcd_barrier(XcdBarrier& b) {
  WAIT_V(0);
  __syncthreads();
  unsigned nloc = b.nloc, nx = b.nx;
  if (b.wave == 0 && LANE_ID() == 0) {
    unsigned* bar = b.bar;
    if (nloc == 0u) xcd_barrier_complete(bar, b.x, nloc, nx);
    const unsigned old = AT_ADD(&bar[XB_XSUB(b.x)], 1u);
    const unsigned gen = old / nloc;
    if (old + 1u == (gen + 1u) * nloc) {
      FENCE_REL();
      WAIT_V(0);
      const unsigned og = AT_ADD(&bar[XB_TOP], 1u);
      const unsigned tg = og / nx;
      if (og + 1u == (tg + 1u) * nx) AT_ADD(&bar[XB_TOPGEN], 1u);
      else XB_SPIN(AT_LD(&bar[XB_TOPGEN]) == tg, bar);
      FENCE_ACQ();
      AT_ADD(&bar[XB_XGEN(b.x)], 1u);
      WAIT_V(0);
    } else {
      XB_SPIN(AT_LD(&bar[XB_XGEN(b.x)]) == gen, bar);
      FENCE_ACQ();
      WAIT_V(0);
    }
  }
  b.nloc = (unsigned)RFL((int)nloc); b.nx = (unsigned)RFL((int)nx);
  __syncthreads();
}

DEVI int pdim(int p) { const int c = p >> 3, e = p & 7; return e < 4 ? 4 * c + e : 64 + 4 * c + (e - 4); }
DEVI int ppos(int d) { return d < 64 ? 8 * (d >> 2) + (d & 3) : 8 * ((d - 64) >> 2) + 4 + (d & 3); }

struct TItem { const float* W; bf16_t* WT; int K, N, perm_cols, item; };
DEVI TItem t_resolve(const Params& P, int it) {
  unsigned char* ws = P.ws;
  constexpr int I_A = (DM / 64) * (EVEN_IN / 32), I_B = (DM / 64) * (DM / 32), I_C2 = (DM / 64) * (ODD_IN / 32), I_D = I_B, I_E = (DM / 64) * (DFF / 32), I_F = (DFF / 64) * (DM / 32);
  int r = it;
  if (r < I_A) return TItem{P.in[I_EVIN], (bf16_t*)(ws + WS_WT_EVIN), DM, EVEN_IN, 0, r}; r -= I_A;
  if (r < I_B) return TItem{P.in[I_EVOUT], (bf16_t*)(ws + WS_WT_EVOUT), DM, DM, 0, r}; r -= I_B;
  if (r < I_C2) return TItem{P.in[I_ODIN], (bf16_t*)(ws + WS_WT_ODIN), DM, ODD_IN, 2 * DM, r}; r -= I_C2;
  if (r < I_D) return TItem{P.in[I_ODOUT], (bf16_t*)(ws + WS_WT_ODOUT), DM, DM, 0, r}; r -= I_D;
  if (r < 2 * I_E) { const int l = r / I_E; return TItem{P.in[I_W1] + (size_t)l * DM * DFF, (bf16_t*)(ws + WS_WT_W1) + (size_t)l * DFF * DM, DM, DFF, 0, r % I_E}; } r -= 2 * I_E;
  { const int l = r / I_F; return TItem{P.in[I_W2] + (size_t)l * DFF * DM, (bf16_t*)(ws + WS_WT_W2) + (size_t)l * DM * DFF, DFF, DM, 0, r % I_F}; }
}
constexpr int T_NITEMS = (DM / 64) * (EVEN_IN / 32) + 2 * (DM / 64) * (DM / 32) + (DM / 64) * (ODD_IN / 32) + 2 * (DM / 64) * (DFF / 32) + 2 * (DFF / 64) * (DM / 32);
DEVI void t_load(const TItem& d, float (&tv)[32], int lane) {
  const int nblk = d.N / 32, kb = d.item / nblk, nb = d.item % nblk, k0 = 64 * kb, n0 = 32 * nb;
#pragma unroll
  for (int i = 0; i < 32; ++i) tv[i] = d.W[(size_t)(k0 + 2 * i + (lane >> 5)) * d.N + n0 + (lane & 31)];
}
DEVI void t_finish(const TItem& d, const float (&tv)[32], LAS float* scr, int lane) {
  const int nblk = d.N / 32, kb = d.item / nblk, nb = d.item % nblk, k0 = 64 * kb, n0 = 32 * nb;
#pragma unroll
  for (int i = 0; i < 32; ++i) scr[(2 * i + (lane >> 5)) * 33 + (lane & 31)] = tv[i];
  WAIT_L(0); CFENCE(); WSYNC();
  const int c = lane & 7;
#pragma unroll
  for (int j = 0; j < 4; ++j) { const int n = (lane >> 3) + 8 * j; const LAS float* s2 = scr + (8 * c) * 33 + n;
    u32x4 o; o.x = cvtpk(s2[0 * 33], s2[1 * 33]); o.y = cvtpk(s2[2 * 33], s2[3 * 33]); o.z = cvtpk(s2[4 * 33], s2[5 * 33]); o.w = cvtpk(s2[6 * 33], s2[7 * 33]);
    int nn = n0 + n; if (nn < d.perm_cols) nn = (nn & ~127) + ppos(nn & 127);
    *(u32x4*)(d.WT + (size_t)nn * d.K + k0 + 8 * c) = o; }
  WAIT_L(0); CFENCE(); WSYNC();
}

DEVI void phase_prep(const Params& P, const Ctx& C) {
  CTX_IDS;
  unsigned char* ws = P.ws;
  {
    LAS float* sv = (LAS float*)(C.lds);
    for (int i = tid; i < (NB + 1) * DM; i += NTHR) { const int bb = i / DM, k = i % DM; const float v = bb < NB ? P.in[I_C][bb * DM + k] : P.in[I_CCTX][k]; sv[i] = silu_f(v); }
    __syncthreads();
    LAS float* red = (LAS float*)(C.lds + (NB + 1) * DM * 4);
    constexpr int NCHK = 6 * DM / 32, KW = DM / NWAVE;
    const int nitems = 2 * NCHK, hw = lane >> 5, l31 = lane & 31;
    for (int it = C.bid; it < nitems; it += C.G) {
      const int l = it / NCHK, j0 = (it % NCHK) * 32;
      const float* w = P.in[I_ADAW] + (size_t)l * DM * 6 * DM + (size_t)(C.wave * KW + hw) * 6 * DM + j0 + l31;
      float acc[NB + 1];
#pragma unroll
      for (int bb = 0; bb <= NB; ++bb) acc[bb] = 0.f;
      for (int k = 0; k < KW; k += 64) {
        float wv[32];
#pragma unroll
        for (int u = 0; u < 32; ++u) wv[u] = w[(size_t)(k + 2 * u) * 6 * DM];
#pragma unroll
        for (int u = 0; u < 32; ++u)
#pragma unroll
          for (int bb = 0; bb <= NB; ++bb) acc[bb] += sv[bb * DM + C.wave * KW + k + 2 * u + hw] * wv[u];
      }
#pragma unroll
      for (int bb = 0; bb <= NB; ++bb) red[((C.wave * 2 + hw) * (NB + 1) + bb) * 32 + l31] = acc[bb];
      __syncthreads();
      if (tid < (NB + 1) * 32) { const int bb = tid / 32, ln = tid % 32; float s2 = 0.f;
#pragma unroll
        for (int w8 = 0; w8 < 2 * NWAVE; ++w8) s2 += red[(w8 * (NB + 1) + bb) * 32 + ln];
        ((float*)(ws + WS_MODS))[((size_t)l * (NB + 1) + bb) * 6 * DM + j0 + ln] = s2 + P.in[I_ADAB][(size_t)l * 6 * DM + j0 + ln]; }
      __syncthreads();
    }
  }
  {
    const int gt = C.bid * NTHR + tid, GT = C.G * NTHR;
    float* lb = (float*)(ws + WS_LB);
    for (int i = gt; i < 2 * NAW; i += GT) { const int d = i / NAW, ch = i % NAW; const float* lg = P.in[I_LBL] + (size_t)d * 3 * NAW + ch;
      const float a = lg[0], b = lg[NAW], c = lg[2 * NAW], m = fmaxf(a, fmaxf(b, c)); const float ea = expf(a - m), eb = expf(b - m), ec = expf(c - m); lb[i] = ea / (ea + eb + ec); }
    float* rc = (float*)(ws + WS_ROPE); float* rs = rc + (size_t)SEQ * 64;
    for (int i = gt; i < SEQ * 64; i += GT) { const int t = i / 64, f = i % 64; const float pos = (float)(f < 32 ? t / GW : t % GW);
      const float inv = powf(10000.0f, -(float)(f & 31) / 32.0f); const float ang = pos * inv; rc[i] = cosf(ang); rs[i] = sinf(ang); }
    float* misc = (float*)(ws + WS_MISC);
    if (gt < 128) { misc[64 + gt] = P.in[I_NAQG][gt]; misc[64 + 128 + gt] = P.in[I_NAKG][gt]; misc[64 + 256 + gt] = P.in[I_DFQG][pdim(gt)]; misc[64 + 384 + gt] = P.in[I_DFKG][pdim(gt)]; }
    if (C.bid == 0 && C.wave == 0) { const float* lp = P.in[I_DFLAM]; float s1 = 0.f, s2 = 0.f;
      for (int i = lane; i < 128; i += 64) { s1 += lp[i] * lp[128 + i]; s2 += lp[256 + i] * lp[384 + i]; }
      s1 = wave_sum(s1); s2 = wave_sum(s2); if (lane == 0) misc[0] = expf(s1) - expf(s2) + LAM_INIT; }
    if (C.bid == 0 && C.wave == 1) { float mq = 0.f, mk = 0.f;
      for (int i = lane; i < 128; i += 64) { mq = fmaxf(mq, fabsf(P.in[I_DFQG][i])); mk = fmaxf(mk, fabsf(P.in[I_DFKG][i])); }
#pragma unroll
      for (int o2 = 1; o2 < 64; o2 <<= 1) { mq = fmaxf(mq, __shfl_xor(mq, o2)); mk = fmaxf(mk, __shfl_xor(mk, o2)); }
      if (lane == 0) misc[1] = 11.3137085f * mq * mk * 1.0001f; }
  }
  {
    LAS float* scr = (LAS float*)(C.lds + C.wave * 16384);
    __syncthreads();
    const int gw = C.bid * NWAVE + C.wave, NGW = C.G * NWAVE;
    float ta[32], tb[32];
    int it = gw;
    if (it < T_NITEMS) { TItem da = t_resolve(P, it); t_load(da, ta, lane);
      for (;;) {
        const int itb = it + NGW; TItem db = da; const bool hb = itb < T_NITEMS;
        if (hb) { db = t_resolve(P, itb); t_load(db, tb, lane); }
        t_finish(da, ta, scr, lane);
        if (!hb) break;
        const int ita = itb + NGW; const bool ha = ita < T_NITEMS;
        if (ha) { da = t_resolve(P, ita); t_load(da, ta, lane); }
        t_finish(db, tb, scr, lane);
        if (!ha) break;
        it = ita;
      } }
  }
}

template <bool FIRST, bool LAT_ONLY>
DEVI void phase_norm(const Params& P, const Ctx& C, int layer, int modi, const float* g) {
  CTX_IDS;
  unsigned char* ws = P.ws;
  float* xres = (float*)(ws + WS_XRES); bf16_t* xn = (bf16_t*)(ws + WS_XN);
  const float* mods = (const float*)(ws + WS_MODS) + (size_t)layer * (NB + 1) * 6 * DM;
  const int gw = C.bid * NWAVE + C.wave, NGW = C.G * NWAVE;
  constexpr int NV = DM / 256;
  for (int R = gw; R < MTOK; R += NGW) {
    const int b = R / TPB, r = R % TPB; const bool isc = r < CTX;
    if (LAT_ONLY && isc) continue;
    const float* src = FIRST ? (isc ? P.in[I_CTX] + ((size_t)b * CTX + r) * DM : P.in[I_X] + ((size_t)b * SEQ + (r - CTX)) * DM) : xres + (size_t)R * DM;
    const float* md = mods + (size_t)(isc ? NB : b) * 6 * DM + (size_t)modi * DM;
    f32x4 v[NV]; float s = 0.f;
#pragma unroll
    for (int j = 0; j < NV; ++j) { v[j] = *(const f32x4*)(src + 256 * j + 4 * lane); s += (v[j].x * v[j].x + v[j].y * v[j].y) + (v[j].z * v[j].z + v[j].w * v[j].w); }
    const float rinv = 1.0f / sqrtf(wave_sum(s) * (1.0f / DM) + EPS);
#pragma unroll
    for (int j = 0; j < NV; ++j) { const int c0 = 256 * j + 4 * lane; const f32x4 gg = *(const f32x4*)(g + c0), sh = *(const f32x4*)(md + c0), sc = *(const f32x4*)(md + DM + c0);
      const f32x4 h = (v[j] * rinv) * gg * (sc + 1.0f) + sh; u32x2 o; o.x = cvtpk(h.x, h.y); o.y = cvtpk(h.z, h.w); *(u32x2*)(xn + (size_t)R * DM + c0) = o; }
  }
}

namespace pg8 {
constexpr int BM = 256, BK = 64, HALF = 128, HTB = HALF * BK * 2, STAGE_BYTES = 8 * HTB, NXCD = 8, WGM = 4;
static_assert(STAGE_BYTES <= LDS_RING, "ring");
DEVI int lds_byte(int r, int c) { const int st = (r >> 4) * 2 + (c >> 5), rr = r & 15, cc = c & 31, ob = rr * 64 + cc * 2; return st * 1024 + (ob ^ (((ob >> 9) & 1) << 5)); }
DEVI void stage_rc(int b, int& R, int& C) { const int st = b / 1024, sb = b % 1024, swz = sb ^ (((sb >> 9) & 1) << 5); R = (st >> 1) * 16 + swz / 64; C = (st & 1) * 32 + (swz % 64) / 2; }
DEVI int perm32(int rho) { const int n = rho >> 4, i = rho & 15; return 8 * (i >> 2) + 4 * n + (i & 3); }
struct Unit { int pm, pn, kt0, nkt, slice, tile, ks; };
struct Gemm { const bf16_t* A; const bf16_t* Bt; int K; };
constexpr int KSPLIT = (DM / 64 >= 16) ? 8 : 4;
struct Order {
  int nM, nN, nwg, G, c, nkt, nsl, ks, pn0c, nNc; bool lat_only;
  DEVI void init(int nM_, int nN_, int G_, int c_, bool lat, int nkt_, int ks_ = 0, int pn0c_ = 0, int nNc_ = 0) { nM = nM_; nN = nN_; nwg = nM * nN; G = G_; c = c_; lat_only = lat; nkt = nkt_; ks = ks_; pn0c = pn0c_; nNc = nNc_; nsl = NB * nNc_ * ks_; }
  DEVI bool next(int i, Unit& u) const {
    const long L = (long)i * G + c; if (L >= nwg + nsl) return false;
    u.ks = ks;
    if (L >= nwg) { const int j = (int)L - nwg; u.tile = j / ks; u.slice = j % ks; u.pm = (u.tile / nNc) * TILES_PB; u.pn = pn0c + u.tile % nNc; u.nkt = nkt / ks; u.kt0 = u.slice * u.nkt; return true; }
    u.kt0 = 0; u.nkt = nkt; u.slice = -1; u.tile = 0;
    int wgid = (int)L; { const int q = nwg / NXCD, r = nwg % NXCD, xcd = wgid % NXCD, off = wgid / NXCD; wgid = (xcd < r ? xcd * (q + 1) : r * (q + 1) + (xcd - r) * q) + off; }
    const int nig = WGM * nN, gid = wgid / nig, fm = gid * WGM, gsz = (nM - fm) < WGM ? (nM - fm) : WGM;
    int pm = fm + ((wgid % nig) % gsz); u.pn = (wgid % nig) / gsz;
    if (lat_only) pm = (pm / (TILES_PB - 1)) * TILES_PB + 1 + pm % (TILES_PB - 1);
    u.pm = pm; return true;
  }
};
enum { EM_RAW = 0, EM_SILU = 1, EM_RELU2 = 2, EM_HNORM = 3 };
template <int kind> struct EpiProj {
  static constexpr bool PERM = true;
  bf16_t* O; int ldc;
  const float* gq; const float* gk; const float* rcos; const float* rsin; LAS float* xch; float* slab; unsigned* cnt;
  DEVI int tile_mode(int pn, const float*& g) const {
    const int colt = pn * BM; g = gq;
    if (kind == 0) { const int seg = colt / NAW; g = seg == 1 ? gk : gq; return seg <= 1 ? EM_HNORM : (seg == 3 || seg == 7) ? EM_SILU : EM_RAW; }
    if (kind == 1) { g = colt < DM ? gq : gk; return colt < 2 * DM ? EM_HNORM : EM_RAW; }
    return EM_RELU2;
  }
  DEVI void operator()(f32x4 (&acc)[2][2][4][2], const Unit& u, int wr, int wc, int fr, int fq) const {
    OPAQUE(fr); OPAQUE(fq);
    if (u.slice >= 0) {
      float* sp = slab + (size_t)(u.tile * u.ks + u.slice) * 65536 + (((wr * 4 + wc) * 64 + fq * 16 + fr) * 4);
#pragma unroll
      for (int ai = 0; ai < 2; ++ai)
#pragma unroll
        for (int bj = 0; bj < 2; ++bj)
#pragma unroll
          for (int m = 0; m < 4; ++m)
#pragma unroll
            for (int n = 0; n < 2; ++n) { float* q_ = sp + (((ai * 2 + bj) * 4 + m) * 2 + n) * 2048; ST_WT16(q_, acc[ai][bj][m][n]); }
      WAIT_V(0); BAR(); CFENCE();
      if (wr == 0 && wc == 0 && LANE_ID() == 0) (void)AT_ADD(cnt + 16 * u.tile, 1u);
      return;
    }
    int mode = EM_RAW; const float* g = gq; bool rope = false;
    const int colt = u.pn * BM;
    if (kind == 0) { const int seg = colt / NAW; mode = seg == 0 ? EM_HNORM : seg == 1 ? EM_HNORM : (seg == 3 || seg == 7) ? EM_SILU : EM_RAW; g = seg == 1 ? gk : gq; }
    else if (kind == 1) { if (colt < 2 * DM) { mode = EM_HNORM; g = colt < DM ? gq : gk; rope = (u.pm % TILES_PB) != 0; } }
    else mode = EM_RELU2;
    bf16_t* base = O + (size_t)(u.pm * BM) * ldc + colt;
    if (mode == EM_HNORM) {
#pragma unroll
      for (int ai = 0; ai < 2; ++ai)
#pragma unroll
        for (int m = 0; m < 4; ++m)
#pragma unroll
          for (int bj = 0; bj < 2; ++bj) { const f32x4 a = acc[ai][bj][m][0], b = acc[ai][bj][m][1];
            float s = (a.x * a.x + a.y * a.y) + (a.z * a.z + a.w * a.w) + (b.x * b.x + b.y * b.y) + (b.z * b.z + b.w * b.w);
            s += __shfl_xor(s, 16); s += __shfl_xor(s, 32);
            if (fq == 0) xch[(ai * HALF + wr * 64 + m * 16 + fr) * 8 + bj * 4 + wc] = s; }
      WAIT_L(0); BAR(); CFENCE();
      const int lt0 = (u.pm % TILES_PB - 1) * 256;
#pragma unroll
      for (int ai = 0; ai < 2; ++ai)
#pragma unroll
        for (int m = 0; m < 4; ++m) { const int lr = ai * HALF + wr * 64 + m * 16 + fr;
          f32x4 cs = {1.f, 1.f, 1.f, 1.f}, sn = {0.f, 0.f, 0.f, 0.f};
          if (rope) { cs = *(const f32x4*)(rcos + (size_t)(lt0 + lr) * 64 + 16 * wc + 4 * fq); sn = *(const f32x4*)(rsin + (size_t)(lt0 + lr) * 64 + 16 * wc + 4 * fq); }
#pragma unroll
          for (int bj = 0; bj < 2; ++bj) { const f32x4 t = *(const LAS f32x4*)(xch + lr * 8 + bj * 4);
            const float rinv = rsq_fast(((t.x + t.y) + (t.z + t.w)) * (1.0f / 128.0f) + EPS);
            const f32x4 g0 = *(const f32x4*)(g + 32 * wc + 8 * fq), g1 = *(const f32x4*)(g + 32 * wc + 8 * fq + 4);
            const f32x4 x1 = acc[ai][bj][m][0] * rinv * g0, x2 = acc[ai][bj][m][1] * rinv * g1;
            const f32x4 o1 = x1 * cs - x2 * sn, o2 = x1 * sn + x2 * cs;
            u32x4 w; w.x = cvtpk(o1.x, o1.y); w.y = cvtpk(o1.z, o1.w); w.z = cvtpk(o2.x, o2.y); w.w = cvtpk(o2.z, o2.w);
            *(u32x4*)(base + (size_t)lr * ldc + bj * HALF + wc * 32 + 8 * fq) = w; } }
    } else {
#pragma unroll
      for (int ai = 0; ai < 2; ++ai)
#pragma unroll
        for (int m = 0; m < 4; ++m) { const int lr = ai * HALF + wr * 64 + m * 16 + fr;
#pragma unroll
          for (int bj = 0; bj < 2; ++bj) { f32x4 v0 = acc[ai][bj][m][0], v1 = acc[ai][bj][m][1];
            if (mode == EM_SILU) {
#pragma unroll
              for (int e = 0; e < 4; ++e) { v0[e] = silu_f(v0[e]); v1[e] = silu_f(v1[e]); } }
            else if (mode == EM_RELU2) {
#pragma unroll
              for (int e = 0; e < 4; ++e) { const float a = fmaxf(v0[e], 0.f), b = fmaxf(v1[e], 0.f); v0[e] = a * a; v1[e] = b * b; } }
            u32x4 w; w.x = cvtpk(v0.x, v0.y); w.y = cvtpk(v0.z, v0.w); w.z = cvtpk(v1.x, v1.y); w.w = cvtpk(v1.z, v1.w);
            *(u32x4*)(base + (size_t)lr * ldc + bj * HALF + wc * 32 + 8 * fq) = w; } }
    }
  }
};
struct EpiResid {
  static constexpr bool PERM = false;
  float* xres; float* xdst; const float* gate; float* fin; float* slab; unsigned* cnt; const float* in_x; const float* in_ctx;
  DEVI void operator()(f32x4 (&acc)[2][2][4][2], const Unit& u, int wr, int wc, int fr, int fq) const {
    OPAQUE(fr); OPAQUE(fq);
    if (u.slice >= 0) {
      float* sp = slab + (size_t)(u.tile * u.ks + u.slice) * 65536 + (((wr * 4 + wc) * 64 + fq * 16 + fr) * 4);
#pragma unroll
      for (int ai = 0; ai < 2; ++ai)
#pragma unroll
        for (int bj = 0; bj < 2; ++bj)
#pragma unroll
          for (int m = 0; m < 4; ++m)
#pragma unroll
            for (int n = 0; n < 2; ++n) { float* q_ = sp + (((ai * 2 + bj) * 4 + m) * 2 + n) * 2048; ST_WT16(q_, acc[ai][bj][m][n]); }
      WAIT_V(0); BAR(); CFENCE();
      if (wr == 0 && wc == 0 && LANE_ID() == 0) (void)AT_ADD(cnt + 16 * u.tile, 1u);
      return;
    }
    const int b = u.pm / TILES_PB, within = u.pm % TILES_PB; const bool isc = within == 0;
    const float* gp = gate + (size_t)(isc ? NB : b) * 6 * DM + u.pn * BM + wc * 32 + 4 * fq;
    f32x4 gv[2][2];
#pragma unroll
    for (int bj = 0; bj < 2; ++bj)
#pragma unroll
      for (int n = 0; n < 2; ++n) gv[bj][n] = *(const f32x4*)(gp + bj * HALF + n * 16);
    const size_t toff = (size_t)(u.pm * BM) * DM + u.pn * BM + wc * 32 + 4 * fq;
    const float* src = in_x ? (isc ? in_ctx + (size_t)b * CTX * DM : in_x + ((size_t)b * SEQ + (size_t)(within - 1) * 256) * DM) + u.pn * BM + wc * 32 + 4 * fq : xres + toff;
    float* dst = (fin && !isc) ? fin + ((size_t)b * SEQ + (size_t)(within - 1) * 256) * DM + u.pn * BM + wc * 32 + 4 * fq : xdst + toff;
#pragma unroll
    for (int ai = 0; ai < 2; ++ai)
#pragma unroll
      for (int m = 0; m < 4; ++m) { const size_t ro = (size_t)(ai * HALF + wr * 64 + m * 16 + fr) * DM;
#pragma unroll
        for (int bj = 0; bj < 2; ++bj)
#pragma unroll
          for (int n = 0; n < 2; ++n) { const f32x4 bs = *(const f32x4*)(src + ro + bj * HALF + n * 16); *(f32x4*)(dst + ro + bj * HALF + n * 16) = bs + gv[bj][n] * acc[ai][bj][m][n]; } }
  }
};

DEVI const float* slab_piece(const float* unit, int row, int bj, int wc, int fq, int n) {
  const int ai = row >> 7, wr = (row >> 6) & 1, m = (row >> 4) & 3, fr = row & 15;
  return unit + ((((ai * 2 + bj) * 4 + m) * 2 + n) * 512 + (wr * 4 + wc) * 64 + fq * 16 + fr) * 4;
}
DEVI void combine_slices(const Order& S, const EpiResid& E, int wid) {
  const int lane = LANE_ID(), tid = wid * 64 + lane;
  Unit u;
  for (int i = 0; S.next(i, u); ++i) {
    if (u.slice < 0) continue;
    if (wid == 0) { unsigned sp = 0; while (AT_LD(E.cnt + 16 * u.tile) < (unsigned)u.ks) { SLEEP1(); if (++sp > (1u << 24)) break; } FENCE_ACQ(); WAIT_V(0); }
    __syncthreads();
    const int RPS = 256 / u.ks;
    for (int rr = tid >> 4; rr < RPS; rr += 32) {
      const int row = RPS * u.slice + rr, col = (tid & 15) * 16;
      const float* sp = E.slab + (size_t)u.tile * u.ks * 65536;
      f32x4 a[4];
#pragma unroll
      for (int q = 0; q < 4; ++q) a[q] = (f32x4){0.f, 0.f, 0.f, 0.f};
      for (int s2 = 0; s2 < u.ks; ++s2)
#pragma unroll
        for (int q = 0; q < 4; ++q) a[q] += *(const f32x4*)slab_piece(sp + (size_t)s2 * 65536, row, col >> 7, (col >> 5) & 3, q, (col >> 4) & 1);
      const float* gp = E.gate + (size_t)NB * 6 * DM + u.pn * BM + col;
      const size_t off = (size_t)(u.pm * BM + row) * DM + u.pn * BM + col;
      const float* bs = E.in_ctx ? E.in_ctx + ((size_t)(u.pm / TILES_PB) * CTX + row) * DM + u.pn * BM + col : E.xres + off;
#pragma unroll
      for (int q = 0; q < 4; ++q) *(f32x4*)(E.xdst + off + 4 * q) = *(const f32x4*)(bs + 4 * q) + *(const f32x4*)(gp + 4 * q) * a[q];
    }
    __syncthreads();
  }
}
template <int kind>
DEVI void combine_proj(const Order& S, const EpiProj<kind>& E, int wid) {
  const int lane = LANE_ID(), tid = wid * 64 + lane;
  Unit u;
  for (int i = 0; S.next(i, u); ++i) {
    if (u.slice < 0) continue;
    if (wid == 0) { unsigned sp = 0; while (AT_LD(E.cnt + 16 * u.tile) < (unsigned)u.ks) { SLEEP1(); if (++sp > (1u << 24)) break; } FENCE_ACQ(); WAIT_V(0); }
    __syncthreads();
    const float* g; const int mode = E.tile_mode(u.pn, g);
    const int RPS = 256 / u.ks;
    for (int rr = tid >> 4; rr < RPS; rr += 32) {
      const int row = RPS * u.slice + rr, col = (tid & 15) * 16;
      const float* sp = E.slab + (size_t)u.tile * u.ks * 65536;
      f32x4 a[4];
#pragma unroll
      for (int q = 0; q < 4; ++q) a[q] = (f32x4){0.f, 0.f, 0.f, 0.f};
      for (int s2 = 0; s2 < u.ks; ++s2)
#pragma unroll
        for (int q = 0; q < 4; ++q) a[q] += *(const f32x4*)slab_piece(sp + (size_t)s2 * 65536, row, col >> 7, (col >> 5) & 3, ((col & 31) >> 3) + (q >> 1), q & 1);
      if (mode == EM_HNORM) {
        float ss = 0.f;
#pragma unroll
        for (int q = 0; q < 4; ++q) ss += (a[q].x * a[q].x + a[q].y * a[q].y) + (a[q].z * a[q].z + a[q].w * a[q].w);
        ss += __shfl_xor(ss, 1); ss += __shfl_xor(ss, 2); ss += __shfl_xor(ss, 4);
        const float rinv = rsq_fast(ss * (1.0f / 128.0f) + EPS);
#pragma unroll
        for (int q = 0; q < 4; ++q) a[q] = a[q] * rinv * *(const f32x4*)(g + (col & 127) + 4 * q);
      } else if (mode == EM_SILU) {
#pragma unroll
        for (int q = 0; q < 4; ++q)
#pragma unroll
          for (int e = 0; e < 4; ++e) a[q][e] = silu_f(a[q][e]);
      } else if (mode == EM_RELU2) {
#pragma unroll
        for (int q = 0; q < 4; ++q)
#pragma unroll
          for (int e = 0; e < 4; ++e) { const float t = fmaxf(a[q][e], 0.f); a[q][e] = t * t; }
      }
      bf16_t* dst = E.O + (size_t)(u.pm * BM + row) * E.ldc + u.pn * BM + col;
      u32x4 w0, w1; w0.x = cvtpk(a[0].x, a[0].y); w0.y = cvtpk(a[0].z, a[0].w); w0.z = cvtpk(a[1].x, a[1].y); w0.w = cvtpk(a[1].z, a[1].w);
      w1.x = cvtpk(a[2].x, a[2].y); w1.y = cvtpk(a[2].z, a[2].w); w1.z = cvtpk(a[3].x, a[3].y); w1.w = cvtpk(a[3].z, a[3].w);
      *(u32x4*)dst = w0; *(u32x4*)(dst + 8) = w1;
    }
    __syncthreads();
  }
}
template <class Epi>
DEVI void gemm_phase(LAS unsigned char* lds, int wid, const Gemm g, const Order& S, const Epi& E) {
  const int lane = LANE_ID(), tid = wid * 64 + lane, wr = wid >> 2, wc = wid & 3, fr = lane & 15, fq = lane >> 4;
  const int K = g.K;
  unsigned voffA[2], voffB[2];
#pragma unroll
  for (int i = 0; i < 2; ++i) { int R, C; stage_rc(tid * 16 + i * 8192, R, C); const int Rb = Epi::PERM ? ((R & ~31) + perm32(R & 31)) : R;
    voffA[i] = (unsigned)(R * K + C) * 2u; voffB[i] = (unsigned)(Rb * K + C) * 2u; }
  const size_t kstep = (size_t)(BK * 2);
  const size_t hstep = (size_t)HALF * K * 2;
  const size_t tstep = 2 * hstep;
  const unsigned ldsw = (unsigned)wid * 1024u;
  const int aoff = lds_byte(wr * 64 + fr, fq * 8), boff = lds_byte(wc * 32 + fr, fq * 8);
#define PG8_SA(b, h) (((b) * 2 + (h)) * HTB)
#define PG8_SB(b, h) ((4 + (b) * 2 + (h)) * HTB)
#define PG8_STAGE(bufoff, gbase, voff) do { _Pragma("unroll") for (int _i = 0; _i < 2; ++_i) \
    GLDS16((const char*)(gbase) + (voff)[_i], lds + (bufoff) + ldsw + _i * 8192); } while (0)
#define PG8_LDA(dst, b, h) do { _Pragma("unroll") for (int m = 0; m < 4; ++m) _Pragma("unroll") for (int k = 0; k < 2; ++k) dst[m][k] = *(const LAS bf16x8*)(lds + PG8_SA(b, h) + aoff + m * 2048 + k * 1024); } while (0)
#define PG8_LDB(dst, b, h) do { _Pragma("unroll") for (int n = 0; n < 2; ++n) _Pragma("unroll") for (int k = 0; k < 2; ++k) dst[n][k] = *(const LAS bf16x8*)(lds + PG8_SB(b, h) + boff + n * 2048 + k * 1024); } while (0)
#define PG8_MMA(ai, bj, At, Bt) do { SETPRIO(1); _Pragma("unroll") for (int m = 0; m < 4; ++m) _Pragma("unroll") for (int n = 0; n < 2; ++n) _Pragma("unroll") for (int k = 0; k < 2; ++k) \
    acc[ai][bj][m][n] = mfma16(Bt[n][k], At[m][k], acc[ai][bj][m][n]); SETPRIO(0); } while (0)
  Unit cur, nxt; int ui = 0;
  if (!S.next(0, cur)) return;
  f32x4 acc[2][2][4][2];
#pragma unroll
  for (int a = 0; a < 2; ++a)
#pragma unroll
    for (int b = 0; b < 2; ++b)
#pragma unroll
      for (int m = 0; m < 4; ++m)
#pragma unroll
        for (int n = 0; n < 2; ++n) acc[a][b][m][n] = (f32x4){0.f, 0.f, 0.f, 0.f};
  bf16x8 At[4][2], B0[2][2], B1[2][2];
  const char* cA = (const char*)g.A + (size_t)cur.pm * tstep + (size_t)cur.kt0 * kstep; const char* cB = (const char*)g.Bt + (size_t)cur.pn * tstep + (size_t)cur.kt0 * kstep;
  int nt = cur.nkt;
  PG8_STAGE(PG8_SB(0, 0), cB, voffB); PG8_STAGE(PG8_SB(0, 1), cB + hstep, voffB); PG8_STAGE(PG8_SA(0, 0), cA, voffA); PG8_STAGE(PG8_SA(0, 1), cA + hstep, voffA);
  if (wr == 1) BAR();
  WAIT_V(2); BAR();
  PG8_STAGE(PG8_SB(1, 0), cB + kstep, voffB); PG8_STAGE(PG8_SA(1, 0), cA + kstep, voffA); PG8_STAGE(PG8_SB(1, 1), cB + hstep + kstep, voffB);
  WAIT_V(6); BAR();
  for (;;) {
    const bool has_next = S.next(ui + 1, nxt);
    const char* nA = has_next ? (const char*)g.A + (size_t)nxt.pm * tstep + (size_t)nxt.kt0 * kstep : cA; const char* nB = has_next ? (const char*)g.Bt + (size_t)nxt.pn * tstep + (size_t)nxt.kt0 * kstep : cB;
    for (int t = 0; t < nt; t += 2) {
      const bool last = (t == nt - 2);
      const char* a1 = cA + (size_t)(t + 1) * kstep;
      const char* a2 = last ? nA : cA + (size_t)(t + 2) * kstep; const char* b2 = last ? nB : cB + (size_t)(t + 2) * kstep;
      const char* a3 = a2 + kstep; const char* b3 = b2 + kstep;
      PG8_LDB(B0, 0, 0); PG8_LDB(B1, 0, 1); SCHED(); PG8_LDA(At, 0, 0); PG8_STAGE(PG8_SA(1, 1), a1 + hstep, voffA);
      WAIT_V(8); WAIT_L(0); BAR(); PG8_MMA(0, 0, At, B0); PG8_MMA(0, 1, At, B1); BAR(); SCHED();
      PG8_LDA(At, 0, 1); PG8_STAGE(PG8_SB(0, 0), b2, voffB); PG8_STAGE(PG8_SB(0, 1), b2 + hstep, voffB); PG8_STAGE(PG8_SA(0, 0), a2, voffA);
      WAIT_V(8); WAIT_L(0); BAR(); PG8_MMA(1, 0, At, B0); PG8_MMA(1, 1, At, B1); BAR(); SCHED();
      PG8_LDB(B0, 1, 0); PG8_LDB(B1, 1, 1); SCHED(); PG8_LDA(At, 1, 0); PG8_STAGE(PG8_SA(0, 1), a2 + hstep, voffA);
      WAIT_V(8); WAIT_L(0); BAR(); PG8_MMA(0, 0, At, B0); PG8_MMA(0, 1, At, B1); BAR(); SCHED();
      PG8_LDA(At, 1, 1); PG8_STAGE(PG8_SB(1, 0), b3, voffB); PG8_STAGE(PG8_SB(1, 1), b3 + hstep, voffB); PG8_STAGE(PG8_SA(1, 0), a3, voffA);
      WAIT_V(8); WAIT_L(0); BAR(); PG8_MMA(1, 0, At, B0); PG8_MMA(1, 1, At, B1); BAR(); SCHED();
    }
    if (wr == 0) BAR();
    E(acc, cur, wr, wc, fr, fq);
    if (!has_next) break;
#pragma unroll
    for (int a = 0; a < 2; ++a)
#pragma unroll
      for (int b = 0; b < 2; ++b)
#pragma unroll
        for (int m = 0; m < 4; ++m)
#pragma unroll
          for (int n = 0; n < 2; ++n) acc[a][b][m][n] = (f32x4){0.f, 0.f, 0.f, 0.f};
    cur = nxt; cA = nA; cB = nB; ++ui; nt = cur.nkt;
    if (wr == 1) BAR();
  }
  WAIT_V(0);
  BAR();
#undef PG8_SA
#undef PG8_SB
#undef PG8_STAGE
#undef PG8_LDA
#undef PG8_LDB
#undef PG8_MMA
}
}

namespace att {
constexpr int D = 128, NW = 8, QBLK = 32, KVBLK = 64;
constexpr float SCALE = 0.088388347648318440f, THR = 8.f;
constexpr int SHM_V = KVBLK * D * 2, SHM_K = KVBLK * D * 2, SHM_ATTN = 2 * SHM_V + 2 * SHM_K + NW * 64 * 4;
#define KSWZ(row, colB) ((row) * 256 + ((colB) ^ (((row) & 15) << 4)))
DEVI int crow(int r, int hi) { return (r & 3) + 8 * (r >> 2) + 4 * hi; }
DEVI void partialSM(f32x16& p0, f32x16& p1, float& m_reg, float& mn, float& alpha) {
  constexpr float Cc = SCALE * 1.4426950408889634f;
  float pmax = p0[0];
#pragma unroll
  for (int r = 1; r < 16; ++r) pmax = fmaxf(pmax, p0[r]);
#pragma unroll
  for (int r = 0; r < 16; ++r) pmax = fmaxf(pmax, p1[r]);
  { unsigned a, b; plswap(__builtin_bit_cast(unsigned, pmax), __builtin_bit_cast(unsigned, pmax), a, b); pmax = fmaxf(__builtin_bit_cast(float, a), __builtin_bit_cast(float, b)); }
  if (__builtin_expect(__all(pmax - m_reg <= THR / SCALE), 1)) { mn = m_reg; alpha = 1.f; }
  else { mn = fmaxf(m_reg, pmax); alpha = exp2_fast((m_reg - mn) * Cc); m_reg = mn; }
  const float mnC = -mn * Cc;
#pragma unroll
  for (int r = 0; r < 16; ++r) p0[r] = fmaf(p0[r], Cc, mnC);
#pragma unroll
  for (int r = 0; r < 16; ++r) p1[r] = fmaf(p1[r], Cc, mnC);
#pragma unroll
  for (int r = 0; r < 16; ++r) p0[r] = exp2_fast(p0[r]);
}
DEVI void finishSM(f32x16& p0, f32x16& p1, float alpha, float& l_reg, bf16x8& pa0, bf16x8& pa1, bf16x8& pa2, bf16x8& pa3) {
#pragma unroll
  for (int r = 0; r < 16; ++r) p1[r] = exp2_fast(p1[r]);
  float ps = 0;
#pragma unroll
  for (int r = 0; r < 16; ++r) ps += p0[r];
#pragma unroll
  for (int r = 0; r < 16; ++r) ps += p1[r];
  { unsigned a, b; plswap(__builtin_bit_cast(unsigned, ps), __builtin_bit_cast(unsigned, ps), a, b); ps = __builtin_bit_cast(float, a) + __builtin_bit_cast(float, b); }
  l_reg = l_reg * alpha + ps;
#define PK4(P, BASE, OUT) do { unsigned a0 = cvtpk(P[BASE + 0], P[BASE + 1]), a1 = cvtpk(P[BASE + 2], P[BASE + 3]);   \
    unsigned b0 = cvtpk(P[BASE + 4], P[BASE + 5]), b1 = cvtpk(P[BASE + 6], P[BASE + 7]);                              \
    unsigned r00, r01, r10, r11; plswap(a0, b0, r00, r01); plswap(a1, b1, r10, r11); \
    u32x4 w = {r00, r10, r01, r11}; OUT = __builtin_bit_cast(bf16x8, w); } while (0)
  PK4(p0, 0, pa0); PK4(p0, 8, pa1); PK4(p1, 0, pa2); PK4(p1, 8, pa3);
#undef PK4
}
DEVI void finishSM_noexp(f32x16& p0, f32x16& p1, float& l_reg, bf16x8& pa0, bf16x8& pa1, bf16x8& pa2, bf16x8& pa3) {
  float ps = 0;
#pragma unroll
  for (int r = 0; r < 16; ++r) ps += p0[r];
#pragma unroll
  for (int r = 0; r < 16; ++r) ps += p1[r];
  { unsigned a, b; plswap(__builtin_bit_cast(unsigned, ps), __builtin_bit_cast(unsigned, ps), a, b); ps = __builtin_bit_cast(float, a) + __builtin_bit_cast(float, b); }
  l_reg += ps;
#define PK4(P, BASE, OUT) do { unsigned a0 = cvtpk(P[BASE + 0], P[BASE + 1]), a1 = cvtpk(P[BASE + 2], P[BASE + 3]);   \
    unsigned b0 = cvtpk(P[BASE + 4], P[BASE + 5]), b1 = cvtpk(P[BASE + 6], P[BASE + 7]);                              \
    unsigned r00, r01, r10, r11; plswap(a0, b0, r00, r01); plswap(a1, b1, r10, r11); \
    u32x4 w = {r00, r10, r01, r11}; OUT = __builtin_bit_cast(bf16x8, w); } while (0)
  PK4(p0, 0, pa0); PK4(p0, 8, pa1); PK4(p1, 0, pa2); PK4(p1, 8, pa3);
#undef PK4
}
template <class Mask> DEVI void qkt(f32x16& p0, f32x16& p1, const LAS unsigned char* Ks, const bf16x8* qr, int r32, int hi, const Mask& mask, int t) {
  mask.init(p0, p1, t);
  if constexpr (Mask::OPQ) OPAQUE(r32);
#pragma unroll
  for (int d0 = 0; d0 < 8; ++d0) { const int cb = (d0 * 16 + hi * 8) * 2;
    const bf16x8 b0 = *(const LAS bf16x8*)(Ks + KSWZ(r32, cb));
    const bf16x8 b1 = *(const LAS bf16x8*)(Ks + KSWZ(32 + r32, cb));
    p0 = mfma32(b0, qr[d0], p0);
    p1 = mfma32(b1, qr[d0], p1); }
}
DEVI int v_st(int k, int c) { const int kk = (k & ~0xC) | ((k & 4) << 1) | ((k & 8) >> 1); return ((kk >> 3) * 4 + (c >> 5)) * 512 + ((kk & 7) * 32 + (c & 31)) * 2; }
DEVI int v_rd_base(int lane) { return ((lane & 3) << 3) | (((lane >> 2) & 3) << 6) | (((lane >> 4) & 1) << 5) | (((lane >> 5) & 1) << 8); }
constexpr int v_rd_off(int d0, int ks, int half) { return d0 * 512 + ks * 4096 + half * 2048; }
template <int D0> DEVI void pv_one(f32x16& od, const LAS unsigned char* vb, bf16x8 pa0, bf16x8 pa1, bf16x8 pa2, bf16x8 pa3) {
  const s16x4 l0 = tr_read_p(vb + v_rd_off(D0, 0, 0)), h0 = tr_read_p(vb + v_rd_off(D0, 0, 1)), l1 = tr_read_p(vb + v_rd_off(D0, 1, 0)), h1 = tr_read_p(vb + v_rd_off(D0, 1, 1));
  const s16x4 l2 = tr_read_p(vb + v_rd_off(D0, 2, 0)), h2 = tr_read_p(vb + v_rd_off(D0, 2, 1)), l3 = tr_read_p(vb + v_rd_off(D0, 3, 0)), h3 = tr_read_p(vb + v_rd_off(D0, 3, 1));
#define PK(L, H) (bf16x8){L[0], L[1], L[2], L[3], H[0], H[1], H[2], H[3]}
  od = mfma32(pa0, PK(l0, h0), od);
  od = mfma32(pa1, PK(l1, h1), od);
  od = mfma32(pa2, PK(l2, h2), od);
  od = mfma32(pa3, PK(l3, h3), od);
#undef PK
}
DEVI void pv_d0(f32x16 (&o)[4], const LAS unsigned char* vb, bf16x8 pa0, bf16x8 pa1, bf16x8 pa2, bf16x8 pa3) {
  pv_one<0>(o[0], vb, pa0, pa1, pa2, pa3); pv_one<1>(o[1], vb, pa0, pa1, pa2, pa3); pv_one<2>(o[2], vb, pa0, pa1, pa2, pa3); pv_one<3>(o[3], vb, pa0, pa1, pa2, pa3);
}
struct NoMask { static constexpr bool OPQ = false; DEVI void init(f32x16& p0, f32x16& p1, int) const { p0 = f32x16{}; p1 = f32x16{}; } };
constexpr int NA_TABW = 128, NA_TABOFF = 48;
struct NaMask {
  static constexpr bool OPQ = true;
  const LAS float* tb0;
  int wb;
  int kr0, r0w;
  DEVI void init(f32x16& p0, f32x16& p1, int t) const {
    if (t < 4) { p0 = f32x16{}; p1 = f32x16{}; return; }
    const int kr = kr0 + t - 4;
    if (kr < r0w || kr >= r0w + 8) {
#pragma unroll
      for (int rg = 0; rg < 16; ++rg) { p0[rg] = -INFINITY; p1[rg] = -INFINITY; }
      return; }
    const LAS float* tb = tb0 + kr * NA_TABW;
#pragma unroll
    for (int rg = 0; rg < 16; ++rg) {
      const int k = (rg & 3) + 8 * (rg >> 2);
      const float b1 = tb[k], b2 = tb[k + 32];
      p0[rg] = (unsigned)(k + wb) < 16u ? b1 : -INFINITY; p1[rg] = (unsigned)(k + 32 + wb) < 16u ? b2 : -INFINITY;
      if ((rg & 3) == 3) CFENCE(); }
  }
};
template <bool DEEP, class Mask>
DEVI void attn_body(const bf16_t* __restrict__ Qb, const bf16_t* __restrict__ Kh, const bf16_t* __restrict__ Vh, int NT, int kshift, const Mask& mask, LAS unsigned char* lds, int wid, f32x16 (&o)[4]) {
  constexpr int ldq = 4 * DM, ldk = 4 * DM;
  int lane = LANE_ID(); OPAQUE(lane);
  const int tid = wid * 64 + lane, r32 = lane & 31, hi = lane >> 5;
  LAS unsigned char* V_lds = lds; LAS unsigned char* K_lds = lds + 2 * SHM_V;
  LAS float* wsf = (LAS float*)(lds + 2 * SHM_V + 2 * SHM_K) + wid * 64; LAS float* li_l = wsf; LAS float* al_l = wsf + 32;
  float m_reg = -1e30f, l_reg = 0; bf16x8 qr[8];
#pragma unroll
  for (int d = 0; d < 4; ++d) o[d] = f32x16{};
  const bf16_t* Qw = Qb + (long)(wid * QBLK + r32) * ldq + hi * 8;
#pragma unroll
  for (int d0 = 0; d0 < 8; ++d0) qr[d0] = *(const bf16x8*)(Qw + d0 * 16);
  const int sr = tid >> 4, sc = (tid & 15) * 8, vst0 = v_st(sr, sc), vst1 = v_st(32 + sr, sc);
  const LAS unsigned char* vb0 = V_lds + v_rd_base(lane);
  bf16x8 vsA0, vsA1, ksA0, ksA1, vsB0, vsB1, ksB0, ksB1;
#define ROW0(t) (64L * ((t) < 4 ? (t) : (t) + kshift))
#define SLOAD(S, t) do { const long r0_ = ROW0(t); vs##S##0 = *(const bf16x8*)(Vh + (r0_ + sr) * ldk + sc); vs##S##1 = *(const bf16x8*)(Vh + (r0_ + 32 + sr) * ldk + sc); \
    ks##S##0 = *(const bf16x8*)(Kh + (r0_ + sr) * ldk + sc); ks##S##1 = *(const bf16x8*)(Kh + (r0_ + 32 + sr) * ldk + sc); } while (0)
#define SWRITE(b, S) do { *(LAS bf16x8*)(V_lds + (b) * SHM_V + vst0) = vs##S##0; *(LAS bf16x8*)(V_lds + (b) * SHM_V + vst1) = vs##S##1; const int kc_ = sc * 2; \
    *(LAS bf16x8*)(K_lds + (b) * SHM_K + KSWZ(sr, kc_)) = ks##S##0; *(LAS bf16x8*)(K_lds + (b) * SHM_K + KSWZ(32 + sr, kc_)) = ks##S##1; } while (0)
#define SWAIT() WAIT_V(4)
#define RESC(a) do { if (__any((a) < 1.f)) { if (hi == 0) al_l[r32] = (a); WAIT_L(0); WSYNC(); \
    _Pragma("unroll") for (int d = 0; d < 4; ++d) _Pragma("unroll") for (int r = 0; r < 16; ++r) o[d][r] *= al_l[crow(r, hi)]; } } while (0)
  f32x16 pA0, pA1, pB0, pB1; float mnA, mnB, alA, alB; bf16x8 pa0, pa1, pa2, pa3;
  SLOAD(A, 0); WAIT_V(0); SWRITE(0, A); __syncthreads();
  qkt(pA0, pA1, K_lds, qr, r32, hi, mask, 0); partialSM(pA0, pA1, m_reg, mnA, alA);
  if constexpr (DEEP) { SLOAD(B, 1); if (2 < NT) SLOAD(A, 2); SWAIT(); SWRITE(1, B); } else { SLOAD(A, 1); WAIT_V(0); SWRITE(1, A); }
  __syncthreads();
  for (int j = 1; j + 1 < NT; j += 2) {
    SCHED(); qkt(pB0, pB1, K_lds + SHM_K, qr, r32, hi, mask, j);
    finishSM(pA0, pA1, alA, l_reg, pa0, pa1, pa2, pa3); SCHED();
    if constexpr (DEEP) SLOAD(B, j + 2); else SLOAD(A, j + 1);
    SCHED();
    pv_d0(o, vb0, pa0, pa1, pa2, pa3); partialSM(pB0, pB1, m_reg, mnB, alB);
    __syncthreads(); if constexpr (DEEP) SWAIT(); else WAIT_V(0);
    SWRITE(0, A);
    RESC(alB); __syncthreads();
    SCHED(); qkt(pA0, pA1, K_lds, qr, r32, hi, mask, j + 1);
    finishSM(pB0, pB1, alB, l_reg, pa0, pa1, pa2, pa3); SCHED();
    if constexpr (DEEP) { if (j + 3 < NT) SLOAD(A, j + 3); } else SLOAD(A, j + 2);
    SCHED();
    pv_d0(o, vb0 + SHM_V, pa0, pa1, pa2, pa3); partialSM(pA0, pA1, m_reg, mnA, alA);
    __syncthreads(); if constexpr (DEEP) { SWAIT(); SWRITE(1, B); } else { WAIT_V(0); SWRITE(1, A); }
    RESC(alA); __syncthreads();
  }
  SCHED(); qkt(pB0, pB1, K_lds + SHM_K, qr, r32, hi, mask, NT - 1);
  finishSM(pA0, pA1, alA, l_reg, pa0, pa1, pa2, pa3); SCHED();
  pv_d0(o, vb0, pa0, pa1, pa2, pa3); partialSM(pB0, pB1, m_reg, mnB, alB);
  __syncthreads(); RESC(alB);
  finishSM(pB0, pB1, alB, l_reg, pa0, pa1, pa2, pa3); SCHED();
  pv_d0(o, vb0 + SHM_V, pa0, pa1, pa2, pa3);
  if (hi == 0) li_l[r32] = l_reg; WAIT_L(0); WSYNC();
#pragma unroll
  for (int r = 0; r < 16; ++r) { const float rl = rcp_fast(li_l[crow(r, hi)]);
#pragma unroll
    for (int d = 0; d < 4; ++d) o[d][r] *= rl; }
  __syncthreads();
#undef ROW0
#undef SLOAD
#undef SWRITE
#undef SWAIT
#undef RESC
}
}

DEVI void phase_attn0(const Params& P, const Ctx& C) {
  CTX_IDS;
  unsigned char* ws = P.ws;
  const bf16_t* Pm = (const bf16_t*)(ws + WS_P); bf16_t* AO = (bf16_t*)(ws + WS_AO);
  constexpr int LDP = 4 * DM, NQB = SEQ / 256, N_NA = NB * NAH * NQB, N_CX = NB * NAH;
  LAS float* tab = (LAS float*)(C.lds + att::SHM_ATTN);
  const int r32 = lane & 31, hi = lane >> 5;
  for (int it0 = C.vcu; it0 < N_NA; it0 += C.G)
  for (int sub = 0; sub < 2; ++sub) {
    if (sub == 1 && (it0 % NQB) != 0) break;
    const int it = sub == 0 ? it0 : N_NA + it0 / NQB;
    f32x16 o[4]; size_t R0; int h;
    if (it < N_NA) {
      const int g = it % NQB; h = (it / NQB) % NAH; const int b = it / (NQB * NAH);
      for (int i = tid; i < 15 * att::NA_TABW; i += NTHR) { const int dr = i / att::NA_TABW, dc = i % att::NA_TABW - att::NA_TABOFF; tab[i] = (dc >= 0 && dc < 31) ? P.in[I_RPB][((size_t)h * 15 + dr) * 31 + dc] * (1.0f / att::SCALE) : 0.f; }
      __syncthreads();
      auto r0f = [](int r) { int v = r - 4; return v < 0 ? 0 : (v > GROWS - 8 ? GROWS - 8 : v); };
      int kr0 = r0f(4 * g), nrows = r0f(4 * g + 3) + 8 - kr0;
      if (nrows & 1) { if (kr0 + nrows < GROWS) ++nrows; else { --kr0; ++nrows; } }
      const int rq = 4 * g + (C.wave >> 1), qc = 32 * (C.wave & 1) + r32; int c0 = qc - 8; c0 = c0 < 0 ? 0 : (c0 > GW - 16 ? GW - 16 : c0);
      att::NaMask mk{tab + (7 - rq) * att::NA_TABW + 4 * hi - qc + 15 + att::NA_TABOFF, 4 * hi - c0, kr0, r0f(rq)};
      R0 = (size_t)b * TPB + CTX + 256 * g;
      att::attn_body<false>(Pm + R0 * LDP + C_QA + h * 128, Pm + (size_t)b * TPB * LDP + C_KA + h * 128, Pm + (size_t)b * TPB * LDP + C_VA + h * 128, 4 + nrows, kr0, mk, C.lds, C.wave, o);
    } else {
      const int i2 = it - N_NA; h = i2 % NAH; const int b = i2 / NAH;
      R0 = (size_t)b * TPB;
      att::attn_body<true>(Pm + R0 * LDP + C_QA + h * 128, Pm + R0 * LDP + C_KA + h * 128, Pm + R0 * LDP + C_VA + h * 128, 4, 0, att::NoMask(), C.lds, C.wave, o);
    }
    bf16_t* Ob = AO + (R0 + C.wave * 32) * DM + h * 128;
#pragma unroll
    for (int r = 0; r < 16; ++r) { const int orow = att::crow(r, hi);
#pragma unroll
      for (int d0 = 0; d0 < 4; ++d0) Ob[(size_t)orow * DM + d0 * 32 + r32] = f2bf1(o[d0][r]); }
  }
}

namespace hg {
constexpr int KS = 72;
constexpr int CS = 136;
constexpr int LDP = 4 * DM;
DEVI int chunk_of(int dir, int j) { return dir == 0 ? j : (j < NCH_CTX ? NCH_CTX - 1 - j : NCH + NCH_CTX - 1 - j); }

template <int RSB> DEVI bf16x8 frag_T(const LAS unsigned char* p0, int lane) {
  const LAS unsigned char* a = p0 + (8 * (lane >> 4) + ((lane >> 2) & 3)) * RSB + 8 * (lane & 3);
  const s16x4 lo = tr_read_p(a), hi = tr_read_p(a + 4 * RSB);
  return (bf16x8){lo[0], lo[1], lo[2], lo[3], hi[0], hi[1], hi[2], hi[3]};
}
constexpr int G2 = 4;
static_assert(NCH % G2 == 0, "chunk groups");
constexpr int KRS = 80, VRS = 272;
DEVI void phase_hg2(const Params& P, const Ctx& C) {
  CTX_IDS;
  unsigned char* ws = P.ws;
  const bf16_t* Pm = (const bf16_t*)(ws + WS_P); bf16_t* HGS = (bf16_t*)(ws + WS_HGS); const float* lbt = (const float*)(ws + WS_LB);
  LAS unsigned char* KR = C.lds;
  LAS unsigned char* VR = C.lds + G2 * 64 * KRS;
  LAS float* segt = (LAS float*)(C.lds + G2 * 64 * (KRS + VRS));
  LAS float* gv = segt + G2 * 512;
  static_assert(G2 * 64 * (KRS + VRS) + G2 * 2048 + G2 * 128 <= LDS_RING, "hg2 lds");
  const int ch = tid & 31, seg = tid >> 5, l15 = lane & 15, l4 = lane >> 4;
  constexpr int NIT = NB * HGH * 2 * 4;
  for (int it = C.vcu; it < NIT; it += C.G) {
    const int dkq = it & 3, dir = (it >> 2) & 1, h = (it >> 3) % HGH, b = it / (8 * HGH);
    const int scan = (b * HGH + h) * 2 + dir;
    const float lb = lbt[dir * NAW + h * 128 + dkq * 32 + ch];
    const bf16_t* zp = Pm + (size_t)b * TPB * LDP + (dir ? C_ZB : C_ZF) + h * 128 + dkq * 32 + ch;
    const bf16_t* vp = Pm + (size_t)b * TPB * LDP + C_IB + h * 128;
    f32x4 acc[2]; acc[0] = (f32x4){0.f, 0.f, 0.f, 0.f}; acc[1] = acc[0];
    bf16_t zr[G2][4]; bf16x8 vr[G2][2];
#define HG2_LOAD(grp) do { _Pragma("unroll") for (int g = 0; g < G2; ++g) { const int c_ = chunk_of(dir, (grp) * G2 + g); \
      _Pragma("unroll") for (int i = 0; i < 4; ++i) { const int u = 4 * seg + i, tok = dir ? 63 - u : u; zr[g][i] = zp[(size_t)(64 * c_ + tok) * LDP]; } \
      _Pragma("unroll") for (int i = 0; i < 2; ++i) { const int idx = tid + 512 * i; vr[g][i] = *(const bf16x8*)(vp + (size_t)(64 * c_ + (idx >> 4)) * LDP + 8 * (idx & 15)); } } } while (0)
    HG2_LOAD(0);
    for (int grp = 0; grp < NCH / G2; ++grp) {
      float fk[G2][4], pl[G2][4];
#pragma unroll
      for (int g = 0; g < G2; ++g) { float run = 0.f;
#pragma unroll
        for (int i = 0; i < 4; ++i) { const float z = bf1(zr[g][i]), e = __expf(-z), sg = rcp_fast(1.0f + e); const float f = lb + (1.0f - lb) * sg; fk[g][i] = (1.0f - lb) * e * sg; run += __log2f(f); pl[g][i] = run; }
        segt[(g * 16 + seg) * 32 + ch] = run; }
      __syncthreads();
#pragma unroll
      for (int g = 0; g < G2; ++g) { float off = 0.f, tot = 0.f;
#pragma unroll
        for (int s2 = 0; s2 < 16; ++s2) { const float v = segt[(g * 16 + s2) * 32 + ch]; tot += v; off += (s2 < seg) ? v : 0.f; }
#pragma unroll
        for (int i = 0; i < 4; ++i) { const int u = 4 * seg + i, tok = dir ? 63 - u : u; *(LAS bf16_t*)(KR + (g * 64 + tok) * KRS + 2 * ch) = f2bf1(fk[g][i] * exp2_fast(tot - (off + pl[g][i]))); }
        if (seg == 0) gv[g * 32 + ch] = exp2_fast(tot);
#pragma unroll
        for (int i = 0; i < 2; ++i) { const int idx = tid + 512 * i; *(LAS bf16x8*)(VR + (g * 64 + (idx >> 4)) * VRS + 16 * (idx & 15)) = vr[g][i]; } }
      if (grp + 1 < NCH / G2) HG2_LOAD(grp + 1);
      __syncthreads();
      f32x4 U[G2][2];
#pragma unroll
      for (int g = 0; g < G2; ++g) {
        bf16x8 bb[2];
#pragma unroll
        for (int ks = 0; ks < 2; ++ks) bb[ks] = frag_T<VRS>(VR + (g * 64 + 32 * ks) * VRS + 32 * C.wave, lane);
#pragma unroll
        for (int mt = 0; mt < 2; ++mt) { f32x4 u4 = (f32x4){0.f, 0.f, 0.f, 0.f};
#pragma unroll
          for (int ks = 0; ks < 2; ++ks) u4 = mfma16(frag_T<KRS>(KR + (g * 64 + 32 * ks) * KRS + 32 * mt, lane), bb[ks], u4);
          U[g][mt] = u4; } }
      const int dv = C.wave * 16 + l15;
#pragma unroll
      for (int g = 0; g < G2; ++g) { const int c = chunk_of(dir, grp * G2 + g);
#pragma unroll
        for (int mt = 0; mt < 2; ++mt) { u32x2 w; w.x = cvtpk(acc[mt][0], acc[mt][1]); w.y = cvtpk(acc[mt][2], acc[mt][3]);
          *(u32x2*)(HGS + (((size_t)scan * NCH + c) * 128 + dv) * 128 + dkq * 32 + mt * 16 + 4 * l4) = w;
          const f32x4 g4 = *(const LAS f32x4*)(gv + g * 32 + mt * 16 + 4 * l4); acc[mt] = acc[mt] * g4 + U[g][mt]; } }
    }
    __syncthreads();
#undef HG2_LOAD
  }
}

DEVI void phase_hg3(const Params& P, const Ctx& C) {
  CTX_IDS;
  unsigned char* ws = P.ws;
  const bf16_t* Pm = (const bf16_t*)(ws + WS_P); const bf16_t* HGS = (const bf16_t*)(ws + WS_HGS); const float* lbt = (const float*)(ws + WS_LB); bf16_t* AO = (bf16_t*)(ws + WS_AO);
  constexpr int SZ_T = 64 * CS * 2;
  LAS unsigned char* VR = C.lds + 6 * SZ_T;
  LAS bf16_t* AT0 = (LAS bf16_t*)(C.lds + 6 * SZ_T + 64 * VRS);
  LAS float* segt = (LAS float*)(C.lds + 6 * SZ_T + 64 * VRS + 2 * 64 * KS * 2);
  LAS float* OS = (LAS float*)(C.lds);
  static_assert(6 * SZ_T + 64 * VRS + 2 * 64 * KS * 2 + 4096 <= LDS_BYTES && 64 * 132 * 4 <= 2 * SZ_T, "hg3 lds");
  constexpr int NIT = NB * HGH * NCH;
  int it = C.bid; if (it >= NIT) return;
  bf16_t zf[16], zb[16], qr[16]; bf16x8 sf[2][4], vr[2], gr[2];
#define HG3_PRE(it_) do { const int c_ = (it_) % NCH, h_ = ((it_) / NCH) % HGH, b_ = (it_) / (NCH * HGH); const size_t R0_ = (size_t)b_ * TPB + 64 * c_; \
    const bf16_t* zp_ = Pm + (R0_ + 16 * seg) * LDP + C_ZF + h_ * 128 + ch; \
    _Pragma("unroll") for (int i = 0; i < 16; ++i) { zf[i] = zp_[(size_t)i * LDP]; zb[i] = zp_[(size_t)i * LDP + (C_ZB - C_ZF)]; qr[i] = zp_[(size_t)i * LDP + (C_QB - C_ZF)]; } \
    _Pragma("unroll") for (int i = 0; i < 2; ++i) { const int idx = tid + 512 * i; vr[i] = *(const bf16x8*)(Pm + (R0_ + (idx >> 4)) * LDP + C_IB + h_ * 128 + 8 * (idx & 15)); } } while (0)
#define HG3_PRES(it_) do { const int c_ = (it_) % NCH, h_ = ((it_) / NCH) % HGH, b_ = (it_) / (NCH * HGH); \
    _Pragma("unroll") for (int d_ = 0; d_ < 2; ++d_) { const bf16_t* Sb_ = HGS + (((size_t)((b_ * HGH + h_) * 2 + d_) * NCH + c_) * 128 + C.wave * 16 + l15) * 128 + 8 * l4; \
      _Pragma("unroll") for (int ks = 0; ks < 4; ++ks) sf[d_][ks] = *(const bf16x8*)(Sb_ + 32 * ks); } } while (0)
  { const int ch = tid & 127, seg = tid >> 7, l15 = lane & 15, l4 = lane >> 4; HG3_PRE(it); HG3_PRES(it); }
  for (;;) {
    int ln_ = lane; OPAQUE(ln_);
    const int tid = C.wave * 64 + ln_, lane = ln_, ch = tid & 127, seg = tid >> 7, l15 = lane & 15, l4 = lane >> 4;
    const int c = it % NCH, h = (it / NCH) % HGH, b = it / (NCH * HGH);
    const size_t R0 = (size_t)b * TPB + 64 * c;
    const float lbF = lbt[h * 128 + ch], lbB = lbt[NAW + h * 128 + ch];
    float kF[16], pF[16], kB[16], pB[16], qv[16]; float runF = 0.f;
#pragma unroll
    for (int i = 0; i < 16; ++i) { qv[i] = bf1(qr[i]);
      { const float z = bf1(zf[i]), e = __expf(-z), sg = rcp_fast(1.0f + e), f = lbF + (1.0f - lbF) * sg; kF[i] = (1.0f - lbF) * e * sg; runF += __log2f(f); pF[i] = runF; }
      { const float z = bf1(zb[i]), e = __expf(-z), sg = rcp_fast(1.0f + e), f = lbB + (1.0f - lbB) * sg; kB[i] = (1.0f - lbB) * e * sg; pB[i] = __log2f(f); } }
    float runB = 0.f;
#pragma unroll
    for (int i = 15; i >= 0; --i) { runB += pB[i]; pB[i] = runB; }
    segt[ch * 4 + seg] = runF; segt[512 + ch * 4 + seg] = runB;
#pragma unroll
    for (int i = 0; i < 2; ++i) { const int idx = tid + 512 * i; *(LAS bf16x8*)(VR + (idx >> 4) * VRS + 16 * (idx & 15)) = vr[i]; }
    __syncthreads();
    { const bf16_t* gp = Pm + (R0 + (tid >> 3)) * LDP + C_GB + h * 128 + (tid & 7) * 16; gr[0] = *(const bf16x8*)gp; gr[1] = *(const bf16x8*)(gp + 8); }
    { const f32x4 sF = *(const LAS f32x4*)(segt + ch * 4), sB = *(const LAS f32x4*)(segt + 512 + ch * 4);
      const float offF = (seg > 0 ? sF.x : 0.f) + (seg > 1 ? sF.y : 0.f) + (seg > 2 ? sF.z : 0.f), midF = sF.x + sF.y;
      const float offB = (seg < 3 ? sB.w : 0.f) + (seg < 2 ? sB.z : 0.f) + (seg < 1 ? sB.y : 0.f), midB = sB.z + sB.w;
      LAS bf16_t* QA = (LAS bf16_t*)(C.lds); LAS bf16_t* KA = (LAS bf16_t*)(C.lds + SZ_T); LAS bf16_t* QI = (LAS bf16_t*)(C.lds + 2 * SZ_T);
      LAS bf16_t* QA1 = (LAS bf16_t*)(C.lds + 3 * SZ_T); LAS bf16_t* KA1 = (LAS bf16_t*)(C.lds + 4 * SZ_T); LAS bf16_t* QI1 = (LAS bf16_t*)(C.lds + 5 * SZ_T);
#pragma unroll
      for (int i = 0; i < 16; ++i) { const int tok = 16 * seg + i;
        { const float cu = offF + pF[i], eq = exp2_fast(cu), em = exp2_fast(cu - midF); QI[tok * CS + ch] = f2bf1(qv[i] * eq); QA[tok * CS + ch] = f2bf1(qv[i] * em); KA[tok * CS + ch] = f2bf1(kF[i] * rcp_fast(em)); }
        { const float cu = offB + pB[i], eq = exp2_fast(cu), em = exp2_fast(cu - midB); QI1[tok * CS + ch] = f2bf1(qv[i] * eq); QA1[tok * CS + ch] = f2bf1(qv[i] * em); KA1[tok * CS + ch] = f2bf1(kB[i] * rcp_fast(em)); } } }
    __syncthreads();
    if (it + C.G < NIT) HG3_PRE(it + C.G);
#pragma unroll
    for (int d = 0; d < 2; ++d) { const LAS bf16_t* QAd = (const LAS bf16_t*)(C.lds + (3 * d) * SZ_T); const LAS bf16_t* KAd = (const LAS bf16_t*)(C.lds + (3 * d + 1) * SZ_T); LAS bf16_t* ATd = AT0 + d * 64 * KS;
      const int mt = C.wave >> 1;
#pragma unroll
      for (int q2 = 0; q2 < 2; ++q2) { const int nt = 2 * (C.wave & 1) + q2; f32x4 a4 = (f32x4){0.f, 0.f, 0.f, 0.f};
#pragma unroll
        for (int ks = 0; ks < 4; ++ks) { const bf16x8 a = *(const LAS bf16x8*)(QAd + (16 * mt + l15) * CS + 32 * ks + 8 * l4), bb = *(const LAS bf16x8*)(KAd + (16 * nt + l15) * CS + 32 * ks + 8 * l4); a4 = mfma16(a, bb, a4); }
#pragma unroll
        for (int r = 0; r < 4; ++r) { const int t = 16 * mt + 4 * l4 + r, s2 = 16 * nt + l15; const bool keep = d ? (s2 >= t) : (s2 <= t); ATd[t * KS + s2] = keep ? f2bf1(a4[r]) : (bf16_t)0; } } }
    __syncthreads();
    f32x4 acc[4];
#pragma unroll
    for (int mt = 0; mt < 4; ++mt) acc[mt] = (f32x4){0.f, 0.f, 0.f, 0.f};
    { bf16x8 vb[2];
#pragma unroll
      for (int ks = 0; ks < 2; ++ks) vb[ks] = frag_T<VRS>(VR + (32 * ks) * VRS + 32 * C.wave, lane);
#pragma unroll
      for (int d = 0; d < 2; ++d) { const LAS bf16_t* ATd = AT0 + d * 64 * KS; const LAS bf16_t* QId = (const LAS bf16_t*)(C.lds + (3 * d + 2) * SZ_T);
#pragma unroll
        for (int mt = 0; mt < 4; ++mt) {
#pragma unroll
          for (int ks = 0; ks < 2; ++ks) { const bf16x8 a = *(const LAS bf16x8*)(ATd + (16 * mt + l15) * KS + 32 * ks + 8 * l4); acc[mt] = mfma16(a, vb[ks], acc[mt]); }
#pragma unroll
          for (int ks = 0; ks < 4; ++ks) { const bf16x8 a = *(const LAS bf16x8*)(QId + (16 * mt + l15) * CS + 32 * ks + 8 * l4); acc[mt] = mfma16(a, sf[d][ks], acc[mt]); } } } }
    if (it + C.G < NIT) HG3_PRES(it + C.G);
    __syncthreads();
#pragma unroll
    for (int mt = 0; mt < 4; ++mt)
#pragma unroll
      for (int r = 0; r < 4; ++r) OS[(16 * mt + 4 * l4 + r) * 132 + C.wave * 16 + l15] = acc[mt][r];
    __syncthreads();
    { const int t = tid >> 3, part = tid & 7; const LAS float* op = OS + t * 132 + part * 16; float v[16]; float ss = 0.f;
#pragma unroll
      for (int e = 0; e < 16; ++e) { v[e] = op[e]; ss += v[e] * v[e]; }
      ss += __shfl_xor(ss, 1); ss += __shfl_xor(ss, 2); ss += __shfl_xor(ss, 4);
      const float rinv = rsq_fast(ss * (1.0f / 128.0f) + EPS);
      const float* gn = P.in[I_GNG] + part * 16;
      unsigned w[8];
#pragma unroll
      for (int e = 0; e < 8; e += 2) { w[e >> 1] = cvtpk(v[e] * rinv * gn[e] * bf1((bf16_t)gr[0][e]), v[e + 1] * rinv * gn[e + 1] * bf1((bf16_t)gr[0][e + 1]));
        w[4 + (e >> 1)] = cvtpk(v[8 + e] * rinv * gn[8 + e] * bf1((bf16_t)gr[1][e]), v[9 + e] * rinv * gn[9 + e] * bf1((bf16_t)gr[1][e + 1])); }
      bf16_t* dst = AO + (R0 + t) * DM + NAW + h * 128 + part * 16;
      *(u32x4*)dst = (u32x4){w[0], w[1], w[2], w[3]}; *(u32x4*)(dst + 8) = (u32x4){w[4], w[5], w[6], w[7]}; }
    __syncthreads();
    it += C.G; if (it >= NIT) break;
  }
#undef HG3_PRE
#undef HG3_PRES
}
}

namespace att2 {
using att::crow; using att::partialSM; using att::finishSM; using att::finishSM_noexp; using att::v_rd_base; using att::SCALE;
constexpr int SHM_K = 16384, SHM_V = 32768, OFF_V = SHM_K, OFF_Q = SHM_K + 2 * SHM_V, OFF_WS = OFF_Q + 65536, SHM_TOTAL = OFF_WS + 8 * 64 * 4;
static_assert(SHM_TOTAL <= LDS_CTLW, "att2 lds");
DEVI int v_st(int k, int c) { const int kk = (k & ~0xC) | ((k & 4) << 1) | ((k & 8) >> 1); return ((kk >> 3) * 8 + (c >> 5)) * 512 + ((kk & 7) * 32 + (c & 31)) * 2; }
constexpr int v_rd_off(int d0, int ks, int half) { return d0 * 512 + ks * 8192 + half * 4096; }
template <int D0> DEVI void pv_one(f32x16& od, const LAS unsigned char* vb, bf16x8 pa0, bf16x8 pa1, bf16x8 pa2, bf16x8 pa3) {
  const s16x4 l0 = tr_read_p(vb + v_rd_off(D0, 0, 0)), h0 = tr_read_p(vb + v_rd_off(D0, 0, 1)), l1 = tr_read_p(vb + v_rd_off(D0, 1, 0)), h1 = tr_read_p(vb + v_rd_off(D0, 1, 1));
  const s16x4 l2 = tr_read_p(vb + v_rd_off(D0, 2, 0)), h2 = tr_read_p(vb + v_rd_off(D0, 2, 1)), l3 = tr_read_p(vb + v_rd_off(D0, 3, 0)), h3 = tr_read_p(vb + v_rd_off(D0, 3, 1));
#define PK(L, H) (bf16x8){L[0], L[1], L[2], L[3], H[0], H[1], H[2], H[3]}
  od = mfma32(pa0, PK(l0, h0), od);
  od = mfma32(pa1, PK(l1, h1), od);
  od = mfma32(pa2, PK(l2, h2), od);
  od = mfma32(pa3, PK(l3, h3), od);
#undef PK
}
template <bool FIXEDREF>
DEVI void attn256_pass(const bf16_t* __restrict__ Qb, const bf16_t* __restrict__ Kh, const bf16_t* __restrict__ Vh, int NT, LAS unsigned char* lds, int wid, f32x16 (&o)[8], float mref) {
  constexpr int ld = 4 * DM;
  int lane = LANE_ID(); OPAQUE(lane);
  const int tid = wid * 64 + lane, r32 = lane & 31, hi = lane >> 5;
  LAS unsigned char* K_lds = lds; LAS unsigned char* V_lds = lds + OFF_V; LAS unsigned char* Q_lds = lds + OFF_Q + wid * 8192;
  LAS float* wsf = (LAS float*)(lds + OFF_WS) + wid * 64; LAS float* li_l = wsf; LAS float* al_l = wsf + 32;
  {
#pragma unroll
    for (int i = 0; i < 8; ++i) { const int row = 4 * i + (lane >> 4), c = lane & 15; const bf16x8 v = *(const bf16x8*)(Qb + (long)(wid * 32 + row) * ld + 8 * c); *(LAS bf16x8*)(Q_lds + KSWZ(row, 16 * c)) = v; }
  }
  float m_reg = -1e30f, l_reg = 0;
#pragma unroll
  for (int d = 0; d < 8; ++d) o[d] = f32x16{};
  const int sr = tid >> 4, sc = (tid & 15) * 8;
  const LAS unsigned char* vb0 = V_lds + v_rd_base(lane);
  bf16x8 ks0, ks1, vs0, vs1, vs2, vs3;
#define A2_SLOAD(t) do { const long r0_ = 64L * (t); ks0 = *(const bf16x8*)(Kh + (r0_ + sr) * ld + sc); ks1 = *(const bf16x8*)(Kh + (r0_ + 32 + sr) * ld + sc); \
    vs0 = *(const bf16x8*)(Vh + (r0_ + (tid >> 5)) * ld + 8 * (tid & 31)); vs1 = *(const bf16x8*)(Vh + (r0_ + 16 + (tid >> 5)) * ld + 8 * (tid & 31)); \
    vs2 = *(const bf16x8*)(Vh + (r0_ + 32 + (tid >> 5)) * ld + 8 * (tid & 31)); vs3 = *(const bf16x8*)(Vh + (r0_ + 48 + (tid >> 5)) * ld + 8 * (tid & 31)); } while (0)
#define A2_SWRITE(b) do { const int kc_ = sc * 2; *(LAS bf16x8*)(K_lds + KSWZ(sr, kc_)) = ks0; *(LAS bf16x8*)(K_lds + KSWZ(32 + sr, kc_)) = ks1; \
    LAS unsigned char* vd_ = V_lds + (b) * SHM_V; const int vr_ = tid >> 5, vc_ = 8 * (tid & 31); \
    *(LAS bf16x8*)(vd_ + v_st(vr_, vc_)) = vs0; *(LAS bf16x8*)(vd_ + v_st(16 + vr_, vc_)) = vs1; *(LAS bf16x8*)(vd_ + v_st(32 + vr_, vc_)) = vs2; *(LAS bf16x8*)(vd_ + v_st(48 + vr_, vc_)) = vs3; } while (0)
  A2_SLOAD(0); A2_SWRITE(0); if (1 < NT) A2_SLOAD(1);
  for (int t = 0; t < NT; ++t) {
    __syncthreads();
    f32x16 p0 = f32x16{}, p1 = f32x16{};
#pragma unroll
    for (int d0 = 0; d0 < 8; ++d0) { const int cb = (d0 * 16 + hi * 8) * 2;
      const bf16x8 b0 = *(const LAS bf16x8*)(K_lds + KSWZ(r32, cb)), b1 = *(const LAS bf16x8*)(K_lds + KSWZ(32 + r32, cb)), q = *(const LAS bf16x8*)(Q_lds + KSWZ(r32, cb));
      p0 = mfma32(b0, q, p0); p1 = mfma32(b1, q, p1); }
    float mn, al; bf16x8 pa0, pa1, pa2, pa3;
    if constexpr (FIXEDREF) {
      constexpr float Cc = SCALE * 1.4426950408889634f; const float mC = -mref * 1.4426950408889634f;
#pragma unroll
      for (int r = 0; r < 16; ++r) { p0[r] = exp2_fast(fmaf(p0[r], Cc, mC)); p1[r] = exp2_fast(fmaf(p1[r], Cc, mC)); }
      finishSM_noexp(p0, p1, l_reg, pa0, pa1, pa2, pa3);
    } else {
    partialSM(p0, p1, m_reg, mn, al);
    if (__any(al < 1.f)) { if (hi == 0) al_l[r32] = al; WAIT_L(0); WSYNC();
#pragma unroll
      for (int d = 0; d < 8; ++d)
#pragma unroll
        for (int r = 0; r < 16; ++r) o[d][r] *= al_l[crow(r, hi)]; }
    finishSM(p0, p1, al, l_reg, pa0, pa1, pa2, pa3);
    }
    __syncthreads();
    if (t + 1 < NT) { A2_SWRITE((t + 1) & 1); if (t + 2 < NT) A2_SLOAD(t + 2); }
    const LAS unsigned char* vb = vb0 + (t & 1) * SHM_V;
    pv_one<0>(o[0], vb, pa0, pa1, pa2, pa3); pv_one<1>(o[1], vb, pa0, pa1, pa2, pa3); pv_one<2>(o[2], vb, pa0, pa1, pa2, pa3); pv_one<3>(o[3], vb, pa0, pa1, pa2, pa3);
    pv_one<4>(o[4], vb, pa0, pa1, pa2, pa3); pv_one<5>(o[5], vb, pa0, pa1, pa2, pa3); pv_one<6>(o[6], vb, pa0, pa1, pa2, pa3); pv_one<7>(o[7], vb, pa0, pa1, pa2, pa3);
  }
  if (hi == 0) li_l[r32] = l_reg; WAIT_L(0); WSYNC();
#pragma unroll
  for (int r = 0; r < 16; ++r) { const float rl = rcp_fast(li_l[crow(r, hi)]);
#pragma unroll
    for (int d = 0; d < 8; ++d) o[d][r] *= rl; }
  __syncthreads();
#undef A2_SLOAD
#undef A2_SWRITE
}
DEVI void attn256_pass_fixed(const bf16_t* __restrict__ Qb, const bf16_t* __restrict__ Kh, const bf16_t* __restrict__ Vh, int NT, LAS unsigned char* lds, int wid, f32x16 (&o)[8], float mref) {
  constexpr int ld = 4 * DM, FK = 0, FV = 2 * SHM_K, FQ = 2 * SHM_K + 2 * SHM_V;
  static_assert(FQ + 65536 <= LDS_BYTES, "att2 fixed lds");
  int lane = LANE_ID(); OPAQUE(lane);
  const int tid = wid * 64 + lane, r32 = lane & 31, hi = lane >> 5;
  LAS unsigned char* K_lds = lds + FK; LAS unsigned char* V_lds = lds + FV; LAS unsigned char* Q_lds = lds + FQ + wid * 8192;
#pragma unroll
  for (int i = 0; i < 8; ++i) { const int row = 4 * i + (lane >> 4), c = lane & 15; const bf16x8 v = *(const bf16x8*)(Qb + (long)(wid * 32 + row) * ld + 8 * c); *(LAS bf16x8*)(Q_lds + KSWZ(row, 16 * c)) = v; }
  float l_reg = 0;
#pragma unroll
  for (int d = 0; d < 8; ++d) o[d] = f32x16{};
  const int sr = tid >> 4, sc = (tid & 15) * 8;
  const LAS unsigned char* vb0 = V_lds + v_rd_base(lane);
  bf16x8 ks0, ks1, vs0, vs1, vs2, vs3;
#define A2_SLOAD(t) do { const long r0_ = 64L * (t); ks0 = *(const bf16x8*)(Kh + (r0_ + sr) * ld + sc); ks1 = *(const bf16x8*)(Kh + (r0_ + 32 + sr) * ld + sc); \
    vs0 = *(const bf16x8*)(Vh + (r0_ + (tid >> 5)) * ld + 8 * (tid & 31)); vs1 = *(const bf16x8*)(Vh + (r0_ + 16 + (tid >> 5)) * ld + 8 * (tid & 31)); \
    vs2 = *(const bf16x8*)(Vh + (r0_ + 32 + (tid >> 5)) * ld + 8 * (tid & 31)); vs3 = *(const bf16x8*)(Vh + (r0_ + 48 + (tid >> 5)) * ld + 8 * (tid & 31)); } while (0)
#define A2_SWRITE(b) do { const int kc_ = sc * 2; LAS unsigned char* kd_ = K_lds + (b) * SHM_K; *(LAS bf16x8*)(kd_ + KSWZ(sr, kc_)) = ks0; *(LAS bf16x8*)(kd_ + KSWZ(32 + sr, kc_)) = ks1; \
    LAS unsigned char* vd_ = V_lds + (b) * SHM_V; const int vr_ = tid >> 5, vc_ = 8 * (tid & 31); \
    *(LAS bf16x8*)(vd_ + v_st(vr_, vc_)) = vs0; *(LAS bf16x8*)(vd_ + v_st(16 + vr_, vc_)) = vs1; *(LAS bf16x8*)(vd_ + v_st(32 + vr_, vc_)) = vs2; *(LAS bf16x8*)(vd_ + v_st(48 + vr_, vc_)) = vs3; } while (0)
  constexpr float Cc = SCALE * 1.4426950408889634f; const float mC = -mref * 1.4426950408889634f;
  A2_SLOAD(0); A2_SWRITE(0); if (1 < NT) A2_SLOAD(1);
  for (int t = 0; t < NT; ++t) {
    __syncthreads();
    if (t + 1 < NT) { A2_SWRITE((t + 1) & 1); if (t + 2 < NT) A2_SLOAD(t + 2); }
    const LAS unsigned char* Kb = K_lds + (t & 1) * SHM_K;
    f32x16 p0 = f32x16{}, p1 = f32x16{};
#pragma unroll
    for (int d0 = 0; d0 < 8; ++d0) { const int cb = (d0 * 16 + hi * 8) * 2;
      const bf16x8 b0 = *(const LAS bf16x8*)(Kb + KSWZ(r32, cb)), b1 = *(const LAS bf16x8*)(Kb + KSWZ(32 + r32, cb)), q = *(const LAS bf16x8*)(Q_lds + KSWZ(r32, cb));
      p0 = mfma32(b0, q, p0); p1 = mfma32(b1, q, p1); }
#pragma unroll
    for (int r = 0; r < 16; ++r) { p0[r] = exp2_fast(fmaf(p0[r], Cc, mC)); p1[r] = exp2_fast(fmaf(p1[r], Cc, mC)); }
    bf16x8 pa0, pa1, pa2, pa3;
    finishSM_noexp(p0, p1, l_reg, pa0, pa1, pa2, pa3);
    const LAS unsigned char* vb = vb0 + (t & 1) * SHM_V;
    pv_one<0>(o[0], vb, pa0, pa1, pa2, pa3); pv_one<1>(o[1], vb, pa0, pa1, pa2, pa3); pv_one<2>(o[2], vb, pa0, pa1, pa2, pa3); pv_one<3>(o[3], vb, pa0, pa1, pa2, pa3);
    pv_one<4>(o[4], vb, pa0, pa1, pa2, pa3); pv_one<5>(o[5], vb, pa0, pa1, pa2, pa3); pv_one<6>(o[6], vb, pa0, pa1, pa2, pa3); pv_one<7>(o[7], vb, pa0, pa1, pa2, pa3);
  }
  __syncthreads();
  LAS float* li_l = (LAS float*)(lds + FK) + wid * 32;
  if (hi == 0) li_l[r32] = l_reg; WAIT_L(0); WSYNC();
#pragma unroll
  for (int r = 0; r < 16; ++r) { const float rl = rcp_fast(li_l[crow(r, hi)]);
#pragma unroll
    for (int d = 0; d < 8; ++d) o[d][r] *= rl; }
  __syncthreads();
#undef A2_SLOAD
#undef A2_SWRITE
}
}

DEVI void phase_diffattn(const Params& P, const Ctx& C) {
  unsigned char* ws = P.ws;
  const bf16_t* Pm = (const bf16_t*)(ws + WS_P); bf16_t* AO = (bf16_t*)(ws + WS_AO);
  constexpr int LDP = 4 * DM, NQB = SEQ / 256, NIT = NB * DIFFH * NQB;
  const float lam = ((const float*)(ws + WS_MISC))[0];
  const float mref = ((const float*)(ws + WS_MISC))[1]; const bool fixedref = mref < 40.f;
  for (int it = C.vcu; it < NIT; it += C.G) {
    const int qb = it % NQB, h = (it / NQB) % DIFFH, b = it / (NQB * DIFFH);
    const size_t R0 = (size_t)b * TPB + CTX + 256 * qb, RB = (size_t)b * TPB;
    const bf16_t* Vp = Pm + RB * LDP + 2 * DM + h * 256;
    f32x16 o[8];
    if (fixedref) att2::attn256_pass_fixed(Pm + R0 * LDP + (h * 2 + 1) * 128, Pm + RB * LDP + DM + (h * 2 + 1) * 128, Vp, TPB / 64, C.lds, C.wave, o, mref);
    else att2::attn256_pass<false>(Pm + R0 * LDP + (h * 2 + 1) * 128, Pm + RB * LDP + DM + (h * 2 + 1) * 128, Vp, TPB / 64, C.lds, C.wave, o, mref);
    int ln = LANE_ID(); OPAQUE(ln);
    f32x4* stash = (f32x4*)(ws + WS_STASH) + ((size_t)C.bid * NTHR + C.wave * 64 + ln) * 32;
#pragma unroll
    for (int d = 0; d < 8; ++d)
#pragma unroll
      for (int q4 = 0; q4 < 4; ++q4) stash[d * 4 + q4] = (f32x4){o[d][4 * q4], o[d][4 * q4 + 1], o[d][4 * q4 + 2], o[d][4 * q4 + 3]} * lam;
    if (fixedref) att2::attn256_pass_fixed(Pm + R0 * LDP + (h * 2) * 128, Pm + RB * LDP + DM + (h * 2) * 128, Vp, TPB / 64, C.lds, C.wave, o, mref);
    else att2::attn256_pass<false>(Pm + R0 * LDP + (h * 2) * 128, Pm + RB * LDP + DM + (h * 2) * 128, Vp, TPB / 64, C.lds, C.wave, o, mref);
    OPAQUE(ln); stash = (f32x4*)(ws + WS_STASH) + ((size_t)C.bid * NTHR + C.wave * 64 + ln) * 32;
    const int r32 = ln & 31, hi = ln >> 5;
#pragma unroll
    for (int d = 0; d < 8; ++d)
#pragma unroll
      for (int q4 = 0; q4 < 4; ++q4) { const f32x4 t = stash[d * 4 + q4]; o[d][4 * q4] -= t.x; o[d][4 * q4 + 1] -= t.y; o[d][4 * q4 + 2] -= t.z; o[d][4 * q4 + 3] -= t.w; }
    const float* sg = P.in[I_SUBG];
    bf16_t* Ob = AO + (R0 + C.wave * 32) * DM + h * 256;
#pragma unroll
    for (int r = 0; r < 16; ++r) {
      float v = 0.f;
#pragma unroll
      for (int d = 0; d < 8; ++d) v += o[d][r] * o[d][r];
      v += SHFL_XOR_LN(v, 1, ln); v += SHFL_XOR_LN(v, 2, ln); v += SHFL_XOR_LN(v, 4, ln); v += SHFL_XOR_LN(v, 8, ln); v += SHFL_XOR_LN(v, 16, ln);
      const float rinv = (1.0f - LAM_INIT) * rsq_fast(v * (1.0f / 256.0f) + EPS); const int orow = att::crow(r, hi);
#pragma unroll
      for (int d = 0; d < 8; ++d) { const int col = 32 * d + r32; Ob[(size_t)orow * DM + col] = f2bf1(o[d][r] * rinv * sg[col]); } }
  }
}

__global__ void __launch_bounds__(NTHR, 1) fwd_kernel(Params P) {
  SMEM_DECL;
  cg::grid_group grid = cg::this_grid();
  Ctx C; C.lds = (LAS unsigned char*)smem_raw; C.wave = RFL((int)threadIdx.x >> 6); C.G = gridDim.x; C.bid = blockIdx.x; C.vcu = (C.G % 8 == 0) ? (C.bid % 8) * (C.G / 8) + C.bid / 8 : C.bid;
  XcdBarrier xb = xcd_barrier_post((unsigned*)(P.ws + WS_CTL), C.wave);
  if (P.ph_lo < 0) grid.sync();
  int ph = 0;
#ifndef PROBE_REP
#define PROBE_REP 1
#endif
#ifndef PROBE_DUP
#define PROBE_DUP -1
#endif
  float* xdst = (float*)(P.ws + WS_XRES);
#define PHASE(...) do { if (ph >= P.ph_lo && ph < P.ph_hi) { \
    if (ph == PROBE_DUP) { xdst = (float*)(P.ws + WS_STASH); __VA_ARGS__; xcd_barrier(xb); if (PROBE_REP >= 2) { __VA_ARGS__; xcd_barrier(xb); } if (PROBE_REP >= 3) { __VA_ARGS__; xcd_barrier(xb); } xdst = (float*)(P.ws + WS_XRES); } \
    __VA_ARGS__; if (ph + 1 < P.ph_hi) xcd_barrier(xb); } ++ph; } while (0)
  PHASE(phase_prep(P, C));
  PHASE((phase_norm<true, false>(P, C, 0, 0, P.in[I_NMIXG])));
  unsigned char* ws = P.ws;
  const float* misc = (const float*)(ws + WS_MISC);
  const float* rcos = (const float*)(ws + WS_ROPE); const float* rsin = rcos + (size_t)SEQ * 64;
  LAS float* xch = (LAS float*)(C.lds + LDS_X);
  float* slab = (float*)(ws + WS_STASH); unsigned* cntb = (unsigned*)(ws + WS_CNT); unsigned* cnt0 = cntb + 2048 * 1; unsigned* cnt1 = cntb + 2048 * 3;
  PHASE({ pg8::Gemm g{(const bf16_t*)(ws + WS_XN), (const bf16_t*)(ws + WS_WT_EVIN), DM}; pg8::Order S; S.init(MTOK / 256, EVEN_IN / 256, C.G, C.bid, false, DM / 64);
          pg8::EpiProj<0> E{(bf16_t*)(ws + WS_P), 4 * DM, misc + 64, misc + 64 + 128, rcos, rsin, xch, slab, cntb + 0}; pg8::gemm_phase(C.lds, C.wave, g, S, E); pg8::combine_proj(S, E, C.wave); });
  PHASE({ hg::phase_hg2(P, C); phase_attn0(P, C); });
  PHASE(hg::phase_hg3(P, C));
  const float* mods0 = (const float*)(ws + WS_MODS); const float* mods1 = mods0 + (size_t)(NB + 1) * 6 * DM;
  float* xres = (float*)(ws + WS_XRES);
  PHASE({ pg8::Gemm g{(const bf16_t*)(ws + WS_AO), (const bf16_t*)(ws + WS_WT_EVOUT), DM}; pg8::Order S; S.init(NB * (TILES_PB - 1), DM / 256, C.G, C.bid, true, DM / 64, pg8::KSPLIT, 0, DM / 256);
          pg8::EpiResid E{xres, xdst, mods0 + 2 * DM, nullptr, slab, cnt0, P.in[I_X], P.in[I_CTX]}; pg8::gemm_phase(C.lds, C.wave, g, S, E); pg8::combine_slices(S, E, C.wave); });
  PHASE((phase_norm<false, false>(P, C, 0, 3, P.in[I_NMLPG])));
  PHASE({ pg8::Gemm g{(const bf16_t*)(ws + WS_XN), (const bf16_t*)(ws + WS_WT_W1), DM}; pg8::Order S; S.init(MTOK / 256, DFF / 256, C.G, C.bid, false, DM / 64);
          pg8::EpiProj<2> E{(bf16_t*)(ws + WS_P), 4 * DM, nullptr, nullptr, nullptr, nullptr, xch, slab, cntb + 2048 * 2}; pg8::gemm_phase(C.lds, C.wave, g, S, E); pg8::combine_proj(S, E, C.wave); });
  PHASE({ pg8::Gemm g{(const bf16_t*)(ws + WS_P), (const bf16_t*)(ws + WS_WT_W2), DFF}; pg8::Order S; S.init(NB * (TILES_PB - 1), DM / 256, C.G, C.bid, true, DFF / 64, pg8::KSPLIT, 0, DM / 256);
          pg8::EpiResid E{xres, xdst, mods0 + 5 * DM, nullptr, slab, cnt1, nullptr, nullptr}; pg8::gemm_phase(C.lds, C.wave, g, S, E); pg8::combine_slices(S, E, C.wave); });
  PHASE((phase_norm<false, false>(P, C, 1, 0, P.in[I_NMIXG] + DM)));
  PHASE({ pg8::Gemm g{(const bf16_t*)(ws + WS_XN), (const bf16_t*)(ws + WS_WT_ODIN), DM}; pg8::Order S; S.init(MTOK / 256, ODD_IN / 256, C.G, C.bid, false, DM / 64);
          pg8::EpiProj<1> E{(bf16_t*)(ws + WS_P), 4 * DM, misc + 64 + 256, misc + 64 + 384, rcos, rsin, xch, slab, cntb + 2048 * 4}; pg8::gemm_phase(C.lds, C.wave, g, S, E); pg8::combine_proj(S, E, C.wave); });
  PHASE(phase_diffattn(P, C));
  PHASE({ pg8::Gemm g{(const bf16_t*)(ws + WS_AO), (const bf16_t*)(ws + WS_WT_ODOUT), DM}; pg8::Order S; S.init(NB * (TILES_PB - 1), DM / 256, C.G, C.bid, true, DM / 64);
          pg8::EpiResid E{xres, xdst, mods1 + 2 * DM, nullptr, nullptr, nullptr, nullptr, nullptr}; pg8::gemm_phase(C.lds, C.wave, g, S, E); });
  PHASE((phase_norm<false, true>(P, C, 1, 3, P.in[I_NMLPG] + DM)));
  PHASE({ pg8::Gemm g{(const bf16_t*)(ws + WS_XN), (const bf16_t*)(ws + WS_WT_W1) + (size_t)DFF * DM, DM}; pg8::Order S; S.init(NB * (TILES_PB - 1), DFF / 256, C.G, C.bid, true, DM / 64);
          pg8::EpiProj<2> E{(bf16_t*)(ws + WS_P), 4 * DM, nullptr, nullptr, nullptr, nullptr, xch, nullptr, nullptr}; pg8::gemm_phase(C.lds, C.wave, g, S, E); });
  PHASE({ pg8::Gemm g{(const bf16_t*)(ws + WS_P), (const bf16_t*)(ws + WS_WT_W2) + (size_t)DM * DFF, DFF}; pg8::Order S; S.init(NB * (TILES_PB - 1), DM / 256, C.G, C.bid, true, DFF / 64);
          pg8::EpiResid E{xres, xdst, mods1 + 5 * DM, P.out, nullptr, nullptr, nullptr, nullptr}; pg8::gemm_phase(C.lds, C.wave, g, S, E); });
#undef PHASE
}

constexpr int N_PHASES = 16;
extern "C" void kernel_launch(void* const* d_in, const int* in_sizes, int n_in, void* d_out, int out_size, void* d_ws, size_t ws_size, hipStream_t stream) {
  static int grid_blocks = 0;
  if (grid_blocks == 0) {
    if (n_in != 23 || ws_size < WS_END) { fprintf(stderr, "kernel_launch: unexpected n_in %d or ws %zu < %zu\n", n_in, ws_size, (size_t)WS_END); grid_blocks = -1; return; }
    int dev = 0, cus = 0, per_cu = 0;
    (void)hipGetDevice(&dev); (void)hipDeviceGetAttribute(&cus, hipDeviceAttributeMultiprocessorCount, dev);
    (void)hipFuncSetAttribute((const void*)fwd_kernel, hipFuncAttributeMaxDynamicSharedMemorySize, LDS_BYTES);
    (void)hipOccupancyMaxActiveBlocksPerMultiprocessor(&per_cu, (const void*)fwd_kernel, NTHR, (size_t)LDS_BYTES);
    if (per_cu < 1) { fprintf(stderr, "kernel_launch: occupancy query says %d blocks per CU\n", per_cu); per_cu = 1; }
    grid_blocks = cus;
  }
  if (grid_blocks < 0) return;
  (void)hipMemsetAsync((char*)d_ws + WS_CTL, 0, WS_MODS, stream);
  Params p{};
  for (int i = 0; i < 23; ++i) p.in[i] = (const float*)d_in[i];
  p.out = (float*)d_out; p.ws = (unsigned char*)d_ws; p.ph_lo = 0; p.ph_hi = N_PHASES;
#ifdef EMU
  if (getenv("EMU_PH_HI")) p.ph_hi = atoi(getenv("EMU_PH_HI"));
#endif
#ifndef EMU
  void* args[] = {&p};
  hipError_t e = hipLaunchCooperativeKernel((void*)fwd_kernel, dim3(grid_blocks), dim3(NTHR), args, LDS_BYTES, stream);
  if (e != hipSuccess) fprintf(stderr, "cooperative launch failed: %s (grid %d)\n", hipGetErrorString(e), grid_blocks);
#else
  emu::launch([p]() { fwd_kernel(p); }, dim3(grid_blocks), dim3(NTHR), LDS_BYTES);
#endif
}
```

```cpp
#include <hip/hip_runtime.h>
#include <hip/hip_cooperative_groups.h>
#include <cstdio>
#include <cstdint>
#include <cmath>
namespace cg = cooperative_groups;

typedef unsigned short bf16_t;
typedef short bf16x8 __attribute__((ext_vector_type(8)));
typedef short s16x4 __attribute__((ext_vector_type(4)));
typedef float f32x2 __attribute__((ext_vector_type(2)));
typedef float f32x4 __attribute__((ext_vector_type(4)));
typedef float f32x16 __attribute__((ext_vector_type(16)));
typedef unsigned u32x2 __attribute__((ext_vector_type(2)));
typedef unsigned u32x4 __attribute__((ext_vector_type(4)));

#ifndef EMU
#define LAS __attribute__((address_space(3)))
#define SMEM_DECL extern __shared__ __attribute__((aligned(16))) unsigned char smem_raw[]
#define BAR() __builtin_amdgcn_s_barrier()
#define WAIT_V(n) asm volatile("s_waitcnt vmcnt(" #n ")" ::: "memory")
#define WAIT_L(n) asm volatile("s_waitcnt lgkmcnt(" #n ")" ::: "memory")
#define CFENCE() asm volatile("" ::: "memory")
#define SCHED() __builtin_amdgcn_sched_barrier(0)
#define SETPRIO(n) __builtin_amdgcn_s_setprio(n)
#define GLDS16(g, l) __builtin_amdgcn_global_load_lds((const unsigned*)(g), (LAS unsigned*)(l), 16, 0, 0)
#define RFL(x) __builtin_amdgcn_readfirstlane(x)
#define OPAQUE(x) asm volatile("" : "+v"(x))
#define WSYNC() __builtin_amdgcn_wave_barrier()
typedef unsigned ldsaddr_t;
#define LDSADDR(p) ((ldsaddr_t)(uintptr_t)(p))
#define AT_LD(p) __hip_atomic_load((p), __ATOMIC_RELAXED, __HIP_MEMORY_SCOPE_AGENT)
#define AT_ADD(p, v) __hip_atomic_fetch_add((p), (v), __ATOMIC_RELAXED, __HIP_MEMORY_SCOPE_AGENT)
#define FENCE_REL() __builtin_amdgcn_fence(__ATOMIC_RELEASE, "agent")
#define FENCE_ACQ() __builtin_amdgcn_fence(__ATOMIC_ACQUIRE, "agent")
#define SLEEP1() __builtin_amdgcn_s_sleep(1)
#define ST_WT16(p, v) asm volatile("global_store_dwordx4 %0, %1, off sc1\n\ts_nop 1" :: "v"(p), "v"(v) : "memory")
#define XCC_ID() ((unsigned)__builtin_amdgcn_s_getreg((3 << 11) | 20) & 0xFu)
#define LANE_ID() ((int)(__builtin_amdgcn_mbcnt_hi(~0u, __builtin_amdgcn_mbcnt_lo(~0u, 0u)) & 63u))
#define SHFL_XOR_LN(v, m, ln) __builtin_bit_cast(float, __builtin_amdgcn_ds_bpermute(((ln) ^ (m)) << 2, __builtin_bit_cast(int, (v))))
__device__ __forceinline__ f32x4 mfma16(bf16x8 a, bf16x8 b, f32x4 c) { return __builtin_amdgcn_mfma_f32_16x16x32_bf16(a, b, c, 0, 0, 0); }
__device__ __forceinline__ f32x16 mfma32(bf16x8 a, bf16x8 b, f32x16 c) { return __builtin_amdgcn_mfma_f32_32x32x16_bf16(a, b, c, 0, 0, 0); }
typedef __bf16 bf16x2_t __attribute__((ext_vector_type(2)));
__device__ __forceinline__ unsigned cvtpk(float lo, float hi) { f32x2 v = {lo, hi}; bf16x2_t b = __builtin_convertvector(v, bf16x2_t); return __builtin_bit_cast(unsigned, b); }
template <int OFF> __device__ __forceinline__ s16x4 tr_read(ldsaddr_t vb) { s16x4 r; asm volatile("ds_read_b64_tr_b16 %0, %1 offset:%2" : "=&v"(r) : "v"(vb), "i"(OFF) : "memory"); return r; }
typedef short v4i16_t __attribute__((ext_vector_type(4)));
__device__ __forceinline__ s16x4 tr_read_p(const LAS void* p) { return __builtin_bit_cast(s16x4, __builtin_amdgcn_ds_read_tr16_b64_v4i16((LAS v4i16_t*)p)); }
__device__ __forceinline__ void plswap(unsigned a, unsigned b, unsigned& r0, unsigned& r1) { auto rr = __builtin_amdgcn_permlane32_swap(a, b, false, false); r0 = rr[0]; r1 = rr[1]; }
__device__ __forceinline__ float exp2_fast(float x) { return __builtin_amdgcn_exp2f(x); }
__device__ __forceinline__ float rcp_fast(float x) { return __builtin_amdgcn_rcpf(x); }
__device__ __forceinline__ float rsq_fast(float x) { return __builtin_amdgcn_rsqf(x); }
#else
#define LAS
#define SMEM_DECL unsigned char* smem_raw = emu::cur->blk->smem
#define BAR() __syncthreads()
#define WAIT_V(n) do { } while (0)
#define WAIT_L(n) do { } while (0)
#define CFENCE() do { } while (0)
#define SCHED() do { } while (0)
#define SETPRIO(n) do { } while (0)
#define GLDS16(g, l) memcpy((unsigned char*)(l) + 16 * emu::cur->lane, (const void*)(g), 16)
#define RFL(x) (x)
#define OPAQUE(x) do { } while (0)
#define WSYNC() do { int z_ = 0; (void)emu::collective(&z_, 4, 20, [](unsigned char (*)[160]) {}); } while (0)
typedef uintptr_t ldsaddr_t;
#define LDSADDR(p) ((ldsaddr_t)(uintptr_t)(p))
#define AT_LD(p) (*(volatile unsigned*)(p))
static inline unsigned emu_at_add(unsigned* p, unsigned v) { unsigned o = *p; *p = o + v; return o; }
#define AT_ADD(p, v) emu_at_add((p), (v))
#define FENCE_REL() do { } while (0)
#define FENCE_ACQ() do { } while (0)
#define SLEEP1() emu::poll_yield()
#define ST_WT16(p, v) (*(f32x4*)(p) = (v))
#define XCC_ID() ((unsigned)(emu::cur->blk->bid.x & 7u))
#define LANE_ID() (emu::cur->lane)
#define SHFL_XOR_LN(v, m, ln) __shfl_xor((v), (m))
static inline float bf2f_(short s) { unsigned u = ((unsigned)(unsigned short)s) << 16; float f; memcpy(&f, &u, 4); return f; }
static inline unsigned f2bf_(float f) { unsigned u; memcpy(&u, &f, 4); if ((u & 0x7fffffffu) > 0x7f800000u) return 0x7fc0u; return (u + 0x7fffu + ((u >> 16) & 1u)) >> 16; }
static inline f32x4 mfma16(bf16x8 a, bf16x8 b, f32x4 c) {
  struct In { bf16x8 a, b; f32x4 c; } in{a, b, c};
  int p = emu::collective(&in, sizeof(in), 10, [](unsigned char (*buf)[160]) {
    static float A[16][32], B[32][16];
    for (int l = 0; l < 64; ++l) { In x; memcpy(&x, buf[l], sizeof(x)); for (int j = 0; j < 8; ++j) { A[l & 15][8 * (l >> 4) + j] = bf2f_(x.a[j]); B[8 * (l >> 4) + j][l & 15] = bf2f_(x.b[j]); } }
    for (int l = 0; l < 64; ++l) { In x; memcpy(&x, buf[l], sizeof(x)); f32x4 d;
      for (int r = 0; r < 4; ++r) { const int row = 4 * (l >> 4) + r, col = l & 15; float acc = x.c[r]; for (int k = 0; k < 32; ++k) acc += A[row][k] * B[k][col]; d[r] = acc; }
      memcpy(buf[l] + 64, &d, 16); } });
  f32x4 d; memcpy(&d, emu::cur->wave->xbuf[p][emu::cur->lane] + 64, 16); return d;
}
static inline f32x16 mfma32(bf16x8 a, bf16x8 b, f32x16 c) {
  struct In { bf16x8 a, b; f32x16 c; } in{a, b, c};
  int p = emu::collective(&in, sizeof(in), 11, [](unsigned char (*buf)[160]) {
    static float A[32][16], B[16][32];
    for (int l = 0; l < 64; ++l) { In x; memcpy(&x, buf[l], sizeof(x)); for (int j = 0; j < 8; ++j) { A[l & 31][8 * (l >> 5) + j] = bf2f_(x.a[j]); B[8 * (l >> 5) + j][l & 31] = bf2f_(x.b[j]); } }
    for (int l = 0; l < 64; ++l) { In x; memcpy(&x, buf[l], sizeof(x)); f32x16 d;
      for (int r = 0; r < 16; ++r) { const int row = (r & 3) + 8 * (r >> 2) + 4 * (l >> 5), col = l & 31; float acc = x.c[r]; for (int k = 0; k < 16; ++k) acc += A[row][k] * B[k][col]; d[r] = acc; }
      memcpy(buf[l] + 96, &d, 64); } });
  f32x16 d; memcpy(&d, emu::cur->wave->xbuf[p][emu::cur->lane] + 96, 64); return d;
}
static inline unsigned cvtpk(float lo, float hi) { return f2bf_(lo) | (f2bf_(hi) << 16); }
template <int OFF> static inline s16x4 tr_read(ldsaddr_t vb) {
  ldsaddr_t a = vb + OFF;
  if (a & 7) { fprintf(stderr, "emu: tr_read misaligned\n"); abort(); }
  int p = emu::collective(&a, sizeof(a), 12, [](unsigned char (*)[160]) {});
  const int lane = emu::cur->lane, g = lane >> 4, i = lane & 15; s16x4 r;
  for (int q = 0; q < 4; ++q) { ldsaddr_t h; memcpy(&h, emu::cur->wave->xbuf[p][16 * g + 4 * q + (i >> 2)], sizeof(h)); r[q] = *(const short*)(h + 2 * (i & 3)); }
  return r;
}
static inline s16x4 tr_read_p(const void* p) { return tr_read<0>((ldsaddr_t)(uintptr_t)p); }
static inline void plswap(unsigned a, unsigned b, unsigned& r0, unsigned& r1) {
  unsigned in[2] = {a, b};
  int p = emu::collective(in, 8, 13, [](unsigned char (*)[160]) {});
  const int lane = emu::cur->lane; unsigned o[2]; memcpy(o, emu::cur->wave->xbuf[p][lane ^ 32], 8);
  if (lane < 32) { r0 = a; r1 = o[0]; } else { r0 = o[1]; r1 = b; }
}
static inline float exp2_fast(float x) { return exp2f(x); }
static inline float rcp_fast(float x) { return 1.0f / x; }
static inline float rsq_fast(float x) { return 1.0f / sqrtf(x); }
#endif

#define DEVI __device__ __forceinline__
DEVI float silu_f(float x) { return x * rcp_fast(1.0f + __expf(-x)); }
DEVI float bflo(unsigned w) { return __builtin_bit_cast(float, w << 16); }
DEVI float bfhi(unsigned w) { return __builtin_bit_cast(float, w & 0xffff0000u); }
DEVI float bf1(bf16_t h) { return __builtin_bit_cast(float, ((unsigned)h) << 16); }
DEVI bf16_t f2bf1(float f) { return (bf16_t)(cvtpk(f, 0.f) & 0xffffu); }
DEVI float wave_sum(float v) {
#pragma unroll
  for (int o = 1; o < 64; o <<= 1) v += __shfl_xor(v, o);
  return v;
}

#ifndef CFG_D
#define CFG_D 2048
#endif
#ifndef CFG_B
#define CFG_B 4
#endif
#ifndef CFG_SEQ
#define CFG_SEQ 2048
#endif
constexpr int DM = CFG_D, NB = CFG_B, SEQ = CFG_SEQ, CTX = 256, GW = 64;
constexpr int NAH = DM / 256, HGH = DM / 256, DIFFH = DM / 256;
constexpr int NAW = DM / 2;
constexpr int EVEN_IN = 4 * DM, ODD_IN = 3 * DM, DFF = 4 * DM;
constexpr int TPB = CTX + SEQ;
constexpr int MTOK = NB * TPB, TILES_PB = TPB / 256, GROWS = SEQ / GW;
constexpr int CHUNK = 64, NCH = TPB / CHUNK, NCH_CTX = CTX / CHUNK;
constexpr float EPS = 1e-6f;
constexpr float LAM_INIT = 0.35550906759f;
constexpr int C_QA = 0, C_KA = NAW, C_VA = 2 * NAW, C_QB = 3 * NAW, C_ZF = 4 * NAW, C_ZB = 5 * NAW, C_IB = 6 * NAW, C_GB = 7 * NAW;
static_assert(SEQ % 256 == 0 && DM % 256 == 0 && GROWS >= 8, "shape");

constexpr size_t al256(size_t x) { return (x + 255) / 256 * 256; }
constexpr size_t WS_CTL = 0;
constexpr size_t WS_CNT = 16384;
constexpr size_t WS_MODS = 16384 + 5 * 2048 * 4;
constexpr size_t WS_LB = WS_MODS + al256((size_t)2 * (NB + 1) * 6 * DM * 4);
constexpr size_t WS_ROPE = WS_LB + al256((size_t)2 * NAW * 4);
constexpr size_t WS_MISC = WS_ROPE + al256((size_t)2 * SEQ * 64 * 4);
constexpr size_t WS_WT_EVIN = WS_MISC + 4096;
constexpr size_t WS_WT_EVOUT = WS_WT_EVIN + (size_t)EVEN_IN * DM * 2;
constexpr size_t WS_WT_ODIN = WS_WT_EVOUT + (size_t)DM * DM * 2;
constexpr size_t WS_WT_ODOUT = WS_WT_ODIN + (size_t)ODD_IN * DM * 2;
constexpr size_t WS_WT_W1 = WS_WT_ODOUT + (size_t)DM * DM * 2;
constexpr size_t WS_WT_W2 = WS_WT_W1 + (size_t)2 * DFF * DM * 2;
constexpr size_t WS_XRES = WS_WT_W2 + (size_t)2 * DFF * DM * 2;
constexpr size_t WS_XN = WS_XRES + (size_t)MTOK * DM * 4;
constexpr size_t WS_P = WS_XN + (size_t)MTOK * DM * 2;
constexpr size_t WS_AO = WS_P + (size_t)MTOK * 4 * DM * 2;
constexpr size_t WS_HGS = WS_AO + (size_t)MTOK * DM * 2;
constexpr size_t WS_STASH = WS_HGS + (size_t)NB * HGH * 2 * NCH * 128 * 128 * 2;
constexpr size_t WS_END = WS_STASH + (size_t)512 * 512 * 128 * 4;

constexpr int LDS_RING = 131072;
constexpr int LDS_X = LDS_RING;
constexpr int LDS_BYTES = 163840;
constexpr int LDS_CTLW = LDS_BYTES;
constexpr int NTHR = 512, NWAVE = 8;

struct Params {
  const float* in[23];
  float* out;
  unsigned char* ws;
  int ph_lo, ph_hi;
};
enum { I_X = 0, I_C, I_CTX, I_CCTX, I_ADAW, I_ADAB, I_NMIXG, I_NMLPG, I_W1, I_W2, I_EVIN, I_EVOUT, I_NAQG, I_NAKG, I_RPB, I_LBL, I_GNG, I_ODIN, I_ODOUT, I_DFQG, I_DFKG, I_DFLAM, I_SUBG };

struct Ctx {
  LAS unsigned char* lds;
  int wave, G, bid, vcu;
};
#define CTX_IDS const int lane = LANE_ID(); const int tid = C.wave * 64 + lane; (void)tid

#define XB_TMO      128
#define XB_XCNT(j)  (256  + 64 * (j))
#define XB_XSUB(j)  (1280 + 64 * (j))
#define XB_XGEN(j)  (2304 + 64 * (j))
#define XB_TOP      3328
#define XB_TOPGEN   3392
#define XCD_BAR_WORDS 3456
#define XB_SPIN_CAP (1u << 22)
#define XB_SPIN(cond, bar) do { unsigned _sp = 0; while (cond) { SLEEP1(); \
    if ((++_sp & 255u) == 0u) { if (AT_LD(&(bar)[XB_TMO])) break; if (_sp > XB_SPIN_CAP) { AT_ADD(&(bar)[XB_TMO], 1u); break; } } } } while (0)
struct XcdBarrier { unsigned* bar; unsigned x; unsigned nloc, nx; int wave; };
DEVI XcdBarrier xcd_barrier_post(unsigned* bar, int wave) {
  XcdBarrier b; b.bar = bar; b.x = XCC_ID(); b.nloc = 0u; b.nx = 0u; b.wave = wave;
  if (wave == 0 && LANE_ID() == 0) (void)AT_ADD(&bar[XB_XCNT(b.x)], 1u);
  return b;
}
DEVI void xcd_barrier_complete(unsigned* bar, unsigned x, unsigned& nloc, unsigned& nx) {
  const unsigned G = gridDim.x;
  unsigned sum, cnt, mine, sp = 0u;
  for (;;) {
    sum = 0u; cnt = 0u; mine = 0u;
#pragma unroll
    for (unsigned j = 0; j < 16; ++j) { const unsigned c = AT_LD(&bar[XB_XCNT(j)]); sum += c; cnt += (c > 0u) ? 1u : 0u; mine = (j == x) ? c : mine; }
    if (sum == G) break;
    SLEEP1();
    if ((++sp & 255u) == 0u) { if (AT_LD(&bar[XB_TMO])) break; if (sp > XB_SPIN_CAP) { AT_ADD(&bar[XB_TMO], 1u); break; } }
  }
  nloc = mine > 0u ? mine : 1u; nx = cnt > 0u ? cnt : 1u;
}
DEVI void xcd_barrier(XcdBarrier& b) {
  WAIT_V(0);
  __syncthreads();
  unsigned nloc = b.nloc, nx = b.nx;
  if (b.wave == 0 && LANE_ID() == 0) {
    unsigned* bar = b.bar;
    if (nloc == 0u) xcd_barrier_complete(bar, b.x, nloc, nx);
    const unsigned old = AT_ADD(&bar[XB_XSUB(b.x)], 1u);
    const unsigned gen = old / nloc;
    if (old + 1u == (gen + 1u) * nloc) {
      FENCE_REL();
      WAIT_V(0);
      const unsigned og = AT_ADD(&bar[XB_TOP], 1u);
      const unsigned tg = og / nx;
      if (og + 1u == (tg + 1u) * nx) AT_ADD(&bar[XB_TOPGEN], 1u);
      else XB_SPIN(AT_LD(&bar[XB_TOPGEN]) == tg, bar);
      FENCE_ACQ();
      AT_ADD(&bar[XB_XGEN(b.x)], 1u);
      WAIT_V(0);
    } else {
      XB_SPIN(AT_LD(&bar[XB_XGEN(b.x)]) == gen, bar);
      FENCE_ACQ();
      WAIT_V(0);
    }
  }
  b.nloc = (unsigned)RFL((int)nloc); b.nx = (unsigned)RFL((int)nx);
  __syncthreads();
}

DEVI int pdim(int p) { const int c = p >> 3, e = p & 7; return e < 4 ? 4 * c + e : 64 + 4 * c + (e - 4); }
DEVI int ppos(int d) { return d < 64 ? 8 * (d >> 2) + (d & 3) : 8 * ((d - 64) >> 2) + 4 + (d & 3); }

struct TItem { const float* W; bf16_t* WT; int K, N, perm_cols, item; };
DEVI TItem t_resolve(const Params& P, int it) {
  unsigned char* ws = P.ws;
  constexpr int I_A = (DM / 64) * (EVEN_IN / 32), I_B = (DM / 64) * (DM / 32), I_C2 = (DM / 64) * (ODD_IN / 32), I_D = I_B, I_E = (DM / 64) * (DFF / 32), I_F = (DFF / 64) * (DM / 32);
  int r = it;
  if (r < I_A) return TItem{P.in[I_EVIN], (bf16_t*)(ws + WS_WT_EVIN), DM, EVEN_IN, 0, r}; r -= I_A;
  if (r < I_B) return TItem{P.in[I_EVOUT], (bf16_t*)(ws + WS_WT_EVOUT), DM, DM, 0, r}; r -= I_B;
  if (r < I_C2) return TItem{P.in[I_ODIN], (bf16_t*)(ws + WS_WT_ODIN), DM, ODD_IN, 2 * DM, r}; r -= I_C2;
  if (r < I_D) return TItem{P.in[I_ODOUT], (bf16_t*)(ws + WS_WT_ODOUT), DM, DM, 0, r}; r -= I_D;
  if (r < 2 * I_E) { const int l = r / I_E; return TItem{P.in[I_W1] + (size_t)l * DM * DFF, (bf16_t*)(ws + WS_WT_W1) + (size_t)l * DFF * DM, DM, DFF, 0, r % I_E}; } r -= 2 * I_E;
  { const int l = r / I_F; return TItem{P.in[I_W2] + (size_t)l * DFF * DM, (bf16_t*)(ws + WS_WT_W2) + (size_t)l * DM * DFF, DFF, DM, 0, r % I_F}; }
}
constexpr int T_NITEMS = (DM / 64) * (EVEN_IN / 32) + 2 * (DM / 64) * (DM / 32) + (DM / 64) * (ODD_IN / 32) + 2 * (DM / 64) * (DFF / 32) + 2 * (DFF / 64) * (DM / 32);
DEVI void t_load(const TItem& d, float (&tv)[32], int lane) {
  const int nblk = d.N / 32, kb = d.item / nblk, nb = d.item % nblk, k0 = 64 * kb, n0 = 32 * nb;
#pragma unroll
  for (int i = 0; i < 32; ++i) tv[i] = d.W[(size_t)(k0 + 2 * i + (lane >> 5)) * d.N + n0 + (lane & 31)];
}
DEVI void t_finish(const TItem& d, const float (&tv)[32], LAS float* scr, int lane) {
  const int nblk = d.N / 32, kb = d.item / nblk, nb = d.item % nblk, k0 = 64 * kb, n0 = 32 * nb;
#pragma unroll
  for (int i = 0; i < 32; ++i) scr[(2 * i + (lane >> 5)) * 33 + (lane & 31)] = tv[i];
  WAIT_L(0); CFENCE(); WSYNC();
  const int c = lane & 7;
#pragma unroll
  for (int j = 0; j < 4; ++j) { const int n = (lane >> 3) + 8 * j; const LAS float* s2 = scr + (8 * c) * 33 + n;
    u32x4 o; o.x = cvtpk(s2[0 * 33], s2[1 * 33]); o.y = cvtpk(s2[2 * 33], s2[3 * 33]); o.z = cvtpk(s2[4 * 33], s2[5 * 33]); o.w = cvtpk(s2[6 * 33], s2[7 * 33]);
    int nn = n0 + n; if (nn < d.perm_cols) nn = (nn & ~127) + ppos(nn & 127);
    *(u32x4*)(d.WT + (size_t)nn * d.K + k0 + 8 * c) = o; }
  WAIT_L(0); CFENCE(); WSYNC();
}

DEVI void phase_prep(const Params& P, const Ctx& C) {
  CTX_IDS;
  unsigned char* ws = P.ws;
  {
    LAS float* sv = (LAS float*)(C.lds);
    for (int i = tid; i < (NB + 1) * DM; i += NTHR) { const int bb = i / DM, k = i % DM; const float v = bb < NB ? P.in[I_C][bb * DM + k] : P.in[I_CCTX][k]; sv[i] = silu_f(v); }
    __syncthreads();
    LAS float* red = (LAS float*)(C.lds + (NB + 1) * DM * 4);
    constexpr int NCHK = 6 * DM / 32, KW = DM / NWAVE;
    const int nitems = 2 * NCHK, hw = lane >> 5, l31 = lane & 31;
    for (int it = C.bid; it < nitems; it += C.G) {
      const int l = it / NCHK, j0 = (it % NCHK) * 32;
      const float* w = P.in[I_ADAW] + (size_t)l * DM * 6 * DM + (size_t)(C.wave * KW + hw) * 6 * DM + j0 + l31;
      float acc[NB + 1];
#pragma unroll
      for (int bb = 0; bb <= NB; ++bb) acc[bb] = 0.f;
      for (int k = 0; k < KW; k += 64) {
        float wv[32];
#pragma unroll
        for (int u = 0; u < 32; ++u) wv[u] = w[(size_t)(k + 2 * u) * 6 * DM];
#pragma unroll
        for (int u = 0; u < 32; ++u)
#pragma unroll
          for (int bb = 0; bb <= NB; ++bb) acc[bb] += sv[bb * DM + C.wave * KW + k + 2 * u + hw] * wv[u];
      }
#pragma unroll
      for (int bb = 0; bb <= NB; ++bb) red[((C.wave * 2 + hw) * (NB + 1) + bb) * 32 + l31] = acc[bb];
      __syncthreads();
      if (tid < (NB + 1) * 32) { const int bb = tid / 32, ln = tid % 32; float s2 = 0.f;
#pragma unroll
        for (int w8 = 0; w8 < 2 * NWAVE; ++w8) s2 += red[(w8 * (NB + 1) + bb) * 32 + ln];
        ((float*)(ws + WS_MODS))[((size_t)l * (NB + 1) + bb) * 6 * DM + j0 + ln] = s2 + P.in[I_ADAB][(size_t)l * 6 * DM + j0 + ln]; }
      __syncthreads();
    }
  }
  {
    const int gt = C.bid * NTHR + tid, GT = C.G * NTHR;
    float* lb = (float*)(ws + WS_LB);
    for (int i = gt; i < 2 * NAW; i += GT) { const int d = i / NAW, ch = i % NAW; const float* lg = P.in[I_LBL] + (size_t)d * 3 * NAW + ch;
      const float a = lg[0], b = lg[NAW], c = lg[2 * NAW], m = fmaxf(a, fmaxf(b, c)); const float ea = expf(a - m), eb = expf(b - m), ec = expf(c - m); lb[i] = ea / (ea + eb + ec); }
    float* rc = (float*)(ws + WS_ROPE); float* rs = rc + (size_t)SEQ * 64;
    for (int i = gt; i < SEQ * 64; i += GT) { const int t = i / 64, f = i % 64; const float pos = (float)(f < 32 ? t / GW : t % GW);
      const float inv = powf(10000.0f, -(float)(f & 31) / 32.0f); const float ang = pos * inv; rc[i] = cosf(ang); rs[i] = sinf(ang); }
    float* misc = (float*)(ws + WS_MISC);
    if (gt < 128) { misc[64 + gt] = P.in[I_NAQG][gt]; misc[64 + 128 + gt] = P.in[I_NAKG][gt]; misc[64 + 256 + gt] = P.in[I_DFQG][pdim(gt)]; misc[64 + 384 + gt] = P.in[I_DFKG][pdim(gt)]; }
    if (C.bid == 0 && C.wave == 0) { const float* lp = P.in[I_DFLAM]; float s1 = 0.f, s2 = 0.f;
      for (int i = lane; i < 128; i += 64) { s1 += lp[i] * lp[128 + i]; s2 += lp[256 + i] * lp[384 + i]; }
      s1 = wave_sum(s1); s2 = wave_sum(s2); if (lane == 0) misc[0] = expf(s1) - expf(s2) + LAM_INIT; }
    if (C.bid == 0 && C.wave == 1) { float mq = 0.f, mk = 0.f;
      for (int i = lane; i < 128; i += 64) { mq = fmaxf(mq, fabsf(P.in[I_DFQG][i])); mk = fmaxf(mk, fabsf(P.in[I_DFKG][i])); }
#pragma unroll
      for (int o2 = 1; o2 < 64; o2 <<= 1) { mq = fmaxf(mq, __shfl_xor(mq, o2)); mk = fmaxf(mk, __shfl_xor(mk, o2)); }
      if (lane == 0) misc[1] = 11.3137085f * mq * mk * 1.0001f; }
  }
  {
    LAS float* scr = (LAS float*)(C.lds + C.wave * 16384);
    __syncthreads();
    const int gw = C.bid * NWAVE + C.wave, NGW = C.G * NWAVE;
    float ta[32], tb[32];
    int it = gw;
    if (it < T_NITEMS) { TItem da = t_resolve(P, it); t_load(da, ta, lane);
      for (;;) {
        const int itb = it + NGW; TItem db = da; const bool hb = itb < T_NITEMS;
        if (hb) { db = t_resolve(P, itb); t_load(db, tb, lane); }
        t_finish(da, ta, scr, lane);
        if (!hb) break;
        const int ita = itb + NGW; const bool ha = ita < T_NITEMS;
        if (ha) { da = t_resolve(P, ita); t_load(da, ta, lane); }
        t_finish(db, tb, scr, lane);
        if (!ha) break;
        it = ita;
      } }
  }
}

template <bool FIRST, bool LAT_ONLY>
DEVI void phase_norm(const Params& P, const Ctx& C, int layer, int modi, const float* g) {
  CTX_IDS;
  unsigned char* ws = P.ws;
  float* xres = (float*)(ws + WS_XRES); bf16_t* xn = (bf16_t*)(ws + WS_XN);
  const float* mods = (const float*)(ws + WS_MODS) + (size_t)layer * (NB + 1) * 6 * DM;
  const int gw = C.bid * NWAVE + C.wave, NGW = C.G * NWAVE;
  constexpr int NV = DM / 256;
  for (int R = gw; R < MTOK; R += NGW) {
    const int b = R / TPB, r = R % TPB; const bool isc = r < CTX;
    if (LAT_ONLY && isc) continue;
    const float* src = FIRST ? (isc ? P.in[I_CTX] + ((size_t)b * CTX + r) * DM : P.in[I_X] + ((size_t)b * SEQ + (r - CTX)) * DM) : xres + (size_t)R * DM;
    const float* md = mods + (size_t)(isc ? NB : b) * 6 * DM + (size_t)modi * DM;
    f32x4 v[NV]; float s = 0.f;
#pragma unroll
    for (int j = 0; j < NV; ++j) { v[j] = *(const f32x4*)(src + 256 * j + 4 * lane); s += (v[j].x * v[j].x + v[j].y * v[j].y) + (v[j].z * v[j].z + v[j].w * v[j].w); }
    const float rinv = 1.0f / sqrtf(wave_sum(s) * (1.0f / DM) + EPS);
#pragma unroll
    for (int j = 0; j < NV; ++j) { const int c0 = 256 * j + 4 * lane; const f32x4 gg = *(const f32x4*)(g + c0), sh = *(const f32x4*)(md + c0), sc = *(const f32x4*)(md + DM + c0);
      const f32x4 h = (v[j] * rinv) * gg * (sc + 1.0f) + sh; u32x2 o; o.x = cvtpk(h.x, h.y); o.y = cvtpk(h.z, h.w); *(u32x2*)(xn + (size_t)R * DM + c0) = o; }
  }
}

namespace pg8 {
constexpr int BM = 256, BK = 64, HALF = 128, HTB = HALF * BK * 2, STAGE_BYTES = 8 * HTB, NXCD = 8, WGM = 4;
static_assert(STAGE_BYTES <= LDS_RING, "ring");
DEVI int lds_byte(int r, int c) { const int st = (r >> 4) * 2 + (c >> 5), rr = r & 15, cc = c & 31, ob = rr * 64 + cc * 2; return st * 1024 + (ob ^ (((ob >> 9) & 1) << 5)); }
DEVI void stage_rc(int b, int& R, int& C) { const int st = b / 1024, sb = b % 1024, swz = sb ^ (((sb >> 9) & 1) << 5); R = (st >> 1) * 16 + swz / 64; C = (st & 1) * 32 + (swz % 64) / 2; }
DEVI int perm32(int rho) { const int n = rho >> 4, i = rho & 15; return 8 * (i >> 2) + 4 * n + (i & 3); }
struct Unit { int pm, pn, kt0, nkt, slice, tile, ks; };
struct Gemm { const bf16_t* A; const bf16_t* Bt; int K; };
constexpr int KSPLIT = (DM / 64 >= 16) ? 8 : 4;
struct Order {
  int nM, nN, nwg, G, c, nkt, nsl, ks, pn0c, nNc; bool lat_only;
  DEVI void init(int nM_, int nN_, int G_, int c_, bool lat, int nkt_, int ks_ = 0, int pn0c_ = 0, int nNc_ = 0) { nM = nM_; nN = nN_; nwg = nM * nN; G = G_; c = c_; lat_only = lat; nkt = nkt_; ks = ks_; pn0c = pn0c_; nNc = nNc_; nsl = NB * nNc_ * ks_; }
  DEVI bool next(int i, Unit& u) const {
    const long L = (long)i * G + c; if (L >= nwg + nsl) return false;
    u.ks = ks;
    if (L >= nwg) { const int j = (int)L - nwg; u.tile = j / ks; u.slice = j % ks; u.pm = (u.tile / nNc) * TILES_PB; u.pn = pn0c + u.tile % nNc; u.nkt = nkt / ks; u.kt0 = u.slice * u.nkt; return true; }
    u.kt0 = 0; u.nkt = nkt; u.slice = -1; u.tile = 0;
    int wgid = (int)L; { const int q = nwg / NXCD, r = nwg % NXCD, xcd = wgid % NXCD, off = wgid / NXCD; wgid = (xcd < r ? xcd * (q + 1) : r * (q + 1) + (xcd - r) * q) + off; }
    const int nig = WGM * nN, gid = wgid / nig, fm = gid * WGM, gsz = (nM - fm) < WGM ? (nM - fm) : WGM;
    int pm = fm + ((wgid % nig) % gsz); u.pn = (wgid % nig) / gsz;
    if (lat_only) pm = (pm / (TILES_PB - 1)) * TILES_PB + 1 + pm % (TILES_PB - 1);
    u.pm = pm; return true;
  }
};
enum { EM_RAW = 0, EM_SILU = 1, EM_RELU2 = 2, EM_HNORM = 3 };
template <int kind> struct EpiProj {
  static constexpr bool PERM = true;
  bf16_t* O; int ldc;
  const float* gq; const float* gk; const float* rcos; const float* rsin; LAS float* xch; float* slab; unsigned* cnt;
  DEVI int tile_mode(int pn, const float*& g) const {
    const int colt = pn * BM; g = gq;
    if (kind == 0) { const int seg = colt / NAW; g = seg == 1 ? gk : gq; return seg <= 1 ? EM_HNORM : (seg == 3 || seg == 7) ? EM_SILU : EM_RAW; }
    if (kind == 1) { g = colt < DM ? gq : gk; return colt < 2 * DM ? EM_HNORM : EM_RAW; }
    return EM_RELU2;
  }
  DEVI void operator()(f32x4 (&acc)[2][2][4][2], const Unit& u, int wr, int wc, int fr, int fq) const {
    OPAQUE(fr); OPAQUE(fq);
    if (u.slice >= 0) {
      float* sp = slab + (size_t)(u.tile * u.ks + u.slice) * 65536 + (((wr * 4 + wc) * 64 + fq * 16 + fr) * 4);
#pragma unroll
      for (int ai = 0; ai < 2; ++ai)
#pragma unroll
        for (int bj = 0; bj < 2; ++bj)
#pragma unroll
          for (int m = 0; m < 4; ++m)
#pragma unroll
            for (int n = 0; n < 2; ++n) { float* q_ = sp + (((ai * 2 + bj) * 4 + m) * 2 + n) * 2048; ST_WT16(q_, acc[ai][bj][m][n]); }
      WAIT_V(0); BAR(); CFENCE();
      if (wr == 0 && wc == 0 && LANE_ID() == 0) (void)AT_ADD(cnt + 16 * u.tile, 1u);
      return;
    }
    int mode = EM_RAW; const float* g = gq; bool rope = false;
    const int colt = u.pn * BM;
    if (kind == 0) { const int seg = colt / NAW; mode = seg == 0 ? EM_HNORM : seg == 1 ? EM_HNORM : (seg == 3 || seg == 7) ? EM_SILU : EM_RAW; g = seg == 1 ? gk : gq; }
    else if (kind == 1) { if (colt < 2 * DM) { mode = EM_HNORM; g = colt < DM ? gq : gk; rope = (u.pm % TILES_PB) != 0; } }
    else mode = EM_RELU2;
    bf16_t* base = O + (size_t)(u.pm * BM) * ldc + colt;
    if (mode == EM_HNORM) {
#pragma unroll
      for (int ai = 0; ai < 2; ++ai)
#pragma unroll
        for (int m = 0; m < 4; ++m)
#pragma unroll
          for (int bj = 0; bj < 2; ++bj) { const f32x4 a = acc[ai][bj][m][0], b = acc[ai][bj][m][1];
            float s = (a.x * a.x + a.y * a.y) + (a.z * a.z + a.w * a.w) + (b.x * b.x + b.y * b.y) + (b.z * b.z + b.w * b.w);
            s += __shfl_xor(s, 16); s += __shfl_xor(s, 32);
            if (fq == 0) xch[(ai * HALF + wr * 64 + m * 16 + fr) * 8 + bj * 4 + wc] = s; }
      WAIT_L(0); BAR(); CFENCE();
      const int lt0 = (u.pm % TILES_PB - 1) * 256;
#pragma unroll
      for (int ai = 0; ai < 2; ++ai)
#pragma unroll
        for (int m = 0; m < 4; ++m) { const int lr = ai * HALF + wr * 64 + m * 16 + fr;
          f32x4 cs = {1.f, 1.f, 1.f, 1.f}, sn = {0.f, 0.f, 0.f, 0.f};
          if (rope) { cs = *(const f32x4*)(rcos + (size_t)(lt0 + lr) * 64 + 16 * wc + 4 * fq); sn = *(const f32x4*)(rsin + (size_t)(lt0 + lr) * 64 + 16 * wc + 4 * fq); }
#pragma unroll
          for (int bj = 0; bj < 2; ++bj) { const f32x4 t = *(const LAS f32x4*)(xch + lr * 8 + bj * 4);
            const float rinv = rsq_fast(((t.x + t.y) + (t.z + t.w)) * (1.0f / 128.0f) + EPS);
            const f32x4 g0 = *(const f32x4*)(g + 32 * wc + 8 * fq), g1 = *(const f32x4*)(g + 32 * wc + 8 * fq + 4);
            const f32x4 x1 = acc[ai][bj][m][0] * rinv * g0, x2 = acc[ai][bj][m][1] * rinv * g1;
            const f32x4 o1 = x1 * cs - x2 * sn, o2 = x1 * sn + x2 * cs;
            u32x4 w; w.x = cvtpk(o1.x, o1.y); w.y = cvtpk(o1.z, o1.w); w.z = cvtpk(o2.x, o2.y); w.w = cvtpk(o2.z, o2.w);
            *(u32x4*)(base + (size_t)lr * ldc + bj * HALF + wc * 32 + 8 * fq) = w; } }
    } else {
#pragma unroll
      for (int ai = 0; ai < 2; ++ai)
#pragma unroll
        for (int m = 0; m < 4; ++m) { const int lr = ai * HALF + wr * 64 + m * 16 + fr;
#pragma unroll
          for (int bj = 0; bj < 2; ++bj) { f32x4 v0 = acc[ai][bj][m][0], v1 = acc[ai][bj][m][1];
            if (mode == EM_SILU) {
#pragma unroll
              for (int e = 0; e < 4; ++e) { v0[e] = silu_f(v0[e]); v1[e] = silu_f(v1[e]); } }
            else if (mode == EM_RELU2) {
#pragma unroll
              for (int e = 0; e < 4; ++e) { const float a = fmaxf(v0[e], 0.f), b = fmaxf(v1[e], 0.f); v0[e] = a * a; v1[e] = b * b; } }
            u32x4 w; w.x = cvtpk(v0.x, v0.y); w.y = cvtpk(v0.z, v0.w); w.z = cvtpk(v1.x, v1.y); w.w = cvtpk(v1.z, v1.w);
            *(u32x4*)(base + (size_t)lr * ldc + bj * HALF + wc * 32 + 8 * fq) = w; } }
    }
  }
};
struct EpiResid {
  static constexpr bool PERM = false;
  float* xres; float* xdst; const float* gate; float* fin; float* slab; unsigned* cnt; const float* in_x; const float* in_ctx;
  DEVI void operator()(f32x4 (&acc)[2][2][4][2], const Unit& u, int wr, int wc, int fr, int fq) const {
    OPAQUE(fr); OPAQUE(fq);
    if (u.slice >= 0) {
      float* sp = slab + (size_t)(u.tile * u.ks + u.slice) * 65536 + (((wr * 4 + wc) * 64 + fq * 16 + fr) * 4);
#pragma unroll
      for (int ai = 0; ai < 2; ++ai)
#pragma unroll
        for (int bj = 0; bj < 2; ++bj)
#pragma unroll
          for (int m = 0; m < 4; ++m)
#pragma unroll
            for (int n = 0; n < 2; ++n) { float* q_ = sp + (((ai * 2 + bj) * 4 + m) * 2 + n) * 2048; ST_WT16(q_, acc[ai][bj][m][n]); }
      WAIT_V(0); BAR(); CFENCE();
      if (wr == 0 && wc == 0 && LANE_ID() == 0) (void)AT_ADD(cnt + 16 * u.tile, 1u);
      return;
    }
    const int b = u.pm / TILES_PB, within = u.pm % TILES_PB; const bool isc = within == 0;
    const float* gp = gate + (size_t)(isc ? NB : b) * 6 * DM + u.pn * BM + wc * 32 + 4 * fq;
    f32x4 gv[2][2];
#pragma unroll
    for (int bj = 0; bj < 2; ++bj)
#pragma unroll
      for (int n = 0; n < 2; ++n) gv[bj][n] = *(const f32x4*)(gp + bj * HALF + n * 16);
    const size_t toff = (size_t)(u.pm * BM) * DM + u.pn * BM + wc * 32 + 4 * fq;
    const float* src = in_x ? (isc ? in_ctx + (size_t)b * CTX * DM : in_x + ((size_t)b * SEQ + (size_t)(within - 1) * 256) * DM) + u.pn * BM + wc * 32 + 4 * fq : xres + toff;
    float* dst = (fin && !isc) ? fin + ((size_t)b * SEQ + (size_t)(within - 1) * 256) * DM + u.pn * BM + wc * 32 + 4 * fq : xdst + toff;
#pragma unroll
    for (int ai = 0; ai < 2; ++ai)
#pragma unroll
      for (int m = 0; m < 4; ++m) { const size_t ro = (size_t)(ai * HALF + wr * 64 + m * 16 + fr) * DM;
#pragma unroll
        for (int bj = 0; bj < 2; ++bj)
#pragma unroll
          for (int n = 0; n < 2; ++n) { const f32x4 bs = *(const f32x4*)(src + ro + bj * HALF + n * 16); *(f32x4*)(dst + ro + bj * HALF + n * 16) = bs + gv[bj][n] * acc[ai][bj][m][n]; } }
  }
};

DEVI const float* slab_piece(const float* unit, int row, int bj, int wc, int fq, int n) {
  const int ai = row >> 7, wr = (row >> 6) & 1, m = (row >> 4) & 3, fr = row & 15;
  return unit + ((((ai * 2 + bj) * 4 + m) * 2 + n) * 512 + (wr * 4 + wc) * 64 + fq * 16 + fr) * 4;
}
DEVI void combine_slices(const Order& S, const EpiResid& E, int wid) {
  const int lane = LANE_ID(), tid = wid * 64 + lane;
  Unit u;
  for (int i = 0; S.next(i, u); ++i) {
    if (u.slice < 0) continue;
    if (wid == 0) { unsigned sp = 0; while (AT_LD(E.cnt + 16 * u.tile) < (unsigned)u.ks) { SLEEP1(); if (++sp > (1u << 24)) break; } FENCE_ACQ(); WAIT_V(0); }
    __syncthreads();
    const int RPS = 256 / u.ks;
    for (int rr = tid >> 4; rr < RPS; rr += 32) {
      const int row = RPS * u.slice + rr, col = (tid & 15) * 16;
      const float* sp = E.slab + (size_t)u.tile * u.ks * 65536;
      f32x4 a[4];
#pragma unroll
      for (int q = 0; q < 4; ++q) a[q] = (f32x4){0.f, 0.f, 0.f, 0.f};
      for (int s2 = 0; s2 < u.ks; ++s2)
#pragma unroll
        for (int q = 0; q < 4; ++q) a[q] += *(const f32x4*)slab_piece(sp + (size_t)s2 * 65536, row, col >> 7, (col >> 5) & 3, q, (col >> 4) & 1);
      const float* gp = E.gate + (size_t)NB * 6 * DM + u.pn * BM + col;
      const size_t off = (size_t)(u.pm * BM + row) * DM + u.pn * BM + col;
      const float* bs = E.in_ctx ? E.in_ctx + ((size_t)(u.pm / TILES_PB) * CTX + row) * DM + u.pn * BM + col : E.xres + off;
#pragma unroll
      for (int q = 0; q < 4; ++q) *(f32x4*)(E.xdst + off + 4 * q) = *(const f32x4*)(bs + 4 * q) + *(const f32x4*)(gp + 4 * q) * a[q];
    }
    __syncthreads();
  }
}
template <int kind>
DEVI void combine_proj(const Order& S, const EpiProj<kind>& E, int wid) {
  const int lane = LANE_ID(), tid = wid * 64 + lane;
  Unit u;
  for (int i = 0; S.next(i, u); ++i) {
    if (u.slice < 0) continue;
    if (wid == 0) { unsigned sp = 0; while (AT_LD(E.cnt + 16 * u.tile) < (unsigned)u.ks) { SLEEP1(); if (++sp > (1u << 24)) break; } FENCE_ACQ(); WAIT_V(0); }
    __syncthreads();
    const float* g; const int mode = E.tile_mode(u.pn, g);
    const int RPS = 256 / u.ks;
    for (int rr = tid >> 4; rr < RPS; rr += 32) {
      const int row = RPS * u.slice + rr, col = (tid & 15) * 16;
      const float* sp = E.slab + (size_t)u.tile * u.ks * 65536;
      f32x4 a[4];
#pragma unroll
      for (int q = 0; q < 4; ++q) a[q] = (f32x4){0.f, 0.f, 0.f, 0.f};
      for (int s2 = 0; s2 < u.ks; ++s2)
#pragma unroll
        for (int q = 0; q < 4; ++q) a[q] += *(const f32x4*)slab_piece(sp + (size_t)s2 * 65536, row, col >> 7, (col >> 5) & 3, ((col & 31) >> 3) + (q >> 1), q & 1);
      if (mode == EM_HNORM) {
        float ss = 0.f;
#pragma unroll
        for (int q = 0; q < 4; ++q) ss += (a[q].x * a[q].x + a[q].y * a[q].y) + (a[q].z * a[q].z + a[q].w * a[q].w);
        ss += __shfl_xor(ss, 1); ss += __shfl_xor(ss, 2); ss += __shfl_xor(ss, 4);
        const float rinv = rsq_fast(ss * (1.0f / 128.0f) + EPS);
#pragma unroll
        for (int q = 0; q < 4; ++q) a[q] = a[q] * rinv * *(const f32x4*)(g + (col & 127) + 4 * q);
      } else if (mode == EM_SILU) {
#pragma unroll
        for (int q = 0; q < 4; ++q)
#pragma unroll
          for (int e = 0; e < 4; ++e) a[q][e] = silu_f(a[q][e]);
      } else if (mode == EM_RELU2) {
#pragma unroll
        for (int q = 0; q < 4; ++q)
#pragma unroll
          for (int e = 0; e < 4; ++e) { const float t = fmaxf(a[q][e], 0.f); a[q][e] = t * t; }
      }
      bf16_t* dst = E.O + (size_t)(u.pm * BM + row) * E.ldc + u.pn * BM + col;
      u32x4 w0, w1; w0.x = cvtpk(a[0].x, a[0].y); w0.y = cvtpk(a[0].z, a[0].w); w0.z = cvtpk(a[1].x, a[1].y); w0.w = cvtpk(a[1].z, a[1].w);
      w1.x = cvtpk(a[2].x, a[2].y); w1.y = cvtpk(a[2].z, a[2].w); w1.z = cvtpk(a[3].x, a[3].y); w1.w = cvtpk(a[3].z, a[3].w);
      *(u32x4*)dst = w0; *(u32x4*)(dst + 8) = w1;
    }
    __syncthreads();
  }
}
template <class Epi>
DEVI void gemm_phase(LAS unsigned char* lds, int wid, const Gemm g, const Order& S, const Epi& E) {
  const int lane = LANE_ID(), tid = wid * 64 + lane, wr = wid >> 2, wc = wid & 3, fr = lane & 15, fq = lane >> 4;
  const int K = g.K;
  unsigned voffA[2], voffB[2];
#pragma unroll
  for (int i = 0; i < 2; ++i) { int R, C; stage_rc(tid * 16 + i * 8192, R, C); const int Rb = Epi::PERM ? ((R & ~31) + perm32(R & 31)) : R;
    voffA[i] = (unsigned)(R * K + C) * 2u; voffB[i] = (unsigned)(Rb * K + C) * 2u; }
  const size_t kstep = (size_t)(BK * 2);
  const size_t hstep = (size_t)HALF * K * 2;
  const size_t tstep = 2 * hstep;
  const unsigned ldsw = (unsigned)wid * 1024u;
  const int aoff = lds_byte(wr * 64 + fr, fq * 8), boff = lds_byte(wc * 32 + fr, fq * 8);
#define PG8_SA(b, h) (((b) * 2 + (h)) * HTB)
#define PG8_SB(b, h) ((4 + (b) * 2 + (h)) * HTB)
#define PG8_STAGE(bufoff, gbase, voff) do { _Pragma("unroll") for (int _i = 0; _i < 2; ++_i) \
    GLDS16((const char*)(gbase) + (voff)[_i], lds + (bufoff) + ldsw + _i * 8192); } while (0)
#define PG8_LDA(dst, b, h) do { _Pragma("unroll") for (int m = 0; m < 4; ++m) _Pragma("unroll") for (int k = 0; k < 2; ++k) dst[m][k] = *(const LAS bf16x8*)(lds + PG8_SA(b, h) + aoff + m * 2048 + k * 1024); } while (0)
#define PG8_LDB(dst, b, h) do { _Pragma("unroll") for (int n = 0; n < 2; ++n) _Pragma("unroll") for (int k = 0; k < 2; ++k) dst[n][k] = *(const LAS bf16x8*)(lds + PG8_SB(b, h) + boff + n * 2048 + k * 1024); } while (0)
#define PG8_MMA(ai, bj, At, Bt) do { SETPRIO(1); _Pragma("unroll") for (int m = 0; m < 4; ++m) _Pragma("unroll") for (int n = 0; n < 2; ++n) _Pragma("unroll") for (int k = 0; k < 2; ++k) \
    acc[ai][bj][m][n] = mfma16(Bt[n][k], At[m][k], acc[ai][bj][m][n]); SETPRIO(0); } while (0)
  Unit cur, nxt; int ui = 0;
  if (!S.next(0, cur)) return;
  f32x4 acc[2][2][4][2];
#pragma unroll
  for (int a = 0; a < 2; ++a)
#pragma unroll
    for (int b = 0; b < 2; ++b)
#pragma unroll
      for (int m = 0; m < 4; ++m)
#pragma unroll
        for (int n = 0; n < 2; ++n) acc[a][b][m][n] = (f32x4){0.f, 0.f, 0.f, 0.f};
  bf16x8 At[4][2], B0[2][2], B1[2][2];
  const char* cA = (const char*)g.A + (size_t)cur.pm * tstep + (size_t)cur.kt0 * kstep; const char* cB = (const char*)g.Bt + (size_t)cur.pn * tstep + (size_t)cur.kt0 * kstep;
  int nt = cur.nkt;
  PG8_STAGE(PG8_SB(0, 0), cB, voffB); PG8_STAGE(PG8_SB(0, 1), cB + hstep, voffB); PG8_STAGE(PG8_SA(0, 0), cA, voffA); PG8_STAGE(PG8_SA(0, 1), cA + hstep, voffA);
  if (wr == 1) BAR();
  WAIT_V(2); BAR();
  PG8_STAGE(PG8_SB(1, 0), cB + kstep, voffB); PG8_STAGE(PG8_SA(1, 0), cA + kstep, voffA); PG8_STAGE(PG8_SB(1, 1), cB + hstep + kstep, voffB);
  WAIT_V(6); BAR();
  for (;;) {
    const bool has_next = S.next(ui + 1, nxt);
    const char* nA = has_next ? (const char*)g.A + (size_t)nxt.pm * tstep + (size_t)nxt.kt0 * kstep : cA; const char* nB = has_next ? (const char*)g.Bt + (size_t)nxt.pn * tstep + (size_t)nxt.kt0 * kstep : cB;
    for (int t = 0; t < nt; t += 2) {
      const bool last = (t == nt - 2);
      const char* a1 = cA + (size_t)(t + 1) * kstep;
      const char* a2 = last ? nA : cA + (size_t)(t + 2) * kstep; const char* b2 = last ? nB : cB + (size_t)(t + 2) * kstep;
      const char* a3 = a2 + kstep; const char* b3 = b2 + kstep;
      PG8_LDB(B0, 0, 0); PG8_LDB(B1, 0, 1); SCHED(); PG8_LDA(At, 0, 0); PG8_STAGE(PG8_SA(1, 1), a1 + hstep, voffA);
      WAIT_V(8); WAIT_L(0); BAR(); PG8_MMA(0, 0, At, B0); PG8_MMA(0, 1, At, B1); BAR(); SCHED();
      PG8_LDA(At, 0, 1); PG8_STAGE(PG8_SB(0, 0), b2, voffB); PG8_STAGE(PG8_SB(0, 1), b2 + hstep, voffB); PG8_STAGE(PG8_SA(0, 0), a2, voffA);
      WAIT_V(8); WAIT_L(0); BAR(); PG8_MMA(1, 0, At, B0); PG8_MMA(1, 1, At, B1); BAR(); SCHED();
      PG8_LDB(B0, 1, 0); PG8_LDB(B1, 1, 1); SCHED(); PG8_LDA(At, 1, 0); PG8_STAGE(PG8_SA(0, 1), a2 + hstep, voffA);
      WAIT_V(8); WAIT_L(0); BAR(); PG8_MMA(0, 0, At, B0); PG8_MMA(0, 1, At, B1); BAR(); SCHED();
      PG8_LDA(At, 1, 1); PG8_STAGE(PG8_SB(1, 0), b3, voffB); PG8_STAGE(PG8_SB(1, 1), b3 + hstep, voffB); PG8_STAGE(PG8_SA(1, 0), a3, voffA);
      WAIT_V(8); WAIT_L(0); BAR(); PG8_MMA(1, 0, At, B0); PG8_MMA(1, 1, At, B1); BAR(); SCHED();
    }
    if (wr == 0) BAR();
    E(acc, cur, wr, wc, fr, fq);
    if (!has_next) break;
#pragma unroll
    for (int a = 0; a < 2; ++a)
#pragma unroll
      for (int b = 0; b < 2; ++b)
#pragma unroll
        for (int m = 0; m < 4; ++m)
#pragma unroll
          for (int n = 0; n < 2; ++n) acc[a][b][m][n] = (f32x4){0.f, 0.f, 0.f, 0.f};
    cur = nxt; cA = nA; cB = nB; ++ui; nt = cur.nkt;
    if (wr == 1) BAR();
  }
  WAIT_V(0);
  BAR();
#undef PG8_SA
#undef PG8_SB
#undef PG8_STAGE
#undef PG8_LDA
#undef PG8_LDB
#undef PG8_MMA
}
}

namespace att {
constexpr int D = 128, NW = 8, QBLK = 32, KVBLK = 64;
constexpr float SCALE = 0.088388347648318440f, THR = 8.f;
constexpr int SHM_V = KVBLK * D * 2, SHM_K = KVBLK * D * 2, SHM_ATTN = 2 * SHM_V + 2 * SHM_K + NW * 64 * 4;
#define KSWZ(row, colB) ((row) * 256 + ((colB) ^ (((row) & 15) << 4)))
DEVI int crow(int r, int hi) { return (r & 3) + 8 * (r >> 2) + 4 * hi; }
DEVI void partialSM(f32x16& p0, f32x16& p1, float& m_reg, float& mn, float& alpha) {
  constexpr float Cc = SCALE * 1.4426950408889634f;
  float pmax = p0[0];
#pragma unroll
  for (int r = 1; r < 16; ++r) pmax = fmaxf(pmax, p0[r]);
#pragma unroll
  for (int r = 0; r < 16; ++r) pmax = fmaxf(pmax, p1[r]);
  { unsigned a, b; plswap(__builtin_bit_cast(unsigned, pmax), __builtin_bit_cast(unsigned, pmax), a, b); pmax = fmaxf(__builtin_bit_cast(float, a), __builtin_bit_cast(float, b)); }
  if (__builtin_expect(__all(pmax - m_reg <= THR / SCALE), 1)) { mn = m_reg; alpha = 1.f; }
  else { mn = fmaxf(m_reg, pmax); alpha = exp2_fast((m_reg - mn) * Cc); m_reg = mn; }
  const float mnC = -mn * Cc;
#pragma unroll
  for (int r = 0; r < 16; ++r) p0[r] = fmaf(p0[r], Cc, mnC);
#pragma unroll
  for (int r = 0; r < 16; ++r) p1[r] = fmaf(p1[r], Cc, mnC);
#pragma unroll
  for (int r = 0; r < 16; ++r) p0[r] = exp2_fast(p0[r]);
}
DEVI void finishSM(f32x16& p0, f32x16& p1, float alpha, float& l_reg, bf16x8& pa0, bf16x8& pa1, bf16x8& pa2, bf16x8& pa3) {
#pragma unroll
  for (int r = 0; r < 16; ++r) p1[r] = exp2_fast(p1[r]);
  float ps = 0;
#pragma unroll
  for (int r = 0; r < 16; ++r) ps += p0[r];
#pragma unroll
  for (int r = 0; r < 16; ++r) ps += p1[r];
  { unsigned a, b; plswap(__builtin_bit_cast(unsigned, ps), __builtin_bit_cast(unsigned, ps), a, b); ps = __builtin_bit_cast(float, a) + __builtin_bit_cast(float, b); }
  l_reg = l_reg * alpha + ps;
#define PK4(P, BASE, OUT) do { unsigned a0 = cvtpk(P[BASE + 0], P[BASE + 1]), a1 = cvtpk(P[BASE + 2], P[BASE + 3]);   \
    unsigned b0 = cvtpk(P[BASE + 4], P[BASE + 5]), b1 = cvtpk(P[BASE + 6], P[BASE + 7]);                              \
    unsigned r00, r01, r10, r11; plswap(a0, b0, r00, r01); plswap(a1, b1, r10, r11); \
    u32x4 w = {r00, r10, r01, r11}; OUT = __builtin_bit_cast(bf16x8, w); } while (0)
  PK4(p0, 0, pa0); PK4(p0, 8, pa1); PK4(p1, 0, pa2); PK4(p1, 8, pa3);
#undef PK4
}
DEVI void finishSM_noexp(f32x16& p0, f32x16& p1, float& l_reg, bf16x8& pa0, bf16x8& pa1, bf16x8& pa2, bf16x8& pa3) {
  float ps = 0;
#pragma unroll
  for (int r = 0; r < 16; ++r) ps += p0[r];
#pragma unroll
  for (int r = 0; r < 16; ++r) ps += p1[r];
  { unsigned a, b; plswap(__builtin_bit_cast(unsigned, ps), __builtin_bit_cast(unsigned, ps), a, b); ps = __builtin_bit_cast(float, a) + __builtin_bit_cast(float, b); }
  l_reg += ps;
#define PK4(P, BASE, OUT) do { unsigned a0 = cvtpk(P[BASE + 0], P[BASE + 1]), a1 = cvtpk(P[BASE + 2], P[BASE + 3]);   \
    unsigned b0 = cvtpk(P[BASE + 4], P[BASE + 5]), b1 = cvtpk(P[BASE + 6], P[BASE + 7]);                              \
    unsigned r00, r01, r10, r11; plswap(a0, b0, r00, r01); plswap(a1, b1, r10, r11); \
    u32x4 w = {r00, r10, r01, r11}; OUT = __builtin_bit_cast(bf16x8, w); } while (0)
  PK4(p0, 0, pa0); PK4(p0, 8, pa1); PK4(p1, 0, pa2); PK4(p1, 8, pa3);
#undef PK4
}
template <class Mask> DEVI void qkt(f32x16& p0, f32x16& p1, const LAS unsigned char* Ks, const bf16x8* qr, int r32, int hi, const Mask& mask, int t) {
  mask.init(p0, p1, t);
  if constexpr (Mask::OPQ) OPAQUE(r32);
#pragma unroll
  for (int d0 = 0; d0 < 8; ++d0) { const int cb = (d0 * 16 + hi * 8) * 2;
    const bf16x8 b0 = *(const LAS bf16x8*)(Ks + KSWZ(r32, cb));
    const bf16x8 b1 = *(const LAS bf16x8*)(Ks + KSWZ(32 + r32, cb));
    p0 = mfma32(b0, qr[d0], p0);
    p1 = mfma32(b1, qr[d0], p1); }
}
DEVI int v_st(int k, int c) { const int kk = (k & ~0xC) | ((k & 4) << 1) | ((k & 8) >> 1); return ((kk >> 3) * 4 + (c >> 5)) * 512 + ((kk & 7) * 32 + (c & 31)) * 2; }
DEVI int v_rd_base(int lane) { return ((lane & 3) << 3) | (((lane >> 2) & 3) << 6) | (((lane >> 4) & 1) << 5) | (((lane >> 5) & 1) << 8); }
constexpr int v_rd_off(int d0, int ks, int half) { return d0 * 512 + ks * 4096 + half * 2048; }
template <int D0> DEVI void pv_one(f32x16& od, const LAS unsigned char* vb, bf16x8 pa0, bf16x8 pa1, bf16x8 pa2, bf16x8 pa3) {
  const s16x4 l0 = tr_read_p(vb + v_rd_off(D0, 0, 0)), h0 = tr_read_p(vb + v_rd_off(D0, 0, 1)), l1 = tr_read_p(vb + v_rd_off(D0, 1, 0)), h1 = tr_read_p(vb + v_rd_off(D0, 1, 1));
  const s16x4 l2 = tr_read_p(vb + v_rd_off(D0, 2, 0)), h2 = tr_read_p(vb + v_rd_off(D0, 2, 1)), l3 = tr_read_p(vb + v_rd_off(D0, 3, 0)), h3 = tr_read_p(vb + v_rd_off(D0, 3, 1));
#define PK(L, H) (bf16x8){L[0], L[1], L[2], L[3], H[0], H[1], H[2], H[3]}
  od = mfma32(pa0, PK(l0, h0), od);
  od = mfma32(pa1, PK(l1, h1), od);
  od = mfma32(pa2, PK(l2, h2), od);
  od = mfma32(pa3, PK(l3, h3), od);
#undef PK
}
DEVI void pv_d0(f32x16 (&o)[4], const LAS unsigned char* vb, bf16x8 pa0, bf16x8 pa1, bf16x8 pa2, bf16x8 pa3) {
  pv_one<0>(o[0], vb, pa0, pa1, pa2, pa3); pv_one<1>(o[1], vb, pa0, pa1, pa2, pa3); pv_one<2>(o[2], vb, pa0, pa1, pa2, pa3); pv_one<3>(o[3], vb, pa0, pa1, pa2, pa3);
}
struct NoMask { static constexpr bool OPQ = false; DEVI void init(f32x16& p0, f32x16& p1, int) const { p0 = f32x16{}; p1 = f32x16{}; } };
constexpr int NA_TABW = 128, NA_TABOFF = 48;
struct NaMask {
  static constexpr bool OPQ = true;
  const LAS float* tb0;
  int wb;
  int kr0, r0w;
  DEVI void init(f32x16& p0, f32x16& p1, int t) const {
    if (t < 4) { p0 = f32x16{}; p1 = f32x16{}; return; }
    const int kr = kr0 + t - 4;
    if (kr < r0w || kr >= r0w + 8) {
#pragma unroll
      for (int rg = 0; rg < 16; ++rg) { p0[rg] = -INFINITY; p1[rg] = -INFINITY; }
      return; }
    const LAS float* tb = tb0 + kr * NA_TABW;
#pragma unroll
    for (int rg = 0; rg < 16; ++rg) {
      const int k = (rg & 3) + 8 * (rg >> 2);
      const float b1 = tb[k], b2 = tb[k + 32];
      p0[rg] = (unsigned)(k + wb) < 16u ? b1 : -INFINITY; p1[rg] = (unsigned)(k + 32 + wb) < 16u ? b2 : -INFINITY;
      if ((rg & 3) == 3) CFENCE(); }
  }
};
template <bool DEEP, class Mask>
DEVI void attn_body(const bf16_t* __restrict__ Qb, const bf16_t* __restrict__ Kh, const bf16_t* __restrict__ Vh, int NT, int kshift, const Mask& mask, LAS unsigned char* lds, int wid, f32x16 (&o)[4]) {
  constexpr int ldq = 4 * DM, ldk = 4 * DM;
  int lane = LANE_ID(); OPAQUE(lane);
  const int tid = wid * 64 + lane, r32 = lane & 31, hi = lane >> 5;
  LAS unsigned char* V_lds = lds; LAS unsigned char* K_lds = lds + 2 * SHM_V;
  LAS float* wsf = (LAS float*)(lds + 2 * SHM_V + 2 * SHM_K) + wid * 64; LAS float* li_l = wsf; LAS float* al_l = wsf + 32;
  float m_reg = -1e30f, l_reg = 0; bf16x8 qr[8];
#pragma unroll
  for (int d = 0; d < 4; ++d) o[d] = f32x16{};
  const bf16_t* Qw = Qb + (long)(wid * QBLK + r32) * ldq + hi * 8;
#pragma unroll
  for (int d0 = 0; d0 < 8; ++d0) qr[d0] = *(const bf16x8*)(Qw + d0 * 16);
  const int sr = tid >> 4, sc = (tid & 15) * 8, vst0 = v_st(sr, sc), vst1 = v_st(32 + sr, sc);
  const LAS unsigned char* vb0 = V_lds + v_rd_base(lane);
  bf16x8 vsA0, vsA1, ksA0, ksA1, vsB0, vsB1, ksB0, ksB1;
#define ROW0(t) (64L * ((t) < 4 ? (t) : (t) + kshift))
#define SLOAD(S, t) do { const long r0_ = ROW0(t); vs##S##0 = *(const bf16x8*)(Vh + (r0_ + sr) * ldk + sc); vs##S##1 = *(const bf16x8*)(Vh + (r0_ + 32 + sr) * ldk + sc); \
    ks##S##0 = *(const bf16x8*)(Kh + (r0_ + sr) * ldk + sc); ks##S##1 = *(const bf16x8*)(Kh + (r0_ + 32 + sr) * ldk + sc); } while (0)
#define SWRITE(b, S) do { *(LAS bf16x8*)(V_lds + (b) * SHM_V + vst0) = vs##S##0; *(LAS bf16x8*)(V_lds + (b) * SHM_V + vst1) = vs##S##1; const int kc_ = sc * 2; \
    *(LAS bf16x8*)(K_lds + (b) * SHM_K + KSWZ(sr, kc_)) = ks##S##0; *(LAS bf16x8*)(K_lds + (b) * SHM_K + KSWZ(32 + sr, kc_)) = ks##S##1; } while (0)
#define SWAIT() WAIT_V(4)
#define RESC(a) do { if (__any((a) < 1.f)) { if (hi == 0) al_l[r32] = (a); WAIT_L(0); WSYNC(); \
    _Pragma("unroll") for (int d = 0; d < 4; ++d) _Pragma("unroll") for (int r = 0; r < 16; ++r) o[d][r] *= al_l[crow(r, hi)]; } } while (0)
  f32x16 pA0, pA1, pB0, pB1; float mnA, mnB, alA, alB; bf16x8 pa0, pa1, pa2, pa3;
  SLOAD(A, 0); WAIT_V(0); SWRITE(0, A); __syncthreads();
  qkt(pA0, pA1, K_lds, qr, r32, hi, mask, 0); partialSM(pA0, pA1, m_reg, mnA, alA);
  if constexpr (DEEP) { SLOAD(B, 1); if (2 < NT) SLOAD(A, 2); SWAIT(); SWRITE(1, B); } else { SLOAD(A, 1); WAIT_V(0); SWRITE(1, A); }
  __syncthreads();
  for (int j = 1; j + 1 < NT; j += 2) {
    SCHED(); qkt(pB0, pB1, K_lds + SHM_K, qr, r32, hi, mask, j);
    finishSM(pA0, pA1, alA, l_reg, pa0, pa1, pa2, pa3); SCHED();
    if constexpr (DEEP) SLOAD(B, j + 2); else SLOAD(A, j + 1);
    SCHED();
    pv_d0(o, vb0, pa0, pa1, pa2, pa3); partialSM(pB0, pB1, m_reg, mnB, alB);
    __syncthreads(); if constexpr (DEEP) SWAIT(); else WAIT_V(0);
    SWRITE(0, A);
    RESC(alB); __syncthreads();
    SCHED(); qkt(pA0, pA1, K_lds, qr, r32, hi, mask, j + 1);
    finishSM(pB0, pB1, alB, l_reg, pa0, pa1, pa2, pa3); SCHED();
    if constexpr (DEEP) { if (j + 3 < NT) SLOAD(A, j + 3); } else SLOAD(A, j + 2);
    SCHED();
    pv_d0(o, vb0 + SHM_V, pa0, pa1, pa2, pa3); partialSM(pA0, pA1, m_reg, mnA, alA);
    __syncthreads(); if constexpr (DEEP) { SWAIT(); SWRITE(1, B); } else { WAIT_V(0); SWRITE(1, A); }
    RESC(alA); __syncthreads();
  }
  SCHED(); qkt(pB0, pB1, K_lds + SHM_K, qr, r32, hi, mask, NT - 1);
  finishSM(pA0, pA1, alA, l_reg, pa0, pa1, pa2, pa3); SCHED();
  pv_d0(o, vb0, pa0, pa1, pa2, pa3); partialSM(pB0, pB1, m_reg, mnB, alB);
  __syncthreads(); RESC(alB);
  finishSM(pB0, pB1, alB, l_reg, pa0, pa1, pa2, pa3); SCHED();
  pv_d0(o, vb0 + SHM_V, pa0, pa1, pa2, pa3);
  if (hi == 0) li_l[r32] = l_reg; WAIT_L(0); WSYNC();
#pragma unroll
  for (int r = 0; r < 16; ++r) { const float rl = rcp_fast(li_l[crow(r, hi)]);
#pragma unroll
    for (int d = 0; d < 4; ++d) o[d][r] *= rl; }
  __syncthreads();
#undef ROW0
#undef SLOAD
#undef SWRITE
#undef SWAIT
#undef RESC
}
}

DEVI void phase_attn0(const Params& P, const Ctx& C) {
  CTX_IDS;
  unsigned char* ws = P.ws;
  const bf16_t* Pm = (const bf16_t*)(ws + WS_P); bf16_t* AO = (bf16_t*)(ws + WS_AO);
  constexpr int LDP = 4 * DM, NQB = SEQ / 256, N_NA = NB * NAH * NQB, N_CX = NB * NAH;
  LAS float* tab = (LAS float*)(C.lds + att::SHM_ATTN);
  const int r32 = lane & 31, hi = lane >> 5;
  for (int it0 = C.vcu; it0 < N_NA; it0 += C.G)
  for (int sub = 0; sub < 2; ++sub) {
    if (sub == 1 && (it0 % NQB) != 0) break;
    const int it = sub == 0 ? it0 : N_NA + it0 / NQB;
    f32x16 o[4]; size_t R0; int h;
    if (it < N_NA) {
      const int g = it % NQB; h = (it / NQB) % NAH; const int b = it / (NQB * NAH);
      for (int i = tid; i < 15 * att::NA_TABW; i += NTHR) { const int dr = i / att::NA_TABW, dc = i % att::NA_TABW - att::NA_TABOFF; tab[i] = (dc >= 0 && dc < 31) ? P.in[I_RPB][((size_t)h * 15 + dr) * 31 + dc] * (1.0f / att::SCALE) : 0.f; }
      __syncthreads();
      auto r0f = [](int r) { int v = r - 4; return v < 0 ? 0 : (v > GROWS - 8 ? GROWS - 8 : v); };
      int kr0 = r0f(4 * g), nrows = r0f(4 * g + 3) + 8 - kr0;
      if (nrows & 1) { if (kr0 + nrows < GROWS) ++nrows; else { --kr0; ++nrows; } }
      const int rq = 4 * g + (C.wave >> 1), qc = 32 * (C.wave & 1) + r32; int c0 = qc - 8; c0 = c0 < 0 ? 0 : (c0 > GW - 16 ? GW - 16 : c0);
      att::NaMask mk{tab + (7 - rq) * att::NA_TABW + 4 * hi - qc + 15 + att::NA_TABOFF, 4 * hi - c0, kr0, r0f(rq)};
      R0 = (size_t)b * TPB + CTX + 256 * g;
      att::attn_body<false>(Pm + R0 * LDP + C_QA + h * 128, Pm + (size_t)b * TPB * LDP + C_KA + h * 128, Pm + (size_t)b * TPB * LDP + C_VA + h * 128, 4 + nrows, kr0, mk, C.lds, C.wave, o);
    } else {
      const int i2 = it - N_NA; h = i2 % NAH; const int b = i2 / NAH;
      R0 = (size_t)b * TPB;
      att::attn_body<true>(Pm + R0 * LDP + C_QA + h * 128, Pm + R0 * LDP + C_KA + h * 128, Pm + R0 * LDP + C_VA + h * 128, 4, 0, att::NoMask(), C.lds, C.wave, o);
    }
    bf16_t* Ob = AO + (R0 + C.wave * 32) * DM + h * 128;
#pragma unroll
    for (int r = 0; r < 16; ++r) { const int orow = att::crow(r, hi);
#pragma unroll
      for (int d0 = 0; d0 < 4; ++d0) Ob[(size_t)orow * DM + d0 * 32 + r32] = f2bf1(o[d0][r]); }
  }
}

namespace hg {
constexpr int KS = 72;
constexpr int CS = 136;
constexpr int LDP = 4 * DM;
DEVI int chunk_of(int dir, int j) { return dir == 0 ? j : (j < NCH_CTX ? NCH_CTX - 1 - j : NCH + NCH_CTX - 1 - j); }

template <int RSB> DEVI bf16x8 frag_T(const LAS unsigned char* p0, int lane) {
  const LAS unsigned char* a = p0 + (8 * (lane >> 4) + ((lane >> 2) & 3)) * RSB + 8 * (lane & 3);
  const s16x4 lo = tr_read_p(a), hi = tr_read_p(a + 4 * RSB);
  return (bf16x8){lo[0], lo[1], lo[2], lo[3], hi[0], hi[1], hi[2], hi[3]};
}
constexpr int G2 = 4;
static_assert(NCH % G2 == 0, "chunk groups");
constexpr int KRS = 80, VRS = 272;
DEVI void phase_hg2(const Params& P, const Ctx& C) {
  CTX_IDS;
  unsigned char* ws = P.ws;
  const bf16_t* Pm = (const bf16_t*)(ws + WS_P); bf16_t* HGS = (bf16_t*)(ws + WS_HGS); const float* lbt = (const float*)(ws + WS_LB);
  LAS unsigned char* KR = C.lds;
  LAS unsigned char* VR = C.lds + G2 * 64 * KRS;
  LAS float* segt = (LAS float*)(C.lds + G2 * 64 * (KRS + VRS));
  LAS float* gv = segt + G2 * 512;
  static_assert(G2 * 64 * (KRS + VRS) + G2 * 2048 + G2 * 128 <= LDS_RING, "hg2 lds");
  const int ch = tid & 31, seg = tid >> 5, l15 = lane & 15, l4 = lane >> 4;
  constexpr int NIT = NB * HGH * 2 * 4;
  for (int it = C.vcu; it < NIT; it += C.G) {
    const int dkq = it & 3, dir = (it >> 2) & 1, h = (it >> 3) % HGH, b = it / (8 * HGH);
    const int scan = (b * HGH + h) * 2 + dir;
    const float lb = lbt[dir * NAW + h * 128 + dkq * 32 + ch];
    const bf16_t* zp = Pm + (size_t)b * TPB * LDP + (dir ? C_ZB : C_ZF) + h * 128 + dkq * 32 + ch;
    const bf16_t* vp = Pm + (size_t)b * TPB * LDP + C_IB + h * 128;
    f32x4 acc[2]; acc[0] = (f32x4){0.f, 0.f, 0.f, 0.f}; acc[1] = acc[0];
    bf16_t zr[G2][4]; bf16x8 vr[G2][2];
#define HG2_LOADZ(grp) do { _Pragma("unroll") for (int g = 0; g < G2; ++g) { const int c_ = chunk_of(dir, (grp) * G2 + g); \
      _Pragma("unroll") for (int i = 0; i < 4; ++i) { const int u = 4 * seg + i, tok = dir ? 63 - u : u; zr[g][i] = zp[(size_t)(64 * c_ + tok) * LDP]; } } } while (0)
#define HG2_LOADV(grp) do { _Pragma("unroll") for (int g = 0; g < G2; ++g) { const int c_ = chunk_of(dir, (grp) * G2 + g); \
      _Pragma("unroll") for (int i = 0; i < 2; ++i) { const int idx = tid + 512 * i; vr[g][i] = *(const bf16x8*)(vp + (size_t)(64 * c_ + (idx >> 4)) * LDP + 8 * (idx & 15)); } } } while (0)
    HG2_LOADZ(0); HG2_LOADV(0);
    for (int grp = 0; grp < NCH / G2; ++grp) {
      float fk[G2][4], pl[G2][4];
#pragma unroll
      for (int g = 0; g < G2; ++g) { float run = 0.f;
#pragma unroll
        for (int i = 0; i < 4; ++i) { const float z = bf1(zr[g][i]), e = __expf(-z), sg = rcp_fast(1.0f + e); const float f = lb + (1.0f - lb) * sg; fk[g][i] = (1.0f - lb) * e * sg; run += __log2f(f); pl[g][i] = run; }
        segt[(g * 16 + seg) * 32 + ch] = run; }
      const int gnx = grp + 1 < NCH / G2 ? grp + 1 : grp;
      HG2_LOADZ(gnx);
      __syncthreads();
#pragma unroll
      for (int g = 0; g < G2; ++g) { float off = 0.f, tot = 0.f;
#pragma unroll
        for (int s2 = 0; s2 < 16; ++s2) { const float v = segt[(g * 16 + s2) * 32 + ch]; tot += v; off += (s2 < seg) ? v : 0.f; }
#pragma unroll
        for (int i = 0; i < 4; ++i) { const int u = 4 * seg + i, tok = dir ? 63 - u : u; *(LAS bf16_t*)(KR + (g * 64 + tok) * KRS + 2 * ch) = f2bf1(fk[g][i] * exp2_fast(tot - (off + pl[g][i]))); }
        if (seg == 0) gv[g * 32 + ch] = exp2_fast(tot);
#pragma unroll
        for (int i = 0; i < 2; ++i) { const int idx = tid + 512 * i; *(LAS bf16x8*)(VR + (g * 64 + (idx >> 4)) * VRS + 16 * (idx & 15)) = vr[g][i]; } }
      HG2_LOADV(gnx);
      __syncthreads();
      f32x4 U[G2][2];
#pragma unroll
      for (int g = 0; g < G2; ++g) {
        bf16x8 bb[2];
#pragma unroll
        for (int ks = 0; ks < 2; ++ks) bb[ks] = frag_T<VRS>(VR + (g * 64 + 32 * ks) * VRS + 32 * C.wave, lane);
#pragma unroll
        for (int mt = 0; mt < 2; ++mt) { f32x4 u4 = (f32x4){0.f, 0.f, 0.f, 0.f};
#pragma unroll
          for (int ks = 0; ks < 2; ++ks) u4 = mfma16(frag_T<KRS>(KR + (g * 64 + 32 * ks) * KRS + 32 * mt, lane), bb[ks], u4);
          U[g][mt] = u4; } }
      const int dv = C.wave * 16 + l15;
#pragma unroll
      for (int g = 0; g < G2; ++g) { const int c = chunk_of(dir, grp * G2 + g);
#pragma unroll
        for (int mt = 0; mt < 2; ++mt) { u32x2 w; w.x = cvtpk(acc[mt][0], acc[mt][1]); w.y = cvtpk(acc[mt][2], acc[mt][3]);
          *(u32x2*)(HGS + (((size_t)scan * NCH + c) * 128 + dv) * 128 + dkq * 32 + mt * 16 + 4 * l4) = w;
          const f32x4 g4 = *(const LAS f32x4*)(gv + g * 32 + mt * 16 + 4 * l4); acc[mt] = acc[mt] * g4 + U[g][mt]; } }
    }
    __syncthreads();
#undef HG2_LOADZ
#undef HG2_LOADV
  }
}

DEVI void phase_hg3(const Params& P, const Ctx& C) {
  CTX_IDS;
  unsigned char* ws = P.ws;
  const bf16_t* Pm = (const bf16_t*)(ws + WS_P); const bf16_t* HGS = (const bf16_t*)(ws + WS_HGS); const float* lbt = (const float*)(ws + WS_LB); bf16_t* AO = (bf16_t*)(ws + WS_AO);
  constexpr int SZ_T = 64 * CS * 2;
  LAS bf16_t* QA = (LAS bf16_t*)(C.lds); LAS bf16_t* KA = (LAS bf16_t*)(C.lds + SZ_T); LAS bf16_t* QI = (LAS bf16_t*)(C.lds + 2 * SZ_T);
  LAS unsigned char* VR = C.lds + 3 * SZ_T;
  LAS bf16_t* AT = (LAS bf16_t*)(C.lds + 3 * SZ_T + 64 * VRS);
  LAS float* segt = (LAS float*)(C.lds + 3 * SZ_T + 64 * VRS + 64 * KS * 2);
  LAS float* OS = segt + 512;
  static_assert(3 * SZ_T + 64 * VRS + 64 * KS * 2 + 2048 + 64 * 132 * 4 <= LDS_RING, "hg3 lds");
  const int ch = tid & 127, seg = tid >> 7, l15 = lane & 15, l4 = lane >> 4;
  constexpr int NIT = NB * HGH * NCH;
  int it = C.bid; if (it >= NIT) return;
  bf16_t zr[16], qr[16]; bf16x8 sfn[4], vr[2], gr[2];
#define HG3_PRE(it_, dir_) do { const int c_ = (it_) % NCH, h_ = ((it_) / NCH) % HGH, b_ = (it_) / (NCH * HGH); const size_t R0_ = (size_t)b_ * TPB + 64 * c_; \
    const bf16_t* zp_ = Pm + R0_ * LDP + ((dir_) ? C_ZB : C_ZF) + h_ * 128 + ch; const bf16_t* qp_ = Pm + R0_ * LDP + C_QB + h_ * 128 + ch; \
    _Pragma("unroll") for (int i = 0; i < 16; ++i) { const int u = 16 * seg + i, tok = (dir_) ? 63 - u : u; zr[i] = zp_[(size_t)tok * LDP]; qr[i] = qp_[(size_t)tok * LDP]; } \
    const bf16_t* Sb_ = HGS + (((size_t)((b_ * HGH + h_) * 2 + (dir_)) * NCH + c_) * 128 + C.wave * 16 + l15) * 128 + 8 * l4; \
    _Pragma("unroll") for (int ks = 0; ks < 4; ++ks) sfn[ks] = *(const bf16x8*)(Sb_ + 32 * ks); } while (0)
#define HG3_PREV(it_) do { const int c_ = (it_) % NCH, h_ = ((it_) / NCH) % HGH, b_ = (it_) / (NCH * HGH); const size_t R0_ = (size_t)b_ * TPB + 64 * c_; \
    _Pragma("unroll") for (int i = 0; i < 2; ++i) { const int idx = tid + 512 * i; vr[i] = *(const bf16x8*)(Pm + (R0_ + (idx >> 4)) * LDP + C_IB + h_ * 128 + 8 * (idx & 15)); } } while (0)
  HG3_PRE(it, 0); HG3_PREV(it);
  for (;;) {
    const int c = it % NCH, h = (it / NCH) % HGH, b = it / (NCH * HGH);
    const size_t R0 = (size_t)b * TPB + 64 * c;
    f32x4 acc[4];
#pragma unroll
    for (int mt = 0; mt < 4; ++mt) acc[mt] = (f32x4){0.f, 0.f, 0.f, 0.f};
#pragma unroll
    for (int dir = 0; dir < 2; ++dir) {
      const float lb = lbt[dir * NAW + h * 128 + ch];
      float fk[16], pl[16], qv[16]; float run = 0.f;
#pragma unroll
      for (int i = 0; i < 16; ++i) { const float z = bf1(zr[i]); qv[i] = bf1(qr[i]);
        const float e = __expf(-z), sg = rcp_fast(1.0f + e), f = lb + (1.0f - lb) * sg; fk[i] = (1.0f - lb) * e * sg; run += __log2f(f); pl[i] = run; }
      bf16x8 sf[4];
#pragma unroll
      for (int ks = 0; ks < 4; ++ks) sf[ks] = sfn[ks];
      segt[ch * 4 + seg] = run;
      if (dir == 0) {
#pragma unroll
        for (int i = 0; i < 2; ++i) { const int idx = tid + 512 * i; *(LAS bf16x8*)(VR + (idx >> 4) * VRS + 16 * (idx & 15)) = vr[i]; } }
      __syncthreads();
      if (dir == 0) { HG3_PRE(it, 1);
        const bf16_t* gp = Pm + (R0 + (tid >> 3)) * LDP + C_GB + h * 128 + (tid & 7) * 16; gr[0] = *(const bf16x8*)gp; gr[1] = *(const bf16x8*)(gp + 8); }
      else if (it + C.G < NIT) { HG3_PRE(it + C.G, 0); HG3_PREV(it + C.G); }
      const f32x4 st = *(const LAS f32x4*)(segt + ch * 4);
      const float off = (seg > 0 ? st.x : 0.f) + (seg > 1 ? st.y : 0.f) + (seg > 2 ? st.z : 0.f), mid = st.x + st.y;
#pragma unroll
      for (int i = 0; i < 16; ++i) { const int u = 16 * seg + i, tok = dir ? 63 - u : u; const float cu = off + pl[i];
        QI[tok * CS + ch] = f2bf1(qv[i] * exp2_fast(cu)); QA[tok * CS + ch] = f2bf1(qv[i] * exp2_fast(cu - mid)); KA[tok * CS + ch] = f2bf1(fk[i] * exp2_fast(mid - cu)); }
      __syncthreads();
      { const int mt = C.wave >> 1;
#pragma unroll
        for (int q2 = 0; q2 < 2; ++q2) { const int nt = 2 * (C.wave & 1) + q2; f32x4 a4 = (f32x4){0.f, 0.f, 0.f, 0.f};
#pragma unroll
          for (int ks = 0; ks < 4; ++ks) { const bf16x8 a = *(const LAS bf16x8*)(QA + (16 * mt + l15) * CS + 32 * ks + 8 * l4), bb = *(const LAS bf16x8*)(KA + (16 * nt + l15) * CS + 32 * ks + 8 * l4); a4 = mfma16(a, bb, a4); }
#pragma unroll
          for (int r = 0; r < 4; ++r) { const int t = 16 * mt + 4 * l4 + r, s2 = 16 * nt + l15; const bool keep = dir ? (s2 >= t) : (s2 <= t); AT[t * KS + s2] = keep ? f2bf1(a4[r]) : (bf16_t)0; } } }
      __syncthreads();
      { bf16x8 vb[2];
#pragma unroll
        for (int ks = 0; ks < 2; ++ks) vb[ks] = frag_T<VRS>(VR + (32 * ks) * VRS + 32 * C.wave, lane);
#pragma unroll
        for (int mt = 0; mt < 4; ++mt) {
#pragma unroll
          for (int ks = 0; ks < 2; ++ks) { const bf16x8 a = *(const LAS bf16x8*)(AT + (16 * mt + l15) * KS + 32 * ks + 8 * l4); acc[mt] = mfma16(a, vb[ks], acc[mt]); }
#pragma unroll
          for (int ks = 0; ks < 4; ++ks) { const bf16x8 a = *(const LAS bf16x8*)(QI + (16 * mt + l15) * CS + 32 * ks + 8 * l4); acc[mt] = mfma16(a, sf[ks], acc[mt]); } } }
      __syncthreads();
    }
#pragma unroll
    for (int mt = 0; mt < 4; ++mt)
#pragma unroll
      for (int r = 0; r < 4; ++r) OS[(16 * mt + 4 * l4 + r) * 132 + C.wave * 16 + l15] = acc[mt][r];
    __syncthreads();
    { const int t = tid >> 3, part = tid & 7; const LAS float* op = OS + t * 132 + part * 16; float v[16]; float ss = 0.f;
#pragma unroll
      for (int e = 0; e < 16; ++e) { v[e] = op[e]; ss += v[e] * v[e]; }
      ss += __shfl_xor(ss, 1); ss += __shfl_xor(ss, 2); ss += __shfl_xor(ss, 4);
      const float rinv = rsq_fast(ss * (1.0f / 128.0f) + EPS);
      const float* gn = P.in[I_GNG] + part * 16;
      unsigned w[8];
#pragma unroll
      for (int e = 0; e < 8; e += 2) { w[e >> 1] = cvtpk(v[e] * rinv * gn[e] * bf1((bf16_t)gr[0][e]), v[e + 1] * rinv * gn[e + 1] * bf1((bf16_t)gr[0][e + 1]));
        w[4 + (e >> 1)] = cvtpk(v[8 + e] * rinv * gn[8 + e] * bf1((bf16_t)gr[1][e]), v[9 + e] * rinv * gn[9 + e] * bf1((bf16_t)gr[1][e + 1])); }
      bf16_t* dst = AO + (R0 + t) * DM + NAW + h * 128 + part * 16;
      *(u32x4*)dst = (u32x4){w[0], w[1], w[2], w[3]}; *(u32x4*)(dst + 8) = (u32x4){w[4], w[5], w[6], w[7]}; }
    __syncthreads();
    it += C.G; if (it >= NIT) break;
  }
#undef HG3_PRE
#undef HG3_PREV
}
}

namespace att2 {
using att::crow; using att::partialSM; using att::finishSM; using att::finishSM_noexp; using att::v_rd_base; using att::SCALE;
constexpr int SHM_K = 16384, SHM_V = 32768, OFF_V = SHM_K, OFF_Q = SHM_K + 2 * SHM_V, OFF_WS = OFF_Q + 65536, SHM_TOTAL = OFF_WS + 8 * 64 * 4;
static_assert(SHM_TOTAL <= LDS_CTLW, "att2 lds");
DEVI int v_st(int k, int c) { const int kk = (k & ~0xC) | ((k & 4) << 1) | ((k & 8) >> 1); return ((kk >> 3) * 8 + (c >> 5)) * 512 + ((kk & 7) * 32 + (c & 31)) * 2; }
constexpr int v_rd_off(int d0, int ks, int half) { return d0 * 512 + ks * 8192 + half * 4096; }
template <int D0> DEVI void pv_one(f32x16& od, const LAS unsigned char* vb, bf16x8 pa0, bf16x8 pa1, bf16x8 pa2, bf16x8 pa3) {
  const s16x4 l0 = tr_read_p(vb + v_rd_off(D0, 0, 0)), h0 = tr_read_p(vb + v_rd_off(D0, 0, 1)), l1 = tr_read_p(vb + v_rd_off(D0, 1, 0)), h1 = tr_read_p(vb + v_rd_off(D0, 1, 1));
  const s16x4 l2 = tr_read_p(vb + v_rd_off(D0, 2, 0)), h2 = tr_read_p(vb + v_rd_off(D0, 2, 1)), l3 = tr_read_p(vb + v_rd_off(D0, 3, 0)), h3 = tr_read_p(vb + v_rd_off(D0, 3, 1));
#define PK(L, H) (bf16x8){L[0], L[1], L[2], L[3], H[0], H[1], H[2], H[3]}
  od = mfma32(pa0, PK(l0, h0), od);
  od = mfma32(pa1, PK(l1, h1), od);
  od = mfma32(pa2, PK(l2, h2), od);
  od = mfma32(pa3, PK(l3, h3), od);
#undef PK
}
template <bool FIXEDREF>
DEVI void attn256_pass(const bf16_t* __restrict__ Qb, const bf16_t* __restrict__ Kh, const bf16_t* __restrict__ Vh, int NT, LAS unsigned char* lds, int wid, f32x16 (&o)[8], float mref) {
  constexpr int ld = 4 * DM;
  int lane = LANE_ID(); OPAQUE(lane);
  const int tid = wid * 64 + lane, r32 = lane & 31, hi = lane >> 5;
  LAS unsigned char* K_lds = lds; LAS unsigned char* V_lds = lds + OFF_V; LAS unsigned char* Q_lds = lds + OFF_Q + wid * 8192;
  LAS float* wsf = (LAS float*)(lds + OFF_WS) + wid * 64; LAS float* li_l = wsf; LAS float* al_l = wsf + 32;
  {
#pragma unroll
    for (int i = 0; i < 8; ++i) { const int row = 4 * i + (lane >> 4), c = lane & 15; const bf16x8 v = *(const bf16x8*)(Qb + (long)(wid * 32 + row) * ld + 8 * c); *(LAS bf16x8*)(Q_lds + KSWZ(row, 16 * c)) = v; }
  }
  float m_reg = -1e30f, l_reg = 0;
#pragma unroll
  for (int d = 0; d < 8; ++d) o[d] = f32x16{};
  const int sr = tid >> 4, sc = (tid & 15) * 8;
  const LAS unsigned char* vb0 = V_lds + v_rd_base(lane);
  bf16x8 ks0, ks1, vs0, vs1, vs2, vs3;
#define A2_SLOAD(t) do { const long r0_ = 64L * (t); ks0 = *(const bf16x8*)(Kh + (r0_ + sr) * ld + sc); ks1 = *(const bf16x8*)(Kh + (r0_ + 32 + sr) * ld + sc); \
    vs0 = *(const bf16x8*)(Vh + (r0_ + (tid >> 5)) * ld + 8 * (tid & 31)); vs1 = *(const bf16x8*)(Vh + (r0_ + 16 + (tid >> 5)) * ld + 8 * (tid & 31)); \
    vs2 = *(const bf16x8*)(Vh + (r0_ + 32 + (tid >> 5)) * ld + 8 * (tid & 31)); vs3 = *(const bf16x8*)(Vh + (r0_ + 48 + (tid >> 5)) * ld + 8 * (tid & 31)); } while (0)
#define A2_SWRITE(b) do { const int kc_ = sc * 2; *(LAS bf16x8*)(K_lds + KSWZ(sr, kc_)) = ks0; *(LAS bf16x8*)(K_lds + KSWZ(32 + sr, kc_)) = ks1; \
    LAS unsigned char* vd_ = V_lds + (b) * SHM_V; const int vr_ = tid >> 5, vc_ = 8 * (tid & 31); \
    *(LAS bf16x8*)(vd_ + v_st(vr_, vc_)) = vs0; *(LAS bf16x8*)(vd_ + v_st(16 + vr_, vc_)) = vs1; *(LAS bf16x8*)(vd_ + v_st(32 + vr_, vc_)) = vs2; *(LAS bf16x8*)(vd_ + v_st(48 + vr_, vc_)) = vs3; } while (0)
  A2_SLOAD(0); A2_SWRITE(0); if (1 < NT) A2_SLOAD(1);
  for (int t = 0; t < NT; ++t) {
    __syncthreads();
    f32x16 p0 = f32x16{}, p1 = f32x16{};
#pragma unroll
    for (int d0 = 0; d0 < 8; ++d0) { const int cb = (d0 * 16 + hi * 8) * 2;
      const bf16x8 b0 = *(const LAS bf16x8*)(K_lds + KSWZ(r32, cb)), b1 = *(const LAS bf16x8*)(K_lds + KSWZ(32 + r32, cb)), q = *(const LAS bf16x8*)(Q_lds + KSWZ(r32, cb));
      p0 = mfma32(b0, q, p0); p1 = mfma32(b1, q, p1); }
    float mn, al; bf16x8 pa0, pa1, pa2, pa3;
    if constexpr (FIXEDREF) {
      constexpr float Cc = SCALE * 1.4426950408889634f; const float mC = -mref * 1.4426950408889634f;
#pragma unroll
      for (int r = 0; r < 16; ++r) { p0[r] = exp2_fast(fmaf(p0[r], Cc, mC)); p1[r] = exp2_fast(fmaf(p1[r], Cc, mC)); }
      finishSM_noexp(p0, p1, l_reg, pa0, pa1, pa2, pa3);
    } else {
    partialSM(p0, p1, m_reg, mn, al);
    if (__any(al < 1.f)) { if (hi == 0) al_l[r32] = al; WAIT_L(0); WSYNC();
#pragma unroll
      for (int d = 0; d < 8; ++d)
#pragma unroll
        for (int r = 0; r < 16; ++r) o[d][r] *= al_l[crow(r, hi)]; }
    finishSM(p0, p1, al, l_reg, pa0, pa1, pa2, pa3);
    }
    __syncthreads();
    if (t + 1 < NT) { A2_SWRITE((t + 1) & 1); if (t + 2 < NT) A2_SLOAD(t + 2); }
    const LAS unsigned char* vb = vb0 + (t & 1) * SHM_V;
    pv_one<0>(o[0], vb, pa0, pa1, pa2, pa3); pv_one<1>(o[1], vb, pa0, pa1, pa2, pa3); pv_one<2>(o[2], vb, pa0, pa1, pa2, pa3); pv_one<3>(o[3], vb, pa0, pa1, pa2, pa3);
    pv_one<4>(o[4], vb, pa0, pa1, pa2, pa3); pv_one<5>(o[5], vb, pa0, pa1, pa2, pa3); pv_one<6>(o[6], vb, pa0, pa1, pa2, pa3); pv_one<7>(o[7], vb, pa0, pa1, pa2, pa3);
  }
  if (hi == 0) li_l[r32] = l_reg; WAIT_L(0); WSYNC();
#pragma unroll
  for (int r = 0; r < 16; ++r) { const float rl = rcp_fast(li_l[crow(r, hi)]);
#pragma unroll
    for (int d = 0; d < 8; ++d) o[d][r] *= rl; }
  __syncthreads();
#undef A2_SLOAD
#undef A2_SWRITE
}
DEVI void attn256_pass_fixed(const bf16_t* __restrict__ Qb, const bf16_t* __restrict__ Kh, const bf16_t* __restrict__ Vh, int NT, LAS unsigned char* lds, int wid, f32x16 (&o)[8], float mref) {
  constexpr int ld = 4 * DM, FK = 0, FV = 2 * SHM_K, FQ = 2 * SHM_K + 2 * SHM_V;
  static_assert(FQ + 65536 <= LDS_BYTES, "att2 fixed lds");
  int lane = LANE_ID(); OPAQUE(lane);
  const int tid = wid * 64 + lane, r32 = lane & 31, hi = lane >> 5;
  LAS unsigned char* K_lds = lds + FK; LAS unsigned char* V_lds = lds + FV; LAS unsigned char* Q_lds = lds + FQ + wid * 8192;
#pragma unroll
  for (int i = 0; i < 8; ++i) { const int row = 4 * i + (lane >> 4), c = lane & 15; const bf16x8 v = *(const bf16x8*)(Qb + (long)(wid * 32 + row) * ld + 8 * c); *(LAS bf16x8*)(Q_lds + KSWZ(row, 16 * c)) = v; }
  float l_reg = 0;
#pragma unroll
  for (int d = 0; d < 8; ++d) o[d] = f32x16{};
  const int sr = tid >> 4, sc = (tid & 15) * 8;
  const LAS unsigned char* vb0 = V_lds + v_rd_base(lane);
  bf16x8 ks0, ks1, vs0, vs1, vs2, vs3;
#define A2_SLOAD(t) do { const long r0_ = 64L * (t); ks0 = *(const bf16x8*)(Kh + (r0_ + sr) * ld + sc); ks1 = *(const bf16x8*)(Kh + (r0_ + 32 + sr) * ld + sc); \
    vs0 = *(const bf16x8*)(Vh + (r0_ + (tid >> 5)) * ld + 8 * (tid & 31)); vs1 = *(const bf16x8*)(Vh + (r0_ + 16 + (tid >> 5)) * ld + 8 * (tid & 31)); \
    vs2 = *(const bf16x8*)(Vh + (r0_ + 32 + (tid >> 5)) * ld + 8 * (tid & 31)); vs3 = *(const bf16x8*)(Vh + (r0_ + 48 + (tid >> 5)) * ld + 8 * (tid & 31)); } while (0)
#define A2_SWRITE(b) do { const int kc_ = sc * 2; LAS unsigned char* kd_ = K_lds + (b) * SHM_K; *(LAS bf16x8*)(kd_ + KSWZ(sr, kc_)) = ks0; *(LAS bf16x8*)(kd_ + KSWZ(32 + sr, kc_)) = ks1; \
    LAS unsigned char* vd_ = V_lds + (b) * SHM_V; const int vr_ = tid >> 5, vc_ = 8 * (tid & 31); \
    *(LAS bf16x8*)(vd_ + v_st(vr_, vc_)) = vs0; *(LAS bf16x8*)(vd_ + v_st(16 + vr_, vc_)) = vs1; *(LAS bf16x8*)(vd_ + v_st(32 + vr_, vc_)) = vs2; *(LAS bf16x8*)(vd_ + v_st(48 + vr_, vc_)) = vs3; } while (0)
  constexpr float Cc = SCALE * 1.4426950408889634f; const float mC = -mref * 1.4426950408889634f;
  A2_SLOAD(0); A2_SWRITE(0); if (1 < NT) A2_SLOAD(1);
  for (int t = 0; t < NT; ++t) {
    __syncthreads();
    if (t + 1 < NT) { A2_SWRITE((t + 1) & 1); if (t + 2 < NT) A2_SLOAD(t + 2); }
    const LAS unsigned char* Kb = K_lds + (t & 1) * SHM_K;
    f32x16 p0 = f32x16{}, p1 = f32x16{};
#pragma unroll
    for (int d0 = 0; d0 < 8; ++d0) { const int cb = (d0 * 16 + hi * 8) * 2;
      const bf16x8 b0 = *(const LAS bf16x8*)(Kb + KSWZ(r32, cb)), b1 = *(const LAS bf16x8*)(Kb + KSWZ(32 + r32, cb)), q = *(const LAS bf16x8*)(Q_lds + KSWZ(r32, cb));
      p0 = mfma32(b0, q, p0); p1 = mfma32(b1, q, p1); }
#pragma unroll
    for (int r = 0; r < 16; ++r) { p0[r] = exp2_fast(fmaf(p0[r], Cc, mC)); p1[r] = exp2_fast(fmaf(p1[r], Cc, mC)); }
    bf16x8 pa0, pa1, pa2, pa3;
    finishSM_noexp(p0, p1, l_reg, pa0, pa1, pa2, pa3);
    const LAS unsigned char* vb = vb0 + (t & 1) * SHM_V;
    pv_one<0>(o[0], vb, pa0, pa1, pa2, pa3); pv_one<1>(o[1], vb, pa0, pa1, pa2, pa3); pv_one<2>(o[2], vb, pa0, pa1, pa2, pa3); pv_one<3>(o[3], vb, pa0, pa1, pa2, pa3);
    pv_one<4>(o[4], vb, pa0, pa1, pa2, pa3); pv_one<5>(o[5], vb, pa0, pa1, pa2, pa3); pv_one<6>(o[6], vb, pa0, pa1, pa2, pa3); pv_one<7>(o[7], vb, pa0, pa1, pa2, pa3);
  }
  __syncthreads();
  LAS float* li_l = (LAS float*)(lds + FK) + wid * 32;
  if (hi == 0) li_l[r32] = l_reg; WAIT_L(0); WSYNC();
#pragma unroll
  for (int r = 0; r < 16; ++r) { const float rl = rcp_fast(li_l[crow(r, hi)]);
#pragma unroll
    for (int d = 0; d < 8; ++d) o[d][r] *= rl; }
  __syncthreads();
#undef A2_SLOAD
#undef A2_SWRITE
}
}

DEVI void phase_diffattn(const Params& P, const Ctx& C) {
  unsigned char* ws = P.ws;
  const bf16_t* Pm = (const bf16_t*)(ws + WS_P); bf16_t* AO = (bf16_t*)(ws + WS_AO);
  constexpr int LDP = 4 * DM, NQB = SEQ / 256, NIT = NB * DIFFH * NQB;
  const float lam = ((const float*)(ws + WS_MISC))[0];
  const float mref = ((const float*)(ws + WS_MISC))[1]; const bool fixedref = mref < 40.f;
  for (int it = C.vcu; it < NIT; it += C.G) {
    const int qb = it % NQB, h = (it / NQB) % DIFFH, b = it / (NQB * DIFFH);
    const size_t R0 = (size_t)b * TPB + CTX + 256 * qb, RB = (size_t)b * TPB;
    const bf16_t* Vp = Pm + RB * LDP + 2 * DM + h * 256;
    f32x16 o[8];
    if (fixedref) att2::attn256_pass_fixed(Pm + R0 * LDP + (h * 2 + 1) * 128, Pm + RB * LDP + DM + (h * 2 + 1) * 128, Vp, TPB / 64, C.lds, C.wave, o, mref);
    else att2::attn256_pass<false>(Pm + R0 * LDP + (h * 2 + 1) * 128, Pm + RB * LDP + DM + (h * 2 + 1) * 128, Vp, TPB / 64, C.lds, C.wave, o, mref);
    int ln = LANE_ID(); OPAQUE(ln);
    f32x4* stash = (f32x4*)(ws + WS_STASH) + ((size_t)C.bid * NTHR + C.wave * 64 + ln) * 32;
#pragma unroll
    for (int d = 0; d < 8; ++d)
#pragma unroll
      for (int q4 = 0; q4 < 4; ++q4) stash[d * 4 + q4] = (f32x4){o[d][4 * q4], o[d][4 * q4 + 1], o[d][4 * q4 + 2], o[d][4 * q4 + 3]} * lam;
    if (fixedref) att2::attn256_pass_fixed(Pm + R0 * LDP + (h * 2) * 128, Pm + RB * LDP + DM + (h * 2) * 128, Vp, TPB / 64, C.lds, C.wave, o, mref);
    else att2::attn256_pass<false>(Pm + R0 * LDP + (h * 2) * 128, Pm + RB * LDP + DM + (h * 2) * 128, Vp, TPB / 64, C.lds, C.wave, o, mref);
    OPAQUE(ln); stash = (f32x4*)(ws + WS_STASH) + ((size_t)C.bid * NTHR + C.wave * 64 + ln) * 32;
    const int r32 = ln & 31, hi = ln >> 5;
#pragma unroll
    for (int d = 0; d < 8; ++d)
#pragma unroll
      for (int q4 = 0; q4 < 4; ++q4) { const f32x4 t = stash[d * 4 + q4]; o[d][4 * q4] -= t.x; o[d][4 * q4 + 1] -= t.y; o[d][4 * q4 + 2] -= t.z; o[d][4 * q4 + 3] -= t.w; }
    const float* sg = P.in[I_SUBG];
    bf16_t* Ob = AO + (R0 + C.wave * 32) * DM + h * 256;
#pragma unroll
    for (int r = 0; r < 16; ++r) {
      float v = 0.f;
#pragma unroll
      for (int d = 0; d < 8; ++d) v += o[d][r] * o[d][r];
      v += SHFL_XOR_LN(v, 1, ln); v += SHFL_XOR_LN(v, 2, ln); v += SHFL_XOR_LN(v, 4, ln); v += SHFL_XOR_LN(v, 8, ln); v += SHFL_XOR_LN(v, 16, ln);
      const float rinv = (1.0f - LAM_INIT) * rsq_fast(v * (1.0f / 256.0f) + EPS); const int orow = att::crow(r, hi);
#pragma unroll
      for (int d = 0; d < 8; ++d) { const int col = 32 * d + r32; Ob[(size_t)orow * DM + col] = f2bf1(o[d][r] * rinv * sg[col]); } }
  }
}

__global__ void __launch_bounds__(NTHR, 1) fwd_kernel(Params P) {
  SMEM_DECL;
  cg::grid_group grid = cg::this_grid();
  Ctx C; C.lds = (LAS unsigned char*)smem_raw; C.wave = RFL((int)threadIdx.x >> 6); C.G = gridDim.x; C.bid = blockIdx.x; C.vcu = (C.G % 8 == 0) ? (C.bid % 8) * (C.G / 8) + C.bid / 8 : C.bid;
  XcdBarrier xb = xcd_barrier_post((unsigned*)(P.ws + WS_CTL), C.wave);
  if (P.ph_lo < 0) grid.sync();
  int ph = 0;
#ifndef PROBE_REP
#define PROBE_REP 1
#endif
#ifndef PROBE_DUP
#define PROBE_DUP -1
#endif
  float* xdst = (float*)(P.ws + WS_XRES);
#define PHASE(...) do { if (ph >= P.ph_lo && ph < P.ph_hi) { \
    if (ph == PROBE_DUP) { xdst = (float*)(P.ws + WS_STASH); __VA_ARGS__; xcd_barrier(xb); if (PROBE_REP >= 2) { __VA_ARGS__; xcd_barrier(xb); } if (PROBE_REP >= 3) { __VA_ARGS__; xcd_barrier(xb); } xdst = (float*)(P.ws + WS_XRES); } \
    __VA_ARGS__; if (ph + 1 < P.ph_hi) xcd_barrier(xb); } ++ph; } while (0)
  PHASE(phase_prep(P, C));
  PHASE((phase_norm<true, false>(P, C, 0, 0, P.in[I_NMIXG])));
  unsigned char* ws = P.ws;
  const float* misc = (const float*)(ws + WS_MISC);
  const float* rcos = (const float*)(ws + WS_ROPE); const float* rsin = rcos + (size_t)SEQ * 64;
  LAS float* xch = (LAS float*)(C.lds + LDS_X);
  float* slab = (float*)(ws + WS_STASH); unsigned* cntb = (unsigned*)(ws + WS_CNT); unsigned* cnt0 = cntb + 2048 * 1; unsigned* cnt1 = cntb + 2048 * 3;
  PHASE({ pg8::Gemm g{(const bf16_t*)(ws + WS_XN), (const bf16_t*)(ws + WS_WT_EVIN), DM}; pg8::Order S; S.init(MTOK / 256, EVEN_IN / 256, C.G, C.bid, false, DM / 64);
          pg8::EpiProj<0> E{(bf16_t*)(ws + WS_P), 4 * DM, misc + 64, misc + 64 + 128, rcos, rsin, xch, slab, cntb + 0}; pg8::gemm_phase(C.lds, C.wave, g, S, E); pg8::combine_proj(S, E, C.wave); });
  PHASE({ hg::phase_hg2(P, C); phase_attn0(P, C); });
  PHASE(hg::phase_hg3(P, C));
  const float* mods0 = (const float*)(ws + WS_MODS); const float* mods1 = mods0 + (size_t)(NB + 1) * 6 * DM;
  float* xres = (float*)(ws + WS_XRES);
  PHASE({ pg8::Gemm g{(const bf16_t*)(ws + WS_AO), (const bf16_t*)(ws + WS_WT_EVOUT), DM}; pg8::Order S; S.init(NB * (TILES_PB - 1), DM / 256, C.G, C.bid, true, DM / 64, pg8::KSPLIT, 0, DM / 256);
          pg8::EpiResid E{xres, xdst, mods0 + 2 * DM, nullptr, slab, cnt0, P.in[I_X], P.in[I_CTX]}; pg8::gemm_phase(C.lds, C.wave, g, S, E); pg8::combine_slices(S, E, C.wave); });
  PHASE((phase_norm<false, false>(P, C, 0, 3, P.in[I_NMLPG])));
  PHASE({ pg8::Gemm g{(const bf16_t*)(ws + WS_XN), (const bf16_t*)(ws + WS_WT_W1), DM}; pg8::Order S; S.init(MTOK / 256, DFF / 256, C.G, C.bid, false, DM / 64);
          pg8::EpiProj<2> E{(bf16_t*)(ws + WS_P), 4 * DM, nullptr, nullptr, nullptr, nullptr, xch, slab, cntb + 2048 * 2}; pg8::gemm_phase(C.lds, C.wave, g, S, E); pg8::combine_proj(S, E, C.wave); });
  PHASE({ pg8::Gemm g{(const bf16_t*)(ws + WS_P), (const bf16_t*)(ws + WS_WT_W2), DFF}; pg8::Order S; S.init(NB * (TILES_PB - 1), DM / 256, C.G, C.bid, true, DFF / 64, pg8::KSPLIT, 0, DM / 256);
          pg8::EpiResid E{xres, xdst, mods0 + 5 * DM, nullptr, slab, cnt1, nullptr, nullptr}; pg8::gemm_phase(C.lds, C.wave, g, S, E); pg8::combine_slices(S, E, C.wave); });
  PHASE((phase_norm<false, false>(P, C, 1, 0, P.in[I_NMIXG] + DM)));
  PHASE({ pg8::Gemm g{(const bf16_t*)(ws + WS_XN), (const bf16_t*)(ws + WS_WT_ODIN), DM}; pg8::Order S; S.init(MTOK / 256, ODD_IN / 256, C.G, C.bid, false, DM / 64);
          pg8::EpiProj<1> E{(bf16_t*)(ws + WS_P), 4 * DM, misc + 64 + 256, misc + 64 + 384, rcos, rsin, xch, slab, cntb + 2048 * 4}; pg8::gemm_phase(C.lds, C.wave, g, S, E); pg8::combine_proj(S, E, C.wave); });
  PHASE(phase_diffattn(P, C));
  PHASE({ pg8::Gemm g{(const bf16_t*)(ws + WS_AO), (const bf16_t*)(ws + WS_WT_ODOUT), DM}; pg8::Order S; S.init(NB * (TILES_PB - 1), DM / 256, C.G, C.bid, true, DM / 64);
          pg8::EpiResid E{xres, xdst, mods1 + 2 * DM, nullptr, nullptr, nullptr, nullptr, nullptr}; pg8::gemm_phase(C.lds, C.wave, g, S, E); });
  PHASE((phase_norm<false, true>(P, C, 1, 3, P.in[I_NMLPG] + DM)));
  PHASE({ pg8::Gemm g{(const bf16_t*)(ws + WS_XN), (const bf16_t*)(ws + WS_WT_W1) + (size_t)DFF * DM, DM}; pg8::Order S; S.init(NB * (TILES_PB - 1), DFF / 256, C.G, C.bid, true, DM / 64);
          pg8::EpiProj<2> E{(bf16_t*)(ws + WS_P), 4 * DM, nullptr, nullptr, nullptr, nullptr, xch, nullptr, nullptr}; pg8::gemm_phase(C.lds, C.wave, g, S, E); });
  PHASE({ pg8::Gemm g{(const bf16_t*)(ws + WS_P), (const bf16_t*)(ws + WS_WT_W2) + (size_t)DM * DFF, DFF}; pg8::Order S; S.init(NB * (TILES_PB - 1), DM / 256, C.G, C.bid, true, DFF / 64);
          pg8::EpiResid E{xres, xdst, mods1 + 5 * DM, P.out, nullptr, nullptr, nullptr, nullptr}; pg8::gemm_phase(C.lds, C.wave, g, S, E); });
#undef PHASE
}

constexpr int N_PHASES = 16;
extern "C" void kernel_launch(void* const* d_in, const int* in_sizes, int n_in, void* d_out, int out_size, void* d_ws, size_t ws_size, hipStream_t stream) {
  static int grid_blocks = 0;
  if (grid_blocks == 0) {
    if (n_in != 23 || ws_size < WS_END) { fprintf(stderr, "kernel_launch: unexpected n_in %d or ws %zu < %zu\n", n_in, ws_size, (size_t)WS_END); grid_blocks = -1; return; }
    int dev = 0, cus = 0, per_cu = 0;
    (void)hipGetDevice(&dev); (void)hipDeviceGetAttribute(&cus, hipDeviceAttributeMultiprocessorCount, dev);
    (void)hipFuncSetAttribute((const void*)fwd_kernel, hipFuncAttributeMaxDynamicSharedMemorySize, LDS_BYTES);
    (void)hipOccupancyMaxActiveBlocksPerMultiprocessor(&per_cu, (const void*)fwd_kernel, NTHR, (size_t)LDS_BYTES);
    if (per_cu < 1) { fprintf(stderr, "kernel_launch: occupancy query says %d blocks per CU\n", per_cu); per_cu = 1; }
    grid_blocks = cus;
  }
  if (grid_blocks < 0) return;
  (void)hipMemsetAsync((char*)d_ws + WS_CTL, 0, WS_MODS, stream);
  Params p{};
  for (int i = 0; i < 23; ++i) p.in[i] = (const float*)d_in[i];
  p.out = (float*)d_out; p.ws = (unsigned char*)d_ws; p.ph_lo = 0; p.ph_hi = N_PHASES;
#ifdef EMU
  if (getenv("EMU_PH_HI")) p.ph_hi = atoi(getenv("EMU_PH_HI"));
#endif
#ifndef EMU
  void* args[] = {&p};
  hipError_t e = hipLaunchCooperativeKernel((void*)fwd_kernel, dim3(grid_blocks), dim3(NTHR), args, LDS_BYTES, stream);
  if (e != hipSuccess) fprintf(stderr, "cooperative launch failed: %s (grid %d)\n", hipGetErrorString(e), grid_blocks);
#else
  emu::launch([p]() { fwd_kernel(p); }, dim3(grid_blocks), dim3(NTHR), LDS_BYTES);
#endif
}
```

```cpp
#include <hip/hip_runtime.h>
#include <hip/hip_cooperative_groups.h>
#include <cstdio>
#include <cstdint>
#include <cmath>
namespace cg = cooperative_groups;

typedef unsigned short bf16_t;
typedef short bf16x8 __attribute__((ext_vector_type(8)));
typedef short s16x4 __attribute__((ext_vector_type(4)));
typedef float f32x2 __attribute__((ext_vector_type(2)));
typedef float f32x4 __attribute__((ext_vector_type(4)));
typedef float f32x16 __attribute__((ext_vector_type(16)));
typedef unsigned u32x2 __attribute__((ext_vector_type(2)));
typedef unsigned u32x4 __attribute__((ext_vector_type(4)));

#ifndef EMU
#define LAS __attribute__((address_space(3)))
#define SMEM_DECL extern __shared__ __attribute__((aligned(16))) unsigned char smem_raw[]
#define BAR() __builtin_amdgcn_s_barrier()
#define WAIT_V(n) asm volatile("s_waitcnt vmcnt(" #n ")" ::: "memory")
#define WAIT_L(n) asm volatile("s_waitcnt lgkmcnt(" #n ")" ::: "memory")
#define CFENCE() asm volatile("" ::: "memory")
#define SCHED() __builtin_amdgcn_sched_barrier(0)
#define SETPRIO(n) __builtin_amdgcn_s_setprio(n)
#define GLDS16(g, l) __builtin_amdgcn_global_load_lds((const unsigned*)(g), (LAS unsigned*)(l), 16, 0, 0)
#define RFL(x) __builtin_amdgcn_readfirstlane(x)
#define OPAQUE(x) asm volatile("" : "+v"(x))
#define WSYNC() __builtin_amdgcn_wave_barrier()
typedef unsigned ldsaddr_t;
#define LDSADDR(p) ((ldsaddr_t)(uintptr_t)(p))
#define AT_LD(p) __hip_atomic_load((p), __ATOMIC_RELAXED, __HIP_MEMORY_SCOPE_AGENT)
#define AT_ADD(p, v) __hip_atomic_fetch_add((p), (v), __ATOMIC_RELAXED, __HIP_MEMORY_SCOPE_AGENT)
#define FENCE_REL() __builtin_amdgcn_fence(__ATOMIC_RELEASE, "agent")
#define FENCE_ACQ() __builtin_amdgcn_fence(__ATOMIC_ACQUIRE, "agent")
#define SLEEP1() __builtin_amdgcn_s_sleep(1)
#define ST_WT16(p, v) asm volatile("global_store_dwordx4 %0, %1, off sc1\n\ts_nop 1" :: "v"(p), "v"(v) : "memory")
#define ST_WT8(p, v) asm volatile("global_store_dwordx2 %0, %1, off sc1\n\ts_nop 1" :: "v"(p), "v"(v) : "memory")
#define XCC_ID() ((unsigned)__builtin_amdgcn_s_getreg((3 << 11) | 20) & 0xFu)
#define LANE_ID() ((int)(__builtin_amdgcn_mbcnt_hi(~0u, __builtin_amdgcn_mbcnt_lo(~0u, 0u)) & 63u))
#define SHFL_XOR_LN(v, m, ln) __builtin_bit_cast(float, __builtin_amdgcn_ds_bpermute(((ln) ^ (m)) << 2, __builtin_bit_cast(int, (v))))
__device__ __forceinline__ f32x4 mfma16(bf16x8 a, bf16x8 b, f32x4 c) { return __builtin_amdgcn_mfma_f32_16x16x32_bf16(a, b, c, 0, 0, 0); }
__device__ __forceinline__ f32x16 mfma32(bf16x8 a, bf16x8 b, f32x16 c) { return __builtin_amdgcn_mfma_f32_32x32x16_bf16(a, b, c, 0, 0, 0); }
typedef __bf16 bf16x2_t __attribute__((ext_vector_type(2)));
__device__ __forceinline__ unsigned cvtpk(float lo, float hi) { f32x2 v = {lo, hi}; bf16x2_t b = __builtin_convertvector(v, bf16x2_t); return __builtin_bit_cast(unsigned, b); }
template <int OFF> __device__ __forceinline__ s16x4 tr_read(ldsaddr_t vb) { s16x4 r; asm volatile("ds_read_b64_tr_b16 %0, %1 offset:%2" : "=&v"(r) : "v"(vb), "i"(OFF) : "memory"); return r; }
typedef short v4i16_t __attribute__((ext_vector_type(4)));
__device__ __forceinline__ s16x4 tr_read_p(const LAS void* p) { return __builtin_bit_cast(s16x4, __builtin_amdgcn_ds_read_tr16_b64_v4i16((LAS v4i16_t*)p)); }
__device__ __forceinline__ void plswap(unsigned a, unsigned b, unsigned& r0, unsigned& r1) { auto rr = __builtin_amdgcn_permlane32_swap(a, b, false, false); r0 = rr[0]; r1 = rr[1]; }
__device__ __forceinline__ float exp2_fast(float x) { return __builtin_amdgcn_exp2f(x); }
__device__ __forceinline__ float rcp_fast(float x) { return __builtin_amdgcn_rcpf(x); }
__device__ __forceinline__ float rsq_fast(float x) { return __builtin_amdgcn_rsqf(x); }
#else
#define LAS
#define SMEM_DECL unsigned char* smem_raw = emu::cur->blk->smem
#define BAR() __syncthreads()
#define WAIT_V(n) do { } while (0)
#define WAIT_L(n) do { } while (0)
#define CFENCE() do { } while (0)
#define SCHED() do { } while (0)
#define SETPRIO(n) do { } while (0)
#define GLDS16(g, l) memcpy((unsigned char*)(l) + 16 * emu::cur->lane, (const void*)(g), 16)
#define RFL(x) (x)
#define OPAQUE(x) do { } while (0)
#define WSYNC() do { int z_ = 0; (void)emu::collective(&z_, 4, 20, [](unsigned char (*)[160]) {}); } while (0)
typedef uintptr_t ldsaddr_t;
#define LDSADDR(p) ((ldsaddr_t)(uintptr_t)(p))
#define AT_LD(p) (*(volatile unsigned*)(p))
static inline unsigned emu_at_add(unsigned* p, unsigned v) { unsigned o = *p; *p = o + v; return o; }
#define AT_ADD(p, v) emu_at_add((p), (v))
#define FENCE_REL() do { } while (0)
#define FENCE_ACQ() do { } while (0)
#define SLEEP1() emu::poll_yield()
#define ST_WT16(p, v) (*(f32x4*)(p) = (v))
#define ST_WT8(p, v) (*(u32x2*)(p) = (v))
#define XCC_ID() ((unsigned)(emu::cur->blk->bid.x & 7u))
#define LANE_ID() (emu::cur->lane)
#define SHFL_XOR_LN(v, m, ln) __shfl_xor((v), (m))
static inline float bf2f_(short s) { unsigned u = ((unsigned)(unsigned short)s) << 16; float f; memcpy(&f, &u, 4); return f; }
static inline unsigned f2bf_(float f) { unsigned u; memcpy(&u, &f, 4); if ((u & 0x7fffffffu) > 0x7f800000u) return 0x7fc0u; return (u + 0x7fffu + ((u >> 16) & 1u)) >> 16; }
static inline f32x4 mfma16(bf16x8 a, bf16x8 b, f32x4 c) {
  struct In { bf16x8 a, b; f32x4 c; } in{a, b, c};
  int p = emu::collective(&in, sizeof(in), 10, [](unsigned char (*buf)[160]) {
    static float A[16][32], B[32][16];
    for (int l = 0; l < 64; ++l) { In x; memcpy(&x, buf[l], sizeof(x)); for (int j = 0; j < 8; ++j) { A[l & 15][8 * (l >> 4) + j] = bf2f_(x.a[j]); B[8 * (l >> 4) + j][l & 15] = bf2f_(x.b[j]); } }
    for (int l = 0; l < 64; ++l) { In x; memcpy(&x, buf[l], sizeof(x)); f32x4 d;
      for (int r = 0; r < 4; ++r) { const int row = 4 * (l >> 4) + r, col = l & 15; float acc = x.c[r]; for (int k = 0; k < 32; ++k) acc += A[row][k] * B[k][col]; d[r] = acc; }
      memcpy(buf[l] + 64, &d, 16); } });
  f32x4 d; memcpy(&d, emu::cur->wave->xbuf[p][emu::cur->lane] + 64, 16); return d;
}
static inline f32x16 mfma32(bf16x8 a, bf16x8 b, f32x16 c) {
  struct In { bf16x8 a, b; f32x16 c; } in{a, b, c};
  int p = emu::collective(&in, sizeof(in), 11, [](unsigned char (*buf)[160]) {
    static float A[32][16], B[16][32];
    for (int l = 0; l < 64; ++l) { In x; memcpy(&x, buf[l], sizeof(x)); for (int j = 0; j < 8; ++j) { A[l & 31][8 * (l >> 5) + j] = bf2f_(x.a[j]); B[8 * (l >> 5) + j][l & 31] = bf2f_(x.b[j]); } }
    for (int l = 0; l < 64; ++l) { In x; memcpy(&x, buf[l], sizeof(x)); f32x16 d;
      for (int r = 0; r < 16; ++r) { const int row = (r & 3) + 8 * (r >> 2) + 4 * (l >> 5), col = l & 31; float acc = x.c[r]; for (int k = 0; k < 16; ++k) acc += A[row][k] * B[k][col]; d[r] = acc; }
      memcpy(buf[l] + 96, &d, 64); } });
  f32x16 d; memcpy(&d, emu::cur->wave->xbuf[p][emu::cur->lane] + 96, 64); return d;
}
static inline unsigned cvtpk(float lo, float hi) { return f2bf_(lo) | (f2bf_(hi) << 16); }
template <int OFF> static inline s16x4 tr_read(ldsaddr_t vb) {
  ldsaddr_t a = vb + OFF;
  if (a & 7) { fprintf(stderr, "emu: tr_read misaligned\n"); abort(); }
  int p = emu::collective(&a, sizeof(a), 12, [](unsigned char (*)[160]) {});
  const int lane = emu::cur->lane, g = lane >> 4, i = lane & 15; s16x4 r;
  for (int q = 0; q < 4; ++q) { ldsaddr_t h; memcpy(&h, emu::cur->wave->xbuf[p][16 * g + 4 * q + (i >> 2)], sizeof(h)); r[q] = *(const short*)(h + 2 * (i & 3)); }
  return r;
}
static inline s16x4 tr_read_p(const void* p) { return tr_read<0>((ldsaddr_t)(uintptr_t)p); }
static inline void plswap(unsigned a, unsigned b, unsigned& r0, unsigned& r1) {
  unsigned in[2] = {a, b};
  int p = emu::collective(in, 8, 13, [](unsigned char (*)[160]) {});
  const int lane = emu::cur->lane; unsigned o[2]; memcpy(o, emu::cur->wave->xbuf[p][lane ^ 32], 8);
  if (lane < 32) { r0 = a; r1 = o[0]; } else { r0 = o[1]; r1 = b; }
}
static inline float exp2_fast(float x) { return exp2f(x); }
static inline float rcp_fast(float x) { return 1.0f / x; }
static inline float rsq_fast(float x) { return 1.0f / sqrtf(x); }
#endif

#define DEVI __device__ __forceinline__
DEVI float silu_f(float x) { return x * rcp_fast(1.0f + __expf(-x)); }
DEVI float bflo(unsigned w) { return __builtin_bit_cast(float, w << 16); }
DEVI float bfhi(unsigned w) { return __builtin_bit_cast(float, w & 0xffff0000u); }
DEVI float bf1(bf16_t h) { return __builtin_bit_cast(float, ((unsigned)h) << 16); }
DEVI bf16_t f2bf1(float f) { return (bf16_t)(cvtpk(f, 0.f) & 0xffffu); }
DEVI float wave_sum(float v) {
#pragma unroll
  for (int o = 1; o < 64; o <<= 1) v += __shfl_xor(v, o);
  return v;
}

#ifndef CFG_D
#define CFG_D 2048
#endif
#ifndef CFG_B
#define CFG_B 4
#endif
#ifndef CFG_SEQ
#define CFG_SEQ 2048
#endif
constexpr int DM = CFG_D, NB = CFG_B, SEQ = CFG_SEQ, CTX = 256, GW = 64;
constexpr int NAH = DM / 256, HGH = DM / 256, DIFFH = DM / 256;
constexpr int NAW = DM / 2;
constexpr int EVEN_IN = 4 * DM, ODD_IN = 3 * DM, DFF = 4 * DM;
constexpr int TPB = CTX + SEQ;
constexpr int MTOK = NB * TPB, TILES_PB = TPB / 256, GROWS = SEQ / GW;
constexpr int CHUNK = 64, NCH = TPB / CHUNK, NCH_CTX = CTX / CHUNK;
constexpr float EPS = 1e-6f;
constexpr float LAM_INIT = 0.35550906759f;
constexpr int C_QA = 0, C_KA = NAW, C_VA = 2 * NAW, C_QB = 3 * NAW, C_ZF = 4 * NAW, C_ZB = 5 * NAW, C_IB = 6 * NAW, C_GB = 7 * NAW;
static_assert(SEQ % 256 == 0 && DM % 256 == 0 && GROWS >= 8, "shape");

constexpr size_t al256(size_t x) { return (x + 255) / 256 * 256; }
constexpr size_t WS_CTL = 0;
constexpr size_t WS_CNT = 16384;
constexpr size_t WS_MODS = 16384 + 5 * 2048 * 4;
constexpr size_t WS_LB = WS_MODS + al256((size_t)2 * (NB + 1) * 6 * DM * 4);
constexpr size_t WS_ROPE = WS_LB + al256((size_t)2 * NAW * 4);
constexpr size_t WS_MISC = WS_ROPE + al256((size_t)2 * SEQ * 64 * 4);
constexpr size_t WS_WT_EVIN = WS_MISC + 4096;
constexpr size_t WS_WT_EVOUT = WS_WT_EVIN + (size_t)EVEN_IN * DM * 2;
constexpr size_t WS_WT_ODIN = WS_WT_EVOUT + (size_t)DM * DM * 2;
constexpr size_t WS_WT_ODOUT = WS_WT_ODIN + (size_t)ODD_IN * DM * 2;
constexpr size_t WS_WT_W1 = WS_WT_ODOUT + (size_t)DM * DM * 2;
constexpr size_t WS_WT_W2 = WS_WT_W1 + (size_t)2 * DFF * DM * 2;
constexpr size_t WS_XRES = WS_WT_W2 + (size_t)2 * DFF * DM * 2;
constexpr size_t WS_XN = WS_XRES + (size_t)MTOK * DM * 4;
constexpr size_t WS_P = WS_XN + (size_t)MTOK * DM * 2;
constexpr size_t WS_AO = WS_P + (size_t)MTOK * 4 * DM * 2;
constexpr size_t WS_HGS = WS_AO + (size_t)MTOK * DM * 2;
constexpr size_t WS_STASH = WS_HGS + (size_t)NB * HGH * 2 * NCH * 128 * 128 * 2;
constexpr size_t WS_END = WS_STASH + (size_t)512 * 512 * 128 * 4;

constexpr int LDS_RING = 131072;
constexpr int LDS_X = LDS_RING;
constexpr int LDS_BYTES = 163840;
constexpr int LDS_CTLW = LDS_BYTES;
constexpr int NTHR = 512, NWAVE = 8;

struct Params {
  const float* in[23];
  float* out;
  unsigned char* ws;
  int ph_lo, ph_hi;
};
enum { I_X = 0, I_C, I_CTX, I_CCTX, I_ADAW, I_ADAB, I_NMIXG, I_NMLPG, I_W1, I_W2, I_EVIN, I_EVOUT, I_NAQG, I_NAKG, I_RPB, I_LBL, I_GNG, I_ODIN, I_ODOUT, I_DFQG, I_DFKG, I_DFLAM, I_SUBG };

struct Ctx {
  LAS unsigned char* lds;
  int wave, G, bid, vcu;
};
#define CTX_IDS const int lane = LANE_ID(); const int tid = C.wave * 64 + lane; (void)tid

#define XB_TMO      128
#define XB_XCNT(j)  (256  + 64 * (j))
#define XB_XSUB(j)  (1280 + 64 * (j))
#define XB_XGEN(j)  (2304 + 64 * (j))
#define XB_TOP      3328
#define XB_TOPGEN   3392
#define XCD_BAR_WORDS 3456
#define XB_SPIN_CAP (1u << 22)
#define XB_SPIN(cond, bar) do { unsigned _sp = 0; while (cond) { SLEEP1(); \
    if ((++_sp & 255u) == 0u) { if (AT_LD(&(bar)[XB_TMO])) break; if (_sp > XB_SPIN_CAP) { AT_ADD(&(bar)[XB_TMO], 1u); break; } } } } while (0)
struct XcdBarrier { unsigned* bar; unsigned x; unsigned nloc, nx; int wave; };
DEVI XcdBarrier xcd_barrier_post(unsigned* bar, int wave) {
  XcdBarrier b; b.bar = bar; b.x = XCC_ID(); b.nloc = 0u; b.nx = 0u; b.wave = wave;
  if (wave == 0 && LANE_ID() == 0) (void)AT_ADD(&bar[XB_XCNT(b.x)], 1u);
  return b;
}
DEVI void xcd_barrier_complete(unsigned* bar, unsigned x, unsigned& nloc, unsigned& nx) {
  const unsigned G = gridDim.x;
  unsigned sum, cnt, mine, sp = 0u;
  for (;;) {
    sum = 0u; cnt = 0u; mine = 0u;
#pragma unroll
    for (unsigned j = 0; j < 16; ++j) { const unsigned c = AT_LD(&bar[XB_XCNT(j)]); sum += c; cnt += (c > 0u) ? 1u : 0u; mine = (j == x) ? c : mine; }
    if (sum == G) break;
    SLEEP1();
    if ((++sp & 255u) == 0u) { if (AT_LD(&bar[XB_TMO])) break; if (sp > XB_SPIN_CAP) { AT_ADD(&bar[XB_TMO], 1u); break; } }
  }
  nloc = mine > 0u ? mine : 1u; nx = cnt > 0u ? cnt : 1u;
}
DEVI void xcd_barrier(XcdBarrier& b) {
  WAIT_V(0);
  __syncthreads();
  unsigned nloc = b.nloc, nx = b.nx;
  if (b.wave == 0 && LANE_ID() == 0) {
    unsigned* bar = b.bar;
    if (nloc == 0u) xcd_barrier_complete(bar, b.x, nloc, nx);
    const unsigned old = AT_ADD(&bar[XB_XSUB(b.x)], 1u);
    const unsigned gen = old / nloc;
    if (old + 1u == (gen + 1u) * nloc) {
      FENCE_REL();
      WAIT_V(0);
      const unsigned og = AT_ADD(&bar[XB_TOP], 1u);
      const unsigned tg = og / nx;
      if (og + 1u == (tg + 1u) * nx) AT_ADD(&bar[XB_TOPGEN], 1u);
      else XB_SPIN(AT_LD(&bar[XB_TOPGEN]) == tg, bar);
      FENCE_ACQ();
      AT_ADD(&bar[XB_XGEN(b.x)], 1u);
      WAIT_V(0);
    } else {
      XB_SPIN(AT_LD(&bar[XB_XGEN(b.x)]) == gen, bar);
      FENCE_ACQ();
      WAIT_V(0);
    }
  }
  b.nloc = (unsigned)RFL((int)nloc); b.nx = (unsigned)RFL((int)nx);
  __syncthreads();
}

DEVI int pdim(int p) { const int c = p >> 3, e = p & 7; return e < 4 ? 4 * c + e : 64 + 4 * c + (e - 4); }
DEVI int ppos(int d) { return d < 64 ? 8 * (d >> 2) + (d & 3) : 8 * ((d - 64) >> 2) + 4 + (d & 3); }

struct TItem { const float* W; bf16_t* WT; int K, N, perm_cols, item; };
DEVI TItem t_resolve(const Params& P, int it) {
  unsigned char* ws = P.ws;
  constexpr int I_A = (DM / 64) * (EVEN_IN / 32), I_B = (DM / 64) * (DM / 32), I_C2 = (DM / 64) * (ODD_IN / 32), I_D = I_B, I_E = (DM / 64) * (DFF / 32), I_F = (DFF / 64) * (DM / 32);
  int r = it;
  if (r < I_A) return TItem{P.in[I_EVIN], (bf16_t*)(ws + WS_WT_EVIN), DM, EVEN_IN, 0, r}; r -= I_A;
  if (r < I_B) return TItem{P.in[I_EVOUT], (bf16_t*)(ws + WS_WT_EVOUT), DM, DM, 0, r}; r -= I_B;
  if (r < I_C2) return TItem{P.in[I_ODIN], (bf16_t*)(ws + WS_WT_ODIN), DM, ODD_IN, 2 * DM, r}; r -= I_C2;
  if (r < I_D) return TItem{P.in[I_ODOUT], (bf16_t*)(ws + WS_WT_ODOUT), DM, DM, 0, r}; r -= I_D;
  if (r < 2 * I_E) { const int l = r / I_E; return TItem{P.in[I_W1] + (size_t)l * DM * DFF, (bf16_t*)(ws + WS_WT_W1) + (size_t)l * DFF * DM, DM, DFF, 0, r % I_E}; } r -= 2 * I_E;
  { const int l = r / I_F; return TItem{P.in[I_W2] + (size_t)l * DFF * DM, (bf16_t*)(ws + WS_WT_W2) + (size_t)l * DM * DFF, DFF, DM, 0, r % I_F}; }
}
constexpr int T_NITEMS = (DM / 64) * (EVEN_IN / 32) + 2 * (DM / 64) * (DM / 32) + (DM / 64) * (ODD_IN / 32) + 2 * (DM / 64) * (DFF / 32) + 2 * (DFF / 64) * (DM / 32);
DEVI void t_load(const TItem& d, float (&tv)[32], int lane) {
  const int nblk = d.N / 32, kb = d.item / nblk, nb = d.item % nblk, k0 = 64 * kb, n0 = 32 * nb;
#pragma unroll
  for (int i = 0; i < 32; ++i) tv[i] = d.W[(size_t)(k0 + 2 * i + (lane >> 5)) * d.N + n0 + (lane & 31)];
}
DEVI void t_finish(const TItem& d, const float (&tv)[32], LAS float* scr, int lane) {
  const int nblk = d.N / 32, kb = d.item / nblk, nb = d.item % nblk, k0 = 64 * kb, n0 = 32 * nb;
#pragma unroll
  for (int i = 0; i < 32; ++i) scr[(2 * i + (lane >> 5)) * 33 + (lane & 31)] = tv[i];
  WAIT_L(0); CFENCE(); WSYNC();
  const int c = lane & 7;
#pragma unroll
  for (int j = 0; j < 4; ++j) { const int n = (lane >> 3) + 8 * j; const LAS float* s2 = scr + (8 * c) * 33 + n;
    u32x4 o; o.x = cvtpk(s2[0 * 33], s2[1 * 33]); o.y = cvtpk(s2[2 * 33], s2[3 * 33]); o.z = cvtpk(s2[4 * 33], s2[5 * 33]); o.w = cvtpk(s2[6 * 33], s2[7 * 33]);
    int nn = n0 + n; if (nn < d.perm_cols) nn = (nn & ~127) + ppos(nn & 127);
    *(u32x4*)(d.WT + (size_t)nn * d.K + k0 + 8 * c) = o; }
  WAIT_L(0); CFENCE(); WSYNC();
}

DEVI void phase_prep(const Params& P, const Ctx& C) {
  CTX_IDS;
  unsigned char* ws = P.ws;
  {
    LAS float* sv = (LAS float*)(C.lds);
    for (int i = tid; i < (NB + 1) * DM; i += NTHR) { const int bb = i / DM, k = i % DM; const float v = bb < NB ? P.in[I_C][bb * DM + k] : P.in[I_CCTX][k]; sv[i] = silu_f(v); }
    __syncthreads();
    LAS float* red = (LAS float*)(C.lds + (NB + 1) * DM * 4);
    constexpr int NCHK = 6 * DM / 32, KW = DM / NWAVE;
    const int nitems = 2 * NCHK, hw = lane >> 5, l31 = lane & 31;
    for (int it = C.bid; it < nitems; it += C.G) {
      const int l = it / NCHK, j0 = (it % NCHK) * 32;
      const float* w = P.in[I_ADAW] + (size_t)l * DM * 6 * DM + (size_t)(C.wave * KW + hw) * 6 * DM + j0 + l31;
      float acc[NB + 1];
#pragma unroll
      for (int bb = 0; bb <= NB; ++bb) acc[bb] = 0.f;
      for (int k = 0; k < KW; k += 64) {
        float wv[32];
#pragma unroll
        for (int u = 0; u < 32; ++u) wv[u] = w[(size_t)(k + 2 * u) * 6 * DM];
#pragma unroll
        for (int u = 0; u < 32; ++u)
#pragma unroll
          for (int bb = 0; bb <= NB; ++bb) acc[bb] += sv[bb * DM + C.wave * KW + k + 2 * u + hw] * wv[u];
      }
#pragma unroll
      for (int bb = 0; bb <= NB; ++bb) red[((C.wave * 2 + hw) * (NB + 1) + bb) * 32 + l31] = acc[bb];
      __syncthreads();
      if (tid < (NB + 1) * 32) { const int bb = tid / 32, ln = tid % 32; float s2 = 0.f;
#pragma unroll
        for (int w8 = 0; w8 < 2 * NWAVE; ++w8) s2 += red[(w8 * (NB + 1) + bb) * 32 + ln];
        ((float*)(ws + WS_MODS))[((size_t)l * (NB + 1) + bb) * 6 * DM + j0 + ln] = s2 + P.in[I_ADAB][(size_t)l * 6 * DM + j0 + ln]; }
      __syncthreads();
    }
  }
  {
    const int gt = C.bid * NTHR + tid, GT = C.G * NTHR;
    float* lb = (float*)(ws + WS_LB);
    for (int i = gt; i < 2 * NAW; i += GT) { const int d = i / NAW, ch = i % NAW; const float* lg = P.in[I_LBL] + (size_t)d * 3 * NAW + ch;
      const float a = lg[0], b = lg[NAW], c = lg[2 * NAW], m = fmaxf(a, fmaxf(b, c)); const float ea = expf(a - m), eb = expf(b - m), ec = expf(c - m); lb[i] = ea / (ea + eb + ec); }
    float* rc = (float*)(ws + WS_ROPE); float* rs = rc + (size_t)SEQ * 64;
    for (int i = gt; i < SEQ * 64; i += GT) { const int t = i / 64, f = i % 64; const float pos = (float)(f < 32 ? t / GW : t % GW);
      const float inv = powf(10000.0f, -(float)(f & 31) / 32.0f); const float ang = pos * inv; rc[i] = cosf(ang); rs[i] = sinf(ang); }
    float* misc = (float*)(ws + WS_MISC);
    if (gt < 128) { misc[64 + gt] = P.in[I_NAQG][gt]; misc[64 + 128 + gt] = P.in[I_NAKG][gt]; misc[64 + 256 + gt] = P.in[I_DFQG][pdim(gt)]; misc[64 + 384 + gt] = P.in[I_DFKG][pdim(gt)]; }
    if (C.bid == 0 && C.wave == 0) { const float* lp = P.in[I_DFLAM]; float s1 = 0.f, s2 = 0.f;
      for (int i = lane; i < 128; i += 64) { s1 += lp[i] * lp[128 + i]; s2 += lp[256 + i] * lp[384 + i]; }
      s1 = wave_sum(s1); s2 = wave_sum(s2); if (lane == 0) misc[0] = expf(s1) - expf(s2) + LAM_INIT; }
    if (C.bid == 0 && C.wave == 1) { float mq = 0.f, mk = 0.f;
      for (int i = lane; i < 128; i += 64) { mq = fmaxf(mq, fabsf(P.in[I_DFQG][i])); mk = fmaxf(mk, fabsf(P.in[I_DFKG][i])); }
#pragma unroll
      for (int o2 = 1; o2 < 64; o2 <<= 1) { mq = fmaxf(mq, __shfl_xor(mq, o2)); mk = fmaxf(mk, __shfl_xor(mk, o2)); }
      if (lane == 0) misc[1] = 11.3137085f * mq * mk * 1.0001f; }
  }
  {
    LAS float* scr = (LAS float*)(C.lds + C.wave * 16384);
    __syncthreads();
    const int gw = C.bid * NWAVE + C.wave, NGW = C.G * NWAVE;
    float ta[32], tb[32];
    int it = gw;
    if (it < T_NITEMS) { TItem da = t_resolve(P, it); t_load(da, ta, lane);
      for (;;) {
        const int itb = it + NGW; TItem db = da; const bool hb = itb < T_NITEMS;
        if (hb) { db = t_resolve(P, itb); t_load(db, tb, lane); }
        t_finish(da, ta, scr, lane);
        if (!hb) break;
        const int ita = itb + NGW; const bool ha = ita < T_NITEMS;
        if (ha) { da = t_resolve(P, ita); t_load(da, ta, lane); }
        t_finish(db, tb, scr, lane);
        if (!ha) break;
        it = ita;
      } }
  }
}

template <bool FIRST, bool LAT_ONLY>
DEVI void phase_norm(const Params& P, const Ctx& C, int layer, int modi, const float* g) {
  CTX_IDS;
  unsigned char* ws = P.ws;
  float* xres = (float*)(ws + WS_XRES); bf16_t* xn = (bf16_t*)(ws + WS_XN);
  const float* mods = (const float*)(ws + WS_MODS) + (size_t)layer * (NB + 1) * 6 * DM;
  const int gw = C.bid * NWAVE + C.wave, NGW = C.G * NWAVE;
  constexpr int NV = DM / 256;
  for (int R = gw; R < MTOK; R += NGW) {
    const int b = R / TPB, r = R % TPB; const bool isc = r < CTX;
    if (LAT_ONLY && isc) continue;
    const float* src = FIRST ? (isc ? P.in[I_CTX] + ((size_t)b * CTX + r) * DM : P.in[I_X] + ((size_t)b * SEQ + (r - CTX)) * DM) : xres + (size_t)R * DM;
    const float* md = mods + (size_t)(isc ? NB : b) * 6 * DM + (size_t)modi * DM;
    f32x4 v[NV]; float s = 0.f;
#pragma unroll
    for (int j = 0; j < NV; ++j) { v[j] = *(const f32x4*)(src + 256 * j + 4 * lane); s += (v[j].x * v[j].x + v[j].y * v[j].y) + (v[j].z * v[j].z + v[j].w * v[j].w); }
    const float rinv = 1.0f / sqrtf(wave_sum(s) * (1.0f / DM) + EPS);
#pragma unroll
    for (int j = 0; j < NV; ++j) { const int c0 = 256 * j + 4 * lane; const f32x4 gg = *(const f32x4*)(g + c0), sh = *(const f32x4*)(md + c0), sc = *(const f32x4*)(md + DM + c0);
      const f32x4 h = (v[j] * rinv) * gg * (sc + 1.0f) + sh; u32x2 o; o.x = cvtpk(h.x, h.y); o.y = cvtpk(h.z, h.w); ST_WT8(xn + (size_t)R * DM + c0, o); }
  }
}

namespace pg8 {
constexpr int BM = 256, BK = 64, HALF = 128, HTB = HALF * BK * 2, STAGE_BYTES = 8 * HTB, NXCD = 8, WGM = 4;
static_assert(STAGE_BYTES <= LDS_RING, "ring");
DEVI int lds_byte(int r, int c) { const int st = (r >> 4) * 2 + (c >> 5), rr = r & 15, cc = c & 31, ob = rr * 64 + cc * 2; return st * 1024 + (ob ^ (((ob >> 9) & 1) << 5)); }
DEVI void stage_rc(int b, int& R, int& C) { const int st = b / 1024, sb = b % 1024, swz = sb ^ (((sb >> 9) & 1) << 5); R = (st >> 1) * 16 + swz / 64; C = (st & 1) * 32 + (swz % 64) / 2; }
DEVI int perm32(int rho) { const int n = rho >> 4, i = rho & 15; return 8 * (i >> 2) + 4 * n + (i & 3); }
struct Unit { int pm, pn, kt0, nkt, slice, tile, ks; };
struct Gemm { const bf16_t* A; const bf16_t* Bt; int K; };
constexpr int KSPLIT = (DM / 64 >= 16) ? 8 : 4;
struct Order {
  int nM, nN, nwg, G, c, nkt, nsl, ks, pn0c, nNc; bool lat_only;
  DEVI void init(int nM_, int nN_, int G_, int c_, bool lat, int nkt_, int ks_ = 0, int pn0c_ = 0, int nNc_ = 0) { nM = nM_; nN = nN_; nwg = nM * nN; G = G_; c = c_; lat_only = lat; nkt = nkt_; ks = ks_; pn0c = pn0c_; nNc = nNc_; nsl = NB * nNc_ * ks_; }
  DEVI bool next(int i, Unit& u) const {
    const long L = (long)i * G + c; if (L >= nwg + nsl) return false;
    u.ks = ks;
    if (L >= nwg) { const int j = (int)L - nwg; u.tile = j / ks; u.slice = j % ks; u.pm = (u.tile / nNc) * TILES_PB; u.pn = pn0c + u.tile % nNc; u.nkt = nkt / ks; u.kt0 = u.slice * u.nkt; return true; }
    u.kt0 = 0; u.nkt = nkt; u.slice = -1; u.tile = 0;
    int wgid = (int)L; { const int q = nwg / NXCD, r = nwg % NXCD, xcd = wgid % NXCD, off = wgid / NXCD; wgid = (xcd < r ? xcd * (q + 1) : r * (q + 1) + (xcd - r) * q) + off; }
    const int nig = WGM * nN, gid = wgid / nig, fm = gid * WGM, gsz = (nM - fm) < WGM ? (nM - fm) : WGM;
    int pm = fm + ((wgid % nig) % gsz); u.pn = (wgid % nig) / gsz;
    if (lat_only) pm = (pm / (TILES_PB - 1)) * TILES_PB + 1 + pm % (TILES_PB - 1);
    u.pm = pm; return true;
  }
};
enum { EM_RAW = 0, EM_SILU = 1, EM_RELU2 = 2, EM_HNORM = 3 };
template <int kind> struct EpiProj {
  static constexpr bool PERM = true;
  bf16_t* O; int ldc;
  const float* gq; const float* gk; const float* rcos; const float* rsin; LAS float* xch; float* slab; unsigned* cnt;
  DEVI int tile_mode(int pn, const float*& g) const {
    const int colt = pn * BM; g = gq;
    if (kind == 0) { const int seg = colt / NAW; g = seg == 1 ? gk : gq; return seg <= 1 ? EM_HNORM : (seg == 3 || seg == 7) ? EM_SILU : EM_RAW; }
    if (kind == 1) { g = colt < DM ? gq : gk; return colt < 2 * DM ? EM_HNORM : EM_RAW; }
    return EM_RELU2;
  }
  DEVI void operator()(f32x4 (&acc)[2][2][4][2], const Unit& u, int wr, int wc, int fr, int fq) const {
    OPAQUE(fr); OPAQUE(fq);
    if (u.slice >= 0) {
      float* sp = slab + (size_t)(u.tile * u.ks + u.slice) * 65536 + (((wr * 4 + wc) * 64 + fq * 16 + fr) * 4);
#pragma unroll
      for (int ai = 0; ai < 2; ++ai)
#pragma unroll
        for (int bj = 0; bj < 2; ++bj)
#pragma unroll
          for (int m = 0; m < 4; ++m)
#pragma unroll
            for (int n = 0; n < 2; ++n) { float* q_ = sp + (((ai * 2 + bj) * 4 + m) * 2 + n) * 2048; ST_WT16(q_, acc[ai][bj][m][n]); }
      WAIT_V(0); BAR(); CFENCE();
      if (wr == 0 && wc == 0 && LANE_ID() == 0) (void)AT_ADD(cnt + 16 * u.tile, 1u);
      return;
    }
    int mode = EM_RAW; const float* g = gq; bool rope = false;
    const int colt = u.pn * BM;
    if (kind == 0) { const int seg = colt / NAW; mode = seg == 0 ? EM_HNORM : seg == 1 ? EM_HNORM : (seg == 3 || seg == 7) ? EM_SILU : EM_RAW; g = seg == 1 ? gk : gq; }
    else if (kind == 1) { if (colt < 2 * DM) { mode = EM_HNORM; g = colt < DM ? gq : gk; rope = (u.pm % TILES_PB) != 0; } }
    else mode = EM_RELU2;
    bf16_t* base = O + (size_t)(u.pm * BM) * ldc + colt;
    if (mode == EM_HNORM) {
#pragma unroll
      for (int ai = 0; ai < 2; ++ai)
#pragma unroll
        for (int m = 0; m < 4; ++m)
#pragma unroll
          for (int bj = 0; bj < 2; ++bj) { const f32x4 a = acc[ai][bj][m][0], b = acc[ai][bj][m][1];
            float s = (a.x * a.x + a.y * a.y) + (a.z * a.z + a.w * a.w) + (b.x * b.x + b.y * b.y) + (b.z * b.z + b.w * b.w);
            s += __shfl_xor(s, 16); s += __shfl_xor(s, 32);
            if (fq == 0) xch[(ai * HALF + wr * 64 + m * 16 + fr) * 8 + bj * 4 + wc] = s; }
      WAIT_L(0); BAR(); CFENCE();
      const int lt0 = (u.pm % TILES_PB - 1) * 256;
#pragma unroll
      for (int ai = 0; ai < 2; ++ai)
#pragma unroll
        for (int m = 0; m < 4; ++m) { const int lr = ai * HALF + wr * 64 + m * 16 + fr;
          f32x4 cs = {1.f, 1.f, 1.f, 1.f}, sn = {0.f, 0.f, 0.f, 0.f};
          if (rope) { cs = *(const f32x4*)(rcos + (size_t)(lt0 + lr) * 64 + 16 * wc + 4 * fq); sn = *(const f32x4*)(rsin + (size_t)(lt0 + lr) * 64 + 16 * wc + 4 * fq); }
#pragma unroll
          for (int bj = 0; bj < 2; ++bj) { const f32x4 t = *(const LAS f32x4*)(xch + lr * 8 + bj * 4);
            const float rinv = rsq_fast(((t.x + t.y) + (t.z + t.w)) * (1.0f / 128.0f) + EPS);
            const f32x4 g0 = *(const f32x4*)(g + 32 * wc + 8 * fq), g1 = *(const f32x4*)(g + 32 * wc + 8 * fq + 4);
            const f32x4 x1 = acc[ai][bj][m][0] * rinv * g0, x2 = acc[ai][bj][m][1] * rinv * g1;
            const f32x4 o1 = x1 * cs - x2 * sn, o2 = x1 * sn + x2 * cs;
            u32x4 w; w.x = cvtpk(o1.x, o1.y); w.y = cvtpk(o1.z, o1.w); w.z = cvtpk(o2.x, o2.y); w.w = cvtpk(o2.z, o2.w);
            *(u32x4*)(base + (size_t)lr * ldc + bj * HALF + wc * 32 + 8 * fq) = w; } }
    } else {
#pragma unroll
      for (int ai = 0; ai < 2; ++ai)
#pragma unroll
        for (int m = 0; m < 4; ++m) { const int lr = ai * HALF + wr * 64 + m * 16 + fr;
#pragma unroll
          for (int bj = 0; bj < 2; ++bj) { f32x4 v0 = acc[ai][bj][m][0], v1 = acc[ai][bj][m][1];
            if (mode == EM_SILU) {
#pragma unroll
              for (int e = 0; e < 4; ++e) { v0[e] = silu_f(v0[e]); v1[e] = silu_f(v1[e]); } }
            else if (mode == EM_RELU2) {
#pragma unroll
              for (int e = 0; e < 4; ++e) { const float a = fmaxf(v0[e], 0.f), b = fmaxf(v1[e], 0.f); v0[e] = a * a; v1[e] = b * b; } }
            u32x4 w; w.x = cvtpk(v0.x, v0.y); w.y = cvtpk(v0.z, v0.w); w.z = cvtpk(v1.x, v1.y); w.w = cvtpk(v1.z, v1.w);
            *(u32x4*)(base + (size_t)lr * ldc + bj * HALF + wc * 32 + 8 * fq) = w; } }
    }
  }
};
struct EpiResid {
  static constexpr bool PERM = false;
  float* xres; float* xdst; const float* gate; float* fin; float* slab; unsigned* cnt; const float* in_x; const float* in_ctx;
  DEVI void operator()(f32x4 (&acc)[2][2][4][2], const Unit& u, int wr, int wc, int fr, int fq) const {
    OPAQUE(fr); OPAQUE(fq);
    if (u.slice >= 0) {
      float* sp = slab + (size_t)(u.tile * u.ks + u.slice) * 65536 + (((wr * 4 + wc) * 64 + fq * 16 + fr) * 4);
#pragma unroll
      for (int ai = 0; ai < 2; ++ai)
#pragma unroll
        for (int bj = 0; bj < 2; ++bj)
#pragma unroll
          for (int m = 0; m < 4; ++m)
#pragma unroll
            for (int n = 0; n < 2; ++n) { float* q_ = sp + (((ai * 2 + bj) * 4 + m) * 2 + n) * 2048; ST_WT16(q_, acc[ai][bj][m][n]); }
      WAIT_V(0); BAR(); CFENCE();
      if (wr == 0 && wc == 0 && LANE_ID() == 0) (void)AT_ADD(cnt + 16 * u.tile, 1u);
      return;
    }
    const int b = u.pm / TILES_PB, within = u.pm % TILES_PB; const bool isc = within == 0;
    const float* gp = gate + (size_t)(isc ? NB : b) * 6 * DM + u.pn * BM + wc * 32 + 4 * fq;
    f32x4 gv[2][2];
#pragma unroll
    for (int bj = 0; bj < 2; ++bj)
#pragma unroll
      for (int n = 0; n < 2; ++n) gv[bj][n] = *(const f32x4*)(gp + bj * HALF + n * 16);
    const size_t toff = (size_t)(u.pm * BM) * DM + u.pn * BM + wc * 32 + 4 * fq;
    const float* src = in_x ? (isc ? in_ctx + (size_t)b * CTX * DM : in_x + ((size_t)b * SEQ + (size_t)(within - 1) * 256) * DM) + u.pn * BM + wc * 32 + 4 * fq : xres + toff;
    float* dst = (fin && !isc) ? fin + ((size_t)b * SEQ + (size_t)(within - 1) * 256) * DM + u.pn * BM + wc * 32 + 4 * fq : xdst + toff;
#pragma unroll
    for (int ai = 0; ai < 2; ++ai)
#pragma unroll
      for (int m = 0; m < 4; ++m) { const size_t ro = (size_t)(ai * HALF + wr * 64 + m * 16 + fr) * DM;
#pragma unroll
        for (int bj = 0; bj < 2; ++bj)
#pragma unroll
          for (int n = 0; n < 2; ++n) { const f32x4 bs = *(const f32x4*)(src + ro + bj * HALF + n * 16); *(f32x4*)(dst + ro + bj * HALF + n * 16) = bs + gv[bj][n] * acc[ai][bj][m][n]; } }
  }
};

DEVI const float* slab_piece(const float* unit, int row, int bj, int wc, int fq, int n) {
  const int ai = row >> 7, wr = (row >> 6) & 1, m = (row >> 4) & 3, fr = row & 15;
  return unit + ((((ai * 2 + bj) * 4 + m) * 2 + n) * 512 + (wr * 4 + wc) * 64 + fq * 16 + fr) * 4;
}
DEVI void combine_slices(const Order& S, const EpiResid& E, int wid) {
  const int lane = LANE_ID(), tid = wid * 64 + lane;
  Unit u;
  for (int i = 0; S.next(i, u); ++i) {
    if (u.slice < 0) continue;
    if (wid == 0) { unsigned sp = 0; while (AT_LD(E.cnt + 16 * u.tile) < (unsigned)u.ks) { SLEEP1(); if (++sp > (1u << 24)) break; } FENCE_ACQ(); WAIT_V(0); }
    __syncthreads();
    const int RPS = 256 / u.ks;
    for (int rr = tid >> 4; rr < RPS; rr += 32) {
      const int row = RPS * u.slice + rr, col = (tid & 15) * 16;
      const float* sp = E.slab + (size_t)u.tile * u.ks * 65536;
      f32x4 a[4];
#pragma unroll
      for (int q = 0; q < 4; ++q) a[q] = (f32x4){0.f, 0.f, 0.f, 0.f};
      for (int s2 = 0; s2 < u.ks; ++s2)
#pragma unroll
        for (int q = 0; q < 4; ++q) a[q] += *(const f32x4*)slab_piece(sp + (size_t)s2 * 65536, row, col >> 7, (col >> 5) & 3, q, (col >> 4) & 1);
      const float* gp = E.gate + (size_t)NB * 6 * DM + u.pn * BM + col;
      const size_t off = (size_t)(u.pm * BM + row) * DM + u.pn * BM + col;
      const float* bs = E.in_ctx ? E.in_ctx + ((size_t)(u.pm / TILES_PB) * CTX + row) * DM + u.pn * BM + col : E.xres + off;
#pragma unroll
      for (int q = 0; q < 4; ++q) *(f32x4*)(E.xdst + off + 4 * q) = *(const f32x4*)(bs + 4 * q) + *(const f32x4*)(gp + 4 * q) * a[q];
    }
    __syncthreads();
  }
}
template <int kind>
DEVI void combine_proj(const Order& S, const EpiProj<kind>& E, int wid) {
  const int lane = LANE_ID(), tid = wid * 64 + lane;
  Unit u;
  for (int i = 0; S.next(i, u); ++i) {
    if (u.slice < 0) continue;
    if (wid == 0) { unsigned sp = 0; while (AT_LD(E.cnt + 16 * u.tile) < (unsigned)u.ks) { SLEEP1(); if (++sp > (1u << 24)) break; } FENCE_ACQ(); WAIT_V(0); }
    __syncthreads();
    const float* g; const int mode = E.tile_mode(u.pn, g);
    const int RPS = 256 / u.ks;
    for (int rr = tid >> 4; rr < RPS; rr += 32) {
      const int row = RPS * u.slice + rr, col = (tid & 15) * 16;
      const float* sp = E.slab + (size_t)u.tile * u.ks * 65536;
      f32x4 a[4];
#pragma unroll
      for (int q = 0; q < 4; ++q) a[q] = (f32x4){0.f, 0.f, 0.f, 0.f};
      for (int s2 = 0; s2 < u.ks; ++s2)
#pragma unroll
        for (int q = 0; q < 4; ++q) a[q] += *(const f32x4*)slab_piece(sp + (size_t)s2 * 65536, row, col >> 7, (col >> 5) & 3, ((col & 31) >> 3) + (q >> 1), q & 1);
      if (mode == EM_HNORM) {
        float ss = 0.f;
#pragma unroll
        for (int q = 0; q < 4; ++q) ss += (a[q].x * a[q].x + a[q].y * a[q].y) + (a[q].z * a[q].z + a[q].w * a[q].w);
        ss += __shfl_xor(ss, 1); ss += __shfl_xor(ss, 2); ss += __shfl_xor(ss, 4);
        const float rinv = rsq_fast(ss * (1.0f / 128.0f) + EPS);
#pragma unroll
        for (int q = 0; q < 4; ++q) a[q] = a[q] * rinv * *(const f32x4*)(g + (col & 127) + 4 * q);
      } else if (mode == EM_SILU) {
#pragma unroll
        for (int q = 0; q < 4; ++q)
#pragma unroll
          for (int e = 0; e < 4; ++e) a[q][e] = silu_f(a[q][e]);
      } else if (mode == EM_RELU2) {
#pragma unroll
        for (int q = 0; q < 4; ++q)
#pragma unroll
          for (int e = 0; e < 4; ++e) { const float t = fmaxf(a[q][e], 0.f); a[q][e] = t * t; }
      }
      bf16_t* dst = E.O + (size_t)(u.pm * BM + row) * E.ldc + u.pn * BM + col;
      u32x4 w0, w1; w0.x = cvtpk(a[0].x, a[0].y); w0.y = cvtpk(a[0].z, a[0].w); w0.z = cvtpk(a[1].x, a[1].y); w0.w = cvtpk(a[1].z, a[1].w);
      w1.x = cvtpk(a[2].x, a[2].y); w1.y = cvtpk(a[2].z, a[2].w); w1.z = cvtpk(a[3].x, a[3].y); w1.w = cvtpk(a[3].z, a[3].w);
      *(u32x4*)dst = w0; *(u32x4*)(dst + 8) = w1;
    }
    __syncthreads();
  }
}
template <class Epi>
DEVI void gemm_phase(LAS unsigned char* lds, int wid, const Gemm g, const Order& S, const Epi& E) {
  const int lane = LANE_ID(), tid = wid * 64 + lane, wr = wid >> 2, wc = wid & 3, fr = lane & 15, fq = lane >> 4;
  const int K = g.K;
  unsigned voffA[2], voffB[2];
#pragma unroll
  for (int i = 0; i < 2; ++i) { int R, C; stage_rc(tid * 16 + i * 8192, R, C); const int Rb = Epi::PERM ? ((R & ~31) + perm32(R & 31)) : R;
    voffA[i] = (unsigned)(R * K + C) * 2u; voffB[i] = (unsigned)(Rb * K + C) * 2u; }
  const size_t kstep = (size_t)(BK * 2);
  const size_t hstep = (size_t)HALF * K * 2;
  const size_t tstep = 2 * hstep;
  const unsigned ldsw = (unsigned)wid * 1024u;
  const int aoff = lds_byte(wr * 64 + fr, fq * 8), boff = lds_byte(wc * 32 + fr, fq * 8);
#define PG8_SA(b, h) (((b) * 2 + (h)) * HTB)
#define PG8_SB(b, h) ((4 + (b) * 2 + (h)) * HTB)
#define PG8_STAGE(bufoff, gbase, voff) do { _Pragma("unroll") for (int _i = 0; _i < 2; ++_i) \
    GLDS16((const char*)(gbase) + (voff)[_i], lds + (bufoff) + ldsw + _i * 8192); } while (0)
#define PG8_LDA(dst, b, h) do { _Pragma("unroll") for (int m = 0; m < 4; ++m) _Pragma("unroll") for (int k = 0; k < 2; ++k) dst[m][k] = *(const LAS bf16x8*)(lds + PG8_SA(b, h) + aoff + m * 2048 + k * 1024); } while (0)
#define PG8_LDB(dst, b, h) do { _Pragma("unroll") for (int n = 0; n < 2; ++n) _Pragma("unroll") for (int k = 0; k < 2; ++k) dst[n][k] = *(const LAS bf16x8*)(lds + PG8_SB(b, h) + boff + n * 2048 + k * 1024); } while (0)
#define PG8_MMA(ai, bj, At, Bt) do { SETPRIO(1); _Pragma("unroll") for (int m = 0; m < 4; ++m) _Pragma("unroll") for (int n = 0; n < 2; ++n) _Pragma("unroll") for (int k = 0; k < 2; ++k) \
    acc[ai][bj][m][n] = mfma16(Bt[n][k], At[m][k], acc[ai][bj][m][n]); SETPRIO(0); } while (0)
  Unit cur, nxt; int ui = 0;
  if (!S.next(0, cur)) return;
  f32x4 acc[2][2][4][2];
#pragma unroll
  for (int a = 0; a < 2; ++a)
#pragma unroll
    for (int b = 0; b < 2; ++b)
#pragma unroll
      for (int m = 0; m < 4; ++m)
#pragma unroll
        for (int n = 0; n < 2; ++n) acc[a][b][m][n] = (f32x4){0.f, 0.f, 0.f, 0.f};
  bf16x8 At[4][2], B0[2][2], B1[2][2];
  const char* cA = (const char*)g.A + (size_t)cur.pm * tstep + (size_t)cur.kt0 * kstep; const char* cB = (const char*)g.Bt + (size_t)cur.pn * tstep + (size_t)cur.kt0 * kstep;
  int nt = cur.nkt;
  PG8_STAGE(PG8_SB(0, 0), cB, voffB); PG8_STAGE(PG8_SB(0, 1), cB + hstep, voffB); PG8_STAGE(PG8_SA(0, 0), cA, voffA); PG8_STAGE(PG8_SA(0, 1), cA + hstep, voffA);
  if (wr == 1) BAR();
  WAIT_V(2); BAR();
  PG8_STAGE(PG8_SB(1, 0), cB + kstep, voffB); PG8_STAGE(PG8_SA(1, 0), cA + kstep, voffA); PG8_STAGE(PG8_SB(1, 1), cB + hstep + kstep, voffB);
  WAIT_V(6); BAR();
  for (;;) {
    const bool has_next = S.next(ui + 1, nxt);
    const char* nA = has_next ? (const char*)g.A + (size_t)nxt.pm * tstep + (size_t)nxt.kt0 * kstep : cA; const char* nB = has_next ? (const char*)g.Bt + (size_t)nxt.pn * tstep + (size_t)nxt.kt0 * kstep : cB;
    for (int t = 0; t < nt; t += 2) {
      const bool last = (t == nt - 2);
      const char* a1 = cA + (size_t)(t + 1) * kstep;
      const char* a2 = last ? nA : cA + (size_t)(t + 2) * kstep; const char* b2 = last ? nB : cB + (size_t)(t + 2) * kstep;
      const char* a3 = a2 + kstep; const char* b3 = b2 + kstep;
      PG8_LDB(B0, 0, 0); PG8_LDB(B1, 0, 1); SCHED(); PG8_LDA(At, 0, 0); PG8_STAGE(PG8_SA(1, 1), a1 + hstep, voffA);
      WAIT_V(8); WAIT_L(0); BAR(); PG8_MMA(0, 0, At, B0); PG8_MMA(0, 1, At, B1); BAR(); SCHED();
      PG8_LDA(At, 0, 1); PG8_STAGE(PG8_SB(0, 0), b2, voffB); PG8_STAGE(PG8_SB(0, 1), b2 + hstep, voffB); PG8_STAGE(PG8_SA(0, 0), a2, voffA);
      WAIT_V(8); WAIT_L(0); BAR(); PG8_MMA(1, 0, At, B0); PG8_MMA(1, 1, At, B1); BAR(); SCHED();
      PG8_LDB(B0, 1, 0); PG8_LDB(B1, 1, 1); SCHED(); PG8_LDA(At, 1, 0); PG8_STAGE(PG8_SA(0, 1), a2 + hstep, voffA);
      WAIT_V(8); WAIT_L(0); BAR(); PG8_MMA(0, 0, At, B0); PG8_MMA(0, 1, At, B1); BAR(); SCHED();
      PG8_LDA(At, 1, 1); PG8_STAGE(PG8_SB(1, 0), b3, voffB); PG8_STAGE(PG8_SB(1, 1), b3 + hstep, voffB); PG8_STAGE(PG8_SA(1, 0), a3, voffA);
      WAIT_V(8); WAIT_L(0); BAR(); PG8_MMA(1, 0, At, B0); PG8_MMA(1, 1, At, B1); BAR(); SCHED();
    }
    if (wr == 0) BAR();
    E(acc, cur, wr, wc, fr, fq);
    if (!has_next) break;
#pragma unroll
    for (int a = 0; a < 2; ++a)
#pragma unroll
      for (int b = 0; b < 2; ++b)
#pragma unroll
        for (int m = 0; m < 4; ++m)
#pragma unroll
          for (int n = 0; n < 2; ++n) acc[a][b][m][n] = (f32x4){0.f, 0.f, 0.f, 0.f};
    cur = nxt; cA = nA; cB = nB; ++ui; nt = cur.nkt;
    if (wr == 1) BAR();
  }
  WAIT_V(0);
  BAR();
#undef PG8_SA
#undef PG8_SB
#undef PG8_STAGE
#undef PG8_LDA
#undef PG8_LDB
#undef PG8_MMA
}
}

namespace att {
constexpr int D = 128, NW = 8, QBLK = 32, KVBLK = 64;
constexpr float SCALE = 0.088388347648318440f, THR = 8.f;
constexpr int SHM_V = KVBLK * D * 2, SHM_K = KVBLK * D * 2, SHM_ATTN = 2 * SHM_V + 2 * SHM_K + NW * 64 * 4;
#define KSWZ(row, colB) ((row) * 256 + ((colB) ^ (((row) & 15) << 4)))
DEVI int crow(int r, int hi) { return (r & 3) + 8 * (r >> 2) + 4 * hi; }
DEVI void partialSM(f32x16& p0, f32x16& p1, float& m_reg, float& mn, float& alpha) {
  constexpr float Cc = SCALE * 1.4426950408889634f;
  float pmax = p0[0];
#pragma unroll
  for (int r = 1; r < 16; ++r) pmax = fmaxf(pmax, p0[r]);
#pragma unroll
  for (int r = 0; r < 16; ++r) pmax = fmaxf(pmax, p1[r]);
  { unsigned a, b; plswap(__builtin_bit_cast(unsigned, pmax), __builtin_bit_cast(unsigned, pmax), a, b); pmax = fmaxf(__builtin_bit_cast(float, a), __builtin_bit_cast(float, b)); }
  if (__builtin_expect(__all(pmax - m_reg <= THR / SCALE), 1)) { mn = m_reg; alpha = 1.f; }
  else { mn = fmaxf(m_reg, pmax); alpha = exp2_fast((m_reg - mn) * Cc); m_reg = mn; }
  const float mnC = -mn * Cc;
#pragma unroll
  for (int r = 0; r < 16; ++r) p0[r] = fmaf(p0[r], Cc, mnC);
#pragma unroll
  for (int r = 0; r < 16; ++r) p1[r] = fmaf(p1[r], Cc, mnC);
#pragma unroll
  for (int r = 0; r < 16; ++r) p0[r] = exp2_fast(p0[r]);
}
DEVI void finishSM(f32x16& p0, f32x16& p1, float alpha, float& l_reg, bf16x8& pa0, bf16x8& pa1, bf16x8& pa2, bf16x8& pa3) {
#pragma unroll
  for (int r = 0; r < 16; ++r) p1[r] = exp2_fast(p1[r]);
  float ps = 0;
#pragma unroll
  for (int r = 0; r < 16; ++r) ps += p0[r];
#pragma unroll
  for (int r = 0; r < 16; ++r) ps += p1[r];
  { unsigned a, b; plswap(__builtin_bit_cast(unsigned, ps), __builtin_bit_cast(unsigned, ps), a, b); ps = __builtin_bit_cast(float, a) + __builtin_bit_cast(float, b); }
  l_reg = l_reg * alpha + ps;
#define PK4(P, BASE, OUT) do { unsigned a0 = cvtpk(P[BASE + 0], P[BASE + 1]), a1 = cvtpk(P[BASE + 2], P[BASE + 3]);   \
    unsigned b0 = cvtpk(P[BASE + 4], P[BASE + 5]), b1 = cvtpk(P[BASE + 6], P[BASE + 7]);                              \
    unsigned r00, r01, r10, r11; plswap(a0, b0, r00, r01); plswap(a1, b1, r10, r11); \
    u32x4 w = {r00, r10, r01, r11}; OUT = __builtin_bit_cast(bf16x8, w); } while (0)
  PK4(p0, 0, pa0); PK4(p0, 8, pa1); PK4(p1, 0, pa2); PK4(p1, 8, pa3);
#undef PK4
}
DEVI void finishSM_noexp(f32x16& p0, f32x16& p1, float& l_reg, bf16x8& pa0, bf16x8& pa1, bf16x8& pa2, bf16x8& pa3) {
  float ps = 0;
#pragma unroll
  for (int r = 0; r < 16; ++r) ps += p0[r];
#pragma unroll
  for (int r = 0; r < 16; ++r) ps += p1[r];
  { unsigned a, b; plswap(__builtin_bit_cast(unsigned, ps), __builtin_bit_cast(unsigned, ps), a, b); ps = __builtin_bit_cast(float, a) + __builtin_bit_cast(float, b); }
  l_reg += ps;
#define PK4(P, BASE, OUT) do { unsigned a0 = cvtpk(P[BASE + 0], P[BASE + 1]), a1 = cvtpk(P[BASE + 2], P[BASE + 3]);   \
    unsigned b0 = cvtpk(P[BASE + 4], P[BASE + 5]), b1 = cvtpk(P[BASE + 6], P[BASE + 7]);                              \
    unsigned r00, r01, r10, r11; plswap(a0, b0, r00, r01); plswap(a1, b1, r10, r11); \
    u32x4 w = {r00, r10, r01, r11}; OUT = __builtin_bit_cast(bf16x8, w); } while (0)
  PK4(p0, 0, pa0); PK4(p0, 8, pa1); PK4(p1, 0, pa2); PK4(p1, 8, pa3);
#undef PK4
}
template <class Mask> DEVI void qkt(f32x16& p0, f32x16& p1, const LAS unsigned char* Ks, const bf16x8* qr, int r32, int hi, const Mask& mask, int t) {
  mask.init(p0, p1, t);
  if constexpr (Mask::OPQ) OPAQUE(r32);
#pragma unroll
  for (int d0 = 0; d0 < 8; ++d0) { const int cb = (d0 * 16 + hi * 8) * 2;
    const bf16x8 b0 = *(const LAS bf16x8*)(Ks + KSWZ(r32, cb));
    const bf16x8 b1 = *(const LAS bf16x8*)(Ks + KSWZ(32 + r32, cb));
    p0 = mfma32(b0, qr[d0], p0);
    p1 = mfma32(b1, qr[d0], p1); }
}
DEVI int v_st(int k, int c) { const int kk = (k & ~0xC) | ((k & 4) << 1) | ((k & 8) >> 1); return ((kk >> 3) * 4 + (c >> 5)) * 512 + ((kk & 7) * 32 + (c & 31)) * 2; }
DEVI int v_rd_base(int lane) { return ((lane & 3) << 3) | (((lane >> 2) & 3) << 6) | (((lane >> 4) & 1) << 5) | (((lane >> 5) & 1) << 8); }
constexpr int v_rd_off(int d0, int ks, int half) { return d0 * 512 + ks * 4096 + half * 2048; }
template <int D0> DEVI void pv_one(f32x16& od, const LAS unsigned char* vb, bf16x8 pa0, bf16x8 pa1, bf16x8 pa2, bf16x8 pa3) {
  const s16x4 l0 = tr_read_p(vb + v_rd_off(D0, 0, 0)), h0 = tr_read_p(vb + v_rd_off(D0, 0, 1)), l1 = tr_read_p(vb + v_rd_off(D0, 1, 0)), h1 = tr_read_p(vb + v_rd_off(D0, 1, 1));
  const s16x4 l2 = tr_read_p(vb + v_rd_off(D0, 2, 0)), h2 = tr_read_p(vb + v_rd_off(D0, 2, 1)), l3 = tr_read_p(vb + v_rd_off(D0, 3, 0)), h3 = tr_read_p(vb + v_rd_off(D0, 3, 1));
#define PK(L, H) (bf16x8){L[0], L[1], L[2], L[3], H[0], H[1], H[2], H[3]}
  od = mfma32(pa0, PK(l0, h0), od);
  od = mfma32(pa1, PK(l1, h1), od);
  od = mfma32(pa2, PK(l2, h2), od);
  od = mfma32(pa3, PK(l3, h3), od);
#undef PK
}
DEVI void pv_d0(f32x16 (&o)[4], const LAS unsigned char* vb, bf16x8 pa0, bf16x8 pa1, bf16x8 pa2, bf16x8 pa3) {
  pv_one<0>(o[0], vb, pa0, pa1, pa2, pa3); pv_one<1>(o[1], vb, pa0, pa1, pa2, pa3); pv_one<2>(o[2], vb, pa0, pa1, pa2, pa3); pv_one<3>(o[3], vb, pa0, pa1, pa2, pa3);
}
struct NoMask { static constexpr bool OPQ = false; DEVI void init(f32x16& p0, f32x16& p1, int) const { p0 = f32x16{}; p1 = f32x16{}; } };
constexpr int NA_TABW = 128, NA_TABOFF = 48;
struct NaMask {
  static constexpr bool OPQ = true;
  const LAS float* tb0;
  int wb;
  int kr0, r0w;
  DEVI void init(f32x16& p0, f32x16& p1, int t) const {
    if (t < 4) { p0 = f32x16{}; p1 = f32x16{}; return; }
    const int kr = kr0 + t - 4;
    if (kr < r0w || kr >= r0w + 8) {
#pragma unroll
      for (int rg = 0; rg < 16; ++rg) { p0[rg] = -INFINITY; p1[rg] = -INFINITY; }
      return; }
    const LAS float* tb = tb0 + kr * NA_TABW;
#pragma unroll
    for (int rg = 0; rg < 16; ++rg) {
      const int k = (rg & 3) + 8 * (rg >> 2);
      const float b1 = tb[k], b2 = tb[k + 32];
      p0[rg] = (unsigned)(k + wb) < 16u ? b1 : -INFINITY; p1[rg] = (unsigned)(k + 32 + wb) < 16u ? b2 : -INFINITY;
      if ((rg & 3) == 3) CFENCE(); }
  }
};
template <bool DEEP, class Mask>
DEVI void attn_body(const bf16_t* __restrict__ Qb, const bf16_t* __restrict__ Kh, const bf16_t* __restrict__ Vh, int NT, int kshift, const Mask& mask, LAS unsigned char* lds, int wid, f32x16 (&o)[4]) {
  constexpr int ldq = 4 * DM, ldk = 4 * DM;
  int lane = LANE_ID(); OPAQUE(lane);
  const int tid = wid * 64 + lane, r32 = lane & 31, hi = lane >> 5;
  LAS unsigned char* V_lds = lds; LAS unsigned char* K_lds = lds + 2 * SHM_V;
  LAS float* wsf = (LAS float*)(lds + 2 * SHM_V + 2 * SHM_K) + wid * 64; LAS float* li_l = wsf; LAS float* al_l = wsf + 32;
  float m_reg = -1e30f, l_reg = 0; bf16x8 qr[8];
#pragma unroll
  for (int d = 0; d < 4; ++d) o[d] = f32x16{};
  const bf16_t* Qw = Qb + (long)(wid * QBLK + r32) * ldq + hi * 8;
#pragma unroll
  for (int d0 = 0; d0 < 8; ++d0) qr[d0] = *(const bf16x8*)(Qw + d0 * 16);
  const int sr = tid >> 4, sc = (tid & 15) * 8, vst0 = v_st(sr, sc), vst1 = v_st(32 + sr, sc);
  const LAS unsigned char* vb0 = V_lds + v_rd_base(lane);
  bf16x8 vsA0, vsA1, ksA0, ksA1, vsB0, vsB1, ksB0, ksB1;
#define ROW0(t) (64L * ((t) < 4 ? (t) : (t) + kshift))
#define SLOAD(S, t) do { const long r0_ = ROW0(t); vs##S##0 = *(const bf16x8*)(Vh + (r0_ + sr) * ldk + sc); vs##S##1 = *(const bf16x8*)(Vh + (r0_ + 32 + sr) * ldk + sc); \
    ks##S##0 = *(const bf16x8*)(Kh + (r0_ + sr) * ldk + sc); ks##S##1 = *(const bf16x8*)(Kh + (r0_ + 32 + sr) * ldk + sc); } while (0)
#define SWRITE(b, S) do { *(LAS bf16x8*)(V_lds + (b) * SHM_V + vst0) = vs##S##0; *(LAS bf16x8*)(V_lds + (b) * SHM_V + vst1) = vs##S##1; const int kc_ = sc * 2; \
    *(LAS bf16x8*)(K_lds + (b) * SHM_K + KSWZ(sr, kc_)) = ks##S##0; *(LAS bf16x8*)(K_lds + (b) * SHM_K + KSWZ(32 + sr, kc_)) = ks##S##1; } while (0)
#define SWAIT() WAIT_V(4)
#define RESC(a) do { if (__any((a) < 1.f)) { if (hi == 0) al_l[r32] = (a); WAIT_L(0); WSYNC(); \
    _Pragma("unroll") for (int d = 0; d < 4; ++d) _Pragma("unroll") for (int r = 0; r < 16; ++r) o[d][r] *= al_l[crow(r, hi)]; } } while (0)
  f32x16 pA0, pA1, pB0, pB1; float mnA, mnB, alA, alB; bf16x8 pa0, pa1, pa2, pa3;
  SLOAD(A, 0); WAIT_V(0); SWRITE(0, A); __syncthreads();
  qkt(pA0, pA1, K_lds, qr, r32, hi, mask, 0); partialSM(pA0, pA1, m_reg, mnA, alA);
  if constexpr (DEEP) { SLOAD(B, 1); if (2 < NT) SLOAD(A, 2); SWAIT(); SWRITE(1, B); } else { SLOAD(A, 1); WAIT_V(0); SWRITE(1, A); }
  __syncthreads();
  for (int j = 1; j + 1 < NT; j += 2) {
    SCHED(); qkt(pB0, pB1, K_lds + SHM_K, qr, r32, hi, mask, j);
    finishSM(pA0, pA1, alA, l_reg, pa0, pa1, pa2, pa3); SCHED();
    if constexpr (DEEP) SLOAD(B, j + 2); else SLOAD(A, j + 1);
    SCHED();
    pv_d0(o, vb0, pa0, pa1, pa2, pa3); partialSM(pB0, pB1, m_reg, mnB, alB);
    __syncthreads(); if constexpr (DEEP) SWAIT(); else WAIT_V(0);
    SWRITE(0, A);
    RESC(alB); __syncthreads();
    SCHED(); qkt(pA0, pA1, K_lds, qr, r32, hi, mask, j + 1);
    finishSM(pB0, pB1, alB, l_reg, pa0, pa1, pa2, pa3); SCHED();
    if constexpr (DEEP) { if (j + 3 < NT) SLOAD(A, j + 3); } else SLOAD(A, j + 2);
    SCHED();
    pv_d0(o, vb0 + SHM_V, pa0, pa1, pa2, pa3); partialSM(pA0, pA1, m_reg, mnA, alA);
    __syncthreads(); if constexpr (DEEP) { SWAIT(); SWRITE(1, B); } else { WAIT_V(0); SWRITE(1, A); }
    RESC(alA); __syncthreads();
  }
  SCHED(); qkt(pB0, pB1, K_lds + SHM_K, qr, r32, hi, mask, NT - 1);
  finishSM(pA0, pA1, alA, l_reg, pa0, pa1, pa2, pa3); SCHED();
  pv_d0(o, vb0, pa0, pa1, pa2, pa3); partialSM(pB0, pB1, m_reg, mnB, alB);
  __syncthreads(); RESC(alB);
  finishSM(pB0, pB1, alB, l_reg, pa0, pa1, pa2, pa3); SCHED();
  pv_d0(o, vb0 + SHM_V, pa0, pa1, pa2, pa3);
  if (hi == 0) li_l[r32] = l_reg; WAIT_L(0); WSYNC();
#pragma unroll
  for (int r = 0; r < 16; ++r) { const float rl = rcp_fast(li_l[crow(r, hi)]);
#pragma unroll
    for (int d = 0; d < 4; ++d) o[d][r] *= rl; }
  __syncthreads();
#undef ROW0
#undef SLOAD
#undef SWRITE
#undef SWAIT
#undef RESC
}
}

DEVI void phase_attn0(const Params& P, const Ctx& C) {
  CTX_IDS;
  unsigned char* ws = P.ws;
  const bf16_t* Pm = (const bf16_t*)(ws + WS_P); bf16_t* AO = (bf16_t*)(ws + WS_AO);
  constexpr int LDP = 4 * DM, NQB = SEQ / 256, N_NA = NB * NAH * NQB, N_CX = NB * NAH;
  LAS float* tab = (LAS float*)(C.lds + att::SHM_ATTN);
  const int r32 = lane & 31, hi = lane >> 5;
  for (int it0 = C.vcu; it0 < N_NA; it0 += C.G)
  for (int sub = 0; sub < 2; ++sub) {
    if (sub == 1 && (it0 % NQB) != 0) break;
    const int it = sub == 0 ? it0 : N_NA + it0 / NQB;
    f32x16 o[4]; size_t R0; int h;
    if (it < N_NA) {
      const int g = it % NQB; h = (it / NQB) % NAH; const int b = it / (NQB * NAH);
      for (int i = tid; i < 15 * att::NA_TABW; i += NTHR) { const int dr = i / att::NA_TABW, dc = i % att::NA_TABW - att::NA_TABOFF; tab[i] = (dc >= 0 && dc < 31) ? P.in[I_RPB][((size_t)h * 15 + dr) * 31 + dc] * (1.0f / att::SCALE) : 0.f; }
      __syncthreads();
      auto r0f = [](int r) { int v = r - 4; return v < 0 ? 0 : (v > GROWS - 8 ? GROWS - 8 : v); };
      int kr0 = r0f(4 * g), nrows = r0f(4 * g + 3) + 8 - kr0;
      if (nrows & 1) { if (kr0 + nrows < GROWS) ++nrows; else { --kr0; ++nrows; } }
      const int rq = 4 * g + (C.wave >> 1), qc = 32 * (C.wave & 1) + r32; int c0 = qc - 8; c0 = c0 < 0 ? 0 : (c0 > GW - 16 ? GW - 16 : c0);
      att::NaMask mk{tab + (7 - rq) * att::NA_TABW + 4 * hi - qc + 15 + att::NA_TABOFF, 4 * hi - c0, kr0, r0f(rq)};
      R0 = (size_t)b * TPB + CTX + 256 * g;
      att::attn_body<false>(Pm + R0 * LDP + C_QA + h * 128, Pm + (size_t)b * TPB * LDP + C_KA + h * 128, Pm + (size_t)b * TPB * LDP + C_VA + h * 128, 4 + nrows, kr0, mk, C.lds, C.wave, o);
    } else {
      const int i2 = it - N_NA; h = i2 % NAH; const int b = i2 / NAH;
      R0 = (size_t)b * TPB;
      att::attn_body<true>(Pm + R0 * LDP + C_QA + h * 128, Pm + R0 * LDP + C_KA + h * 128, Pm + R0 * LDP + C_VA + h * 128, 4, 0, att::NoMask(), C.lds, C.wave, o);
    }
    bf16_t* Ob = AO + (R0 + C.wave * 32) * DM + h * 128;
#pragma unroll
    for (int r = 0; r < 16; ++r) { const int orow = att::crow(r, hi);
#pragma unroll
      for (int d0 = 0; d0 < 4; ++d0) Ob[(size_t)orow * DM + d0 * 32 + r32] = f2bf1(o[d0][r]); }
  }
}

namespace hg {
constexpr int KS = 72;
constexpr int CS = 136;
constexpr int LDP = 4 * DM;
DEVI int chunk_of(int dir, int j) { return dir == 0 ? j : (j < NCH_CTX ? NCH_CTX - 1 - j : NCH + NCH_CTX - 1 - j); }

template <int RSB> DEVI bf16x8 frag_T(const LAS unsigned char* p0, int lane) {
  const LAS unsigned char* a = p0 + (8 * (lane >> 4) + ((lane >> 2) & 3)) * RSB + 8 * (lane & 3);
  const s16x4 lo = tr_read_p(a), hi = tr_read_p(a + 4 * RSB);
  return (bf16x8){lo[0], lo[1], lo[2], lo[3], hi[0], hi[1], hi[2], hi[3]};
}
constexpr int G2 = 4;
static_assert(NCH % G2 == 0, "chunk groups");
constexpr int KRS = 80, VRS = 272;
DEVI void phase_hg2(const Params& P, const Ctx& C) {
  CTX_IDS;
  unsigned char* ws = P.ws;
  const bf16_t* Pm = (const bf16_t*)(ws + WS_P); bf16_t* HGS = (bf16_t*)(ws + WS_HGS); const float* lbt = (const float*)(ws + WS_LB);
  LAS unsigned char* KR = C.lds;
  LAS unsigned char* VR = C.lds + G2 * 64 * KRS;
  LAS float* segt = (LAS float*)(C.lds + G2 * 64 * (KRS + VRS));
  LAS float* gv = segt + G2 * 512;
  static_assert(G2 * 64 * (KRS + VRS) + G2 * 2048 + G2 * 128 <= LDS_RING, "hg2 lds");
  const int ch = tid & 31, seg = tid >> 5, l15 = lane & 15, l4 = lane >> 4;
  constexpr int NIT = NB * HGH * 2 * 4;
  for (int it = C.vcu; it < NIT; it += C.G) {
    const int dkq = it & 3, dir = (it >> 2) & 1, h = (it >> 3) % HGH, b = it / (8 * HGH);
    const int scan = (b * HGH + h) * 2 + dir;
    const float lb = lbt[dir * NAW + h * 128 + dkq * 32 + ch];
    const bf16_t* zp = Pm + (size_t)b * TPB * LDP + (dir ? C_ZB : C_ZF) + h * 128 + dkq * 32 + ch;
    const bf16_t* vp = Pm + (size_t)b * TPB * LDP + C_IB + h * 128;
    f32x4 acc[2]; acc[0] = (f32x4){0.f, 0.f, 0.f, 0.f}; acc[1] = acc[0];
    bf16_t zr[G2][4]; bf16x8 vr[G2][2];
#define HG2_LOADZ(grp) do { _Pragma("unroll") for (int g = 0; g < G2; ++g) { const int c_ = chunk_of(dir, (grp) * G2 + g); \
      _Pragma("unroll") for (int i = 0; i < 4; ++i) { const int u = 4 * seg + i, tok = dir ? 63 - u : u; zr[g][i] = zp[(size_t)(64 * c_ + tok) * LDP]; } } } while (0)
#define HG2_LOADV(grp) do { _Pragma("unroll") for (int g = 0; g < G2; ++g) { const int c_ = chunk_of(dir, (grp) * G2 + g); \
      _Pragma("unroll") for (int i = 0; i < 2; ++i) { const int idx = tid + 512 * i; vr[g][i] = *(const bf16x8*)(vp + (size_t)(64 * c_ + (idx >> 4)) * LDP + 8 * (idx & 15)); } } } while (0)
    HG2_LOADZ(0); HG2_LOADV(0);
    for (int grp = 0; grp < NCH / G2; ++grp) {
      float fk[G2][4], pl[G2][4];
#pragma unroll
      for (int g = 0; g < G2; ++g) { float run = 0.f;
#pragma unroll
        for (int i = 0; i < 4; ++i) { const float z = bf1(zr[g][i]), e = __expf(-z), sg = rcp_fast(1.0f + e); const float f = lb + (1.0f - lb) * sg; fk[g][i] = (1.0f - lb) * e * sg; run += __log2f(f); pl[g][i] = run; }
        segt[(g * 16 + seg) * 32 + ch] = run; }
      const int gnx = grp + 1 < NCH / G2 ? grp + 1 : grp;
      HG2_LOADZ(gnx);
      __syncthreads();
#pragma unroll
      for (int g = 0; g < G2; ++g) { float off = 0.f, tot = 0.f;
#pragma unroll
        for (int s2 = 0; s2 < 16; ++s2) { const float v = segt[(g * 16 + s2) * 32 + ch]; tot += v; off += (s2 < seg) ? v : 0.f; }
#pragma unroll
        for (int i = 0; i < 4; ++i) { const int u = 4 * seg + i, tok = dir ? 63 - u : u; *(LAS bf16_t*)(KR + (g * 64 + tok) * KRS + 2 * ch) = f2bf1(fk[g][i] * exp2_fast(tot - (off + pl[g][i]))); }
        if (seg == 0) gv[g * 32 + ch] = exp2_fast(tot);
#pragma unroll
        for (int i = 0; i < 2; ++i) { const int idx = tid + 512 * i; *(LAS bf16x8*)(VR + (g * 64 + (idx >> 4)) * VRS + 16 * (idx & 15)) = vr[g][i]; } }
      HG2_LOADV(gnx);
      __syncthreads();
      f32x4 U[G2][2];
#pragma unroll
      for (int g = 0; g < G2; ++g) {
        bf16x8 bb[2];
#pragma unroll
        for (int ks = 0; ks < 2; ++ks) bb[ks] = frag_T<VRS>(VR + (g * 64 + 32 * ks) * VRS + 32 * C.wave, lane);
#pragma unroll
        for (int mt = 0; mt < 2; ++mt) { f32x4 u4 = (f32x4){0.f, 0.f, 0.f, 0.f};
#pragma unroll
          for (int ks = 0; ks < 2; ++ks) u4 = mfma16(frag_T<KRS>(KR + (g * 64 + 32 * ks) * KRS + 32 * mt, lane), bb[ks], u4);
          U[g][mt] = u4; } }
      const int dv = C.wave * 16 + l15;
#pragma unroll
      for (int g = 0; g < G2; ++g) { const int c = chunk_of(dir, grp * G2 + g);
#pragma unroll
        for (int mt = 0; mt < 2; ++mt) { u32x2 w; w.x = cvtpk(acc[mt][0], acc[mt][1]); w.y = cvtpk(acc[mt][2], acc[mt][3]);
          *(u32x2*)(HGS + (((size_t)scan * NCH + c) * 128 + dv) * 128 + dkq * 32 + mt * 16 + 4 * l4) = w;
          const f32x4 g4 = *(const LAS f32x4*)(gv + g * 32 + mt * 16 + 4 * l4); acc[mt] = acc[mt] * g4 + U[g][mt]; } }
    }
    __syncthreads();
#undef HG2_LOADZ
#undef HG2_LOADV
  }
}

DEVI void phase_hg3(const Params& P, const Ctx& C) {
  CTX_IDS;
  unsigned char* ws = P.ws;
  const bf16_t* Pm = (const bf16_t*)(ws + WS_P); const bf16_t* HGS = (const bf16_t*)(ws + WS_HGS); const float* lbt = (const float*)(ws + WS_LB); bf16_t* AO = (bf16_t*)(ws + WS_AO);
  constexpr int SZ_T = 64 * CS * 2;
  LAS bf16_t* QA = (LAS bf16_t*)(C.lds); LAS bf16_t* KA = (LAS bf16_t*)(C.lds + SZ_T); LAS bf16_t* QI = (LAS bf16_t*)(C.lds + 2 * SZ_T);
  LAS unsigned char* VR = C.lds + 3 * SZ_T;
  LAS bf16_t* AT = (LAS bf16_t*)(C.lds + 3 * SZ_T + 64 * VRS);
  LAS float* segt = (LAS float*)(C.lds + 3 * SZ_T + 64 * VRS + 64 * KS * 2);
  LAS float* OS = segt + 512;
  static_assert(3 * SZ_T + 64 * VRS + 64 * KS * 2 + 2048 + 64 * 132 * 4 <= LDS_RING, "hg3 lds");
  const int ch = tid & 127, seg = tid >> 7, l15 = lane & 15, l4 = lane >> 4;
  constexpr int NIT = NB * HGH * NCH;
  int it = C.bid; if (it >= NIT) return;
  bf16_t zr[16], qr[16]; bf16x8 sfn[4], vr[2], gr[2];
#define HG3_PRE(it_, dir_) do { const int c_ = (it_) % NCH, h_ = ((it_) / NCH) % HGH, b_ = (it_) / (NCH * HGH); const size_t R0_ = (size_t)b_ * TPB + 64 * c_; \
    const bf16_t* zp_ = Pm + R0_ * LDP + ((dir_) ? C_ZB : C_ZF) + h_ * 128 + ch; const bf16_t* qp_ = Pm + R0_ * LDP + C_QB + h_ * 128 + ch; \
    _Pragma("unroll") for (int i = 0; i < 16; ++i) { const int u = 16 * seg + i, tok = (dir_) ? 63 - u : u; zr[i] = zp_[(size_t)tok * LDP]; qr[i] = qp_[(size_t)tok * LDP]; } \
    const bf16_t* Sb_ = HGS + (((size_t)((b_ * HGH + h_) * 2 + (dir_)) * NCH + c_) * 128 + C.wave * 16 + l15) * 128 + 8 * l4; \
    _Pragma("unroll") for (int ks = 0; ks < 4; ++ks) sfn[ks] = *(const bf16x8*)(Sb_ + 32 * ks); } while (0)
#define HG3_PREV(it_) do { const int c_ = (it_) % NCH, h_ = ((it_) / NCH) % HGH, b_ = (it_) / (NCH * HGH); const size_t R0_ = (size_t)b_ * TPB + 64 * c_; \
    _Pragma("unroll") for (int i = 0; i < 2; ++i) { const int idx = tid + 512 * i; vr[i] = *(const bf16x8*)(Pm + (R0_ + (idx >> 4)) * LDP + C_IB + h_ * 128 + 8 * (idx & 15)); } } while (0)
  HG3_PRE(it, 0); HG3_PREV(it);
  for (;;) {
    const int c = it % NCH, h = (it / NCH) % HGH, b = it / (NCH * HGH);
    const size_t R0 = (size_t)b * TPB + 64 * c;
    f32x4 acc[4];
#pragma unroll
    for (int mt = 0; mt < 4; ++mt) acc[mt] = (f32x4){0.f, 0.f, 0.f, 0.f};
#pragma unroll
    for (int dir = 0; dir < 2; ++dir) {
      const float lb = lbt[dir * NAW + h * 128 + ch];
      float fk[16], pl[16], qv[16]; float run = 0.f;
#pragma unroll
      for (int i = 0; i < 16; ++i) { const float z = bf1(zr[i]); qv[i] = bf1(qr[i]);
        const float e = __expf(-z), sg = rcp_fast(1.0f + e), f = lb + (1.0f - lb) * sg; fk[i] = (1.0f - lb) * e * sg; run += __log2f(f); pl[i] = run; }
      bf16x8 sf[4];
#pragma unroll
      for (int ks = 0; ks < 4; ++ks) sf[ks] = sfn[ks];
      segt[ch * 4 + seg] = run;
      if (dir == 0) {
#pragma unroll
        for (int i = 0; i < 2; ++i) { const int idx = tid + 512 * i; *(LAS bf16x8*)(VR + (idx >> 4) * VRS + 16 * (idx & 15)) = vr[i]; } }
      __syncthreads();
      if (dir == 0) { HG3_PRE(it, 1);
        const bf16_t* gp = Pm + (R0 + (tid >> 3)) * LDP + C_GB + h * 128 + (tid & 7) * 16; gr[0] = *(const bf16x8*)gp; gr[1] = *(const bf16x8*)(gp + 8); }
      else if (it + C.G < NIT) { HG3_PRE(it + C.G, 0); HG3_PREV(it + C.G); }
      const f32x4 st = *(const LAS f32x4*)(segt + ch * 4);
      const float off = (seg > 0 ? st.x : 0.f) + (seg > 1 ? st.y : 0.f) + (seg > 2 ? st.z : 0.f), mid = st.x + st.y;
#pragma unroll
      for (int i = 0; i < 16; ++i) { const int u = 16 * seg + i, tok = dir ? 63 - u : u; const float cu = off + pl[i];
        QI[tok * CS + ch] = f2bf1(qv[i] * exp2_fast(cu)); QA[tok * CS + ch] = f2bf1(qv[i] * exp2_fast(cu - mid)); KA[tok * CS + ch] = f2bf1(fk[i] * exp2_fast(mid - cu)); }
      __syncthreads();
      { const int mt = C.wave >> 1;
#pragma unroll
        for (int q2 = 0; q2 < 2; ++q2) { const int nt = 2 * (C.wave & 1) + q2; f32x4 a4 = (f32x4){0.f, 0.f, 0.f, 0.f};
#pragma unroll
          for (int ks = 0; ks < 4; ++ks) { const bf16x8 a = *(const LAS bf16x8*)(QA + (16 * mt + l15) * CS + 32 * ks + 8 * l4), bb = *(const LAS bf16x8*)(KA + (16 * nt + l15) * CS + 32 * ks + 8 * l4); a4 = mfma16(a, bb, a4); }
#pragma unroll
          for (int r = 0; r < 4; ++r) { const int t = 16 * mt + 4 * l4 + r, s2 = 16 * nt + l15; const bool keep = dir ? (s2 >= t) : (s2 <= t); AT[t * KS + s2] = keep ? f2bf1(a4[r]) : (bf16_t)0; } } }
      __syncthreads();
      { bf16x8 vb[2];
#pragma unroll
        for (int ks = 0; ks < 2; ++ks) vb[ks] = frag_T<VRS>(VR + (32 * ks) * VRS + 32 * C.wave, lane);
#pragma unroll
        for (int mt = 0; mt < 4; ++mt) {
#pragma unroll
          for (int ks = 0; ks < 2; ++ks) { const bf16x8 a = *(const LAS bf16x8*)(AT + (16 * mt + l15) * KS + 32 * ks + 8 * l4); acc[mt] = mfma16(a, vb[ks], acc[mt]); }
#pragma unroll
          for (int ks = 0; ks < 4; ++ks) { const bf16x8 a = *(const LAS bf16x8*)(QI + (16 * mt + l15) * CS + 32 * ks + 8 * l4); acc[mt] = mfma16(a, sf[ks], acc[mt]); } } }
      __syncthreads();
    }
#pragma unroll
    for (int mt = 0; mt < 4; ++mt)
#pragma unroll
      for (int r = 0; r < 4; ++r) OS[(16 * mt + 4 * l4 + r) * 132 + C.wave * 16 + l15] = acc[mt][r];
    __syncthreads();
    { const int t = tid >> 3, part = tid & 7; const LAS float* op = OS + t * 132 + part * 16; float v[16]; float ss = 0.f;
#pragma unroll
      for (int e = 0; e < 16; ++e) { v[e] = op[e]; ss += v[e] * v[e]; }
      ss += __shfl_xor(ss, 1); ss += __shfl_xor(ss, 2); ss += __shfl_xor(ss, 4);
      const float rinv = rsq_fast(ss * (1.0f / 128.0f) + EPS);
      const float* gn = P.in[I_GNG] + part * 16;
      unsigned w[8];
#pragma unroll
      for (int e = 0; e < 8; e += 2) { w[e >> 1] = cvtpk(v[e] * rinv * gn[e] * bf1((bf16_t)gr[0][e]), v[e + 1] * rinv * gn[e + 1] * bf1((bf16_t)gr[0][e + 1]));
        w[4 + (e >> 1)] = cvtpk(v[8 + e] * rinv * gn[8 + e] * bf1((bf16_t)gr[1][e]), v[9 + e] * rinv * gn[9 + e] * bf1((bf16_t)gr[1][e + 1])); }
      bf16_t* dst = AO + (R0 + t) * DM + NAW + h * 128 + part * 16;
      *(u32x4*)dst = (u32x4){w[0], w[1], w[2], w[3]}; *(u32x4*)(dst + 8) = (u32x4){w[4], w[5], w[6], w[7]}; }
    __syncthreads();
    it += C.G; if (it >= NIT) break;
  }
#undef HG3_PRE
#undef HG3_PREV
}
}

namespace att2 {
using att::crow; using att::partialSM; using att::finishSM; using att::finishSM_noexp; using att::v_rd_base; using att::SCALE;
constexpr int SHM_K = 16384, SHM_V = 32768, OFF_V = SHM_K, OFF_Q = SHM_K + 2 * SHM_V, OFF_WS = OFF_Q + 65536, SHM_TOTAL = OFF_WS + 8 * 64 * 4;
static_assert(SHM_TOTAL <= LDS_CTLW, "att2 lds");
DEVI int v_st(int k, int c) { const int kk = (k & ~0xC) | ((k & 4) << 1) | ((k & 8) >> 1); return ((kk >> 3) * 8 + (c >> 5)) * 512 + ((kk & 7) * 32 + (c & 31)) * 2; }
constexpr int v_rd_off(int d0, int ks, int half) { return d0 * 512 + ks * 8192 + half * 4096; }
template <int D0> DEVI void pv_one(f32x16& od, const LAS unsigned char* vb, bf16x8 pa0, bf16x8 pa1, bf16x8 pa2, bf16x8 pa3) {
  const s16x4 l0 = tr_read_p(vb + v_rd_off(D0, 0, 0)), h0 = tr_read_p(vb + v_rd_off(D0, 0, 1)), l1 = tr_read_p(vb + v_rd_off(D0, 1, 0)), h1 = tr_read_p(vb + v_rd_off(D0, 1, 1));
  const s16x4 l2 = tr_read_p(vb + v_rd_off(D0, 2, 0)), h2 = tr_read_p(vb + v_rd_off(D0, 2, 1)), l3 = tr_read_p(vb + v_rd_off(D0, 3, 0)), h3 = tr_read_p(vb + v_rd_off(D0, 3, 1));
#define PK(L, H) (bf16x8){L[0], L[1], L[2], L[3], H[0], H[1], H[2], H[3]}
  od = mfma32(pa0, PK(l0, h0), od);
  od = mfma32(pa1, PK(l1, h1), od);
  od = mfma32(pa2, PK(l2, h2), od);
  od = mfma32(pa3, PK(l3, h3), od);
#undef PK
}
template <bool FIXEDREF>
DEVI void attn256_pass(const bf16_t* __restrict__ Qb, const bf16_t* __restrict__ Kh, const bf16_t* __restrict__ Vh, int NT, LAS unsigned char* lds, int wid, f32x16 (&o)[8], float mref) {
  constexpr int ld = 4 * DM;
  int lane = LANE_ID(); OPAQUE(lane);
  const int tid = wid * 64 + lane, r32 = lane & 31, hi = lane >> 5;
  LAS unsigned char* K_lds = lds; LAS unsigned char* V_lds = lds + OFF_V; LAS unsigned char* Q_lds = lds + OFF_Q + wid * 8192;
  LAS float* wsf = (LAS float*)(lds + OFF_WS) + wid * 64; LAS float* li_l = wsf; LAS float* al_l = wsf + 32;
  {
#pragma unroll
    for (int i = 0; i < 8; ++i) { const int row = 4 * i + (lane >> 4), c = lane & 15; const bf16x8 v = *(const bf16x8*)(Qb + (long)(wid * 32 + row) * ld + 8 * c); *(LAS bf16x8*)(Q_lds + KSWZ(row, 16 * c)) = v; }
  }
  float m_reg = -1e30f, l_reg = 0;
#pragma unroll
  for (int d = 0; d < 8; ++d) o[d] = f32x16{};
  const int sr = tid >> 4, sc = (tid & 15) * 8;
  const LAS unsigned char* vb0 = V_lds + v_rd_base(lane);
  bf16x8 ks0, ks1, vs0, vs1, vs2, vs3;
#define A2_SLOAD(t) do { const long r0_ = 64L * (t); ks0 = *(const bf16x8*)(Kh + (r0_ + sr) * ld + sc); ks1 = *(const bf16x8*)(Kh + (r0_ + 32 + sr) * ld + sc); \
    vs0 = *(const bf16x8*)(Vh + (r0_ + (tid >> 5)) * ld + 8 * (tid & 31)); vs1 = *(const bf16x8*)(Vh + (r0_ + 16 + (tid >> 5)) * ld + 8 * (tid & 31)); \
    vs2 = *(const bf16x8*)(Vh + (r0_ + 32 + (tid >> 5)) * ld + 8 * (tid & 31)); vs3 = *(const bf16x8*)(Vh + (r0_ + 48 + (tid >> 5)) * ld + 8 * (tid & 31)); } while (0)
#define A2_SWRITE(b) do { const int kc_ = sc * 2; *(LAS bf16x8*)(K_lds + KSWZ(sr, kc_)) = ks0; *(LAS bf16x8*)(K_lds + KSWZ(32 + sr, kc_)) = ks1; \
    LAS unsigned char* vd_ = V_lds + (b) * SHM_V; const int vr_ = tid >> 5, vc_ = 8 * (tid & 31); \
    *(LAS bf16x8*)(vd_ + v_st(vr_, vc_)) = vs0; *(LAS bf16x8*)(vd_ + v_st(16 + vr_, vc_)) = vs1; *(LAS bf16x8*)(vd_ + v_st(32 + vr_, vc_)) = vs2; *(LAS bf16x8*)(vd_ + v_st(48 + vr_, vc_)) = vs3; } while (0)
  A2_SLOAD(0); A2_SWRITE(0); if (1 < NT) A2_SLOAD(1);
  for (int t = 0; t < NT; ++t) {
    __syncthreads();
    f32x16 p0 = f32x16{}, p1 = f32x16{};
#pragma unroll
    for (int d0 = 0; d0 < 8; ++d0) { const int cb = (d0 * 16 + hi * 8) * 2;
      const bf16x8 b0 = *(const LAS bf16x8*)(K_lds + KSWZ(r32, cb)), b1 = *(const LAS bf16x8*)(K_lds + KSWZ(32 + r32, cb)), q = *(const LAS bf16x8*)(Q_lds + KSWZ(r32, cb));
      p0 = mfma32(b0, q, p0); p1 = mfma32(b1, q, p1); }
    float mn, al; bf16x8 pa0, pa1, pa2, pa3;
    if constexpr (FIXEDREF) {
      constexpr float Cc = SCALE * 1.4426950408889634f; const float mC = -mref * 1.4426950408889634f;
#pragma unroll
      for (int r = 0; r < 16; ++r) { p0[r] = exp2_fast(fmaf(p0[r], Cc, mC)); p1[r] = exp2_fast(fmaf(p1[r], Cc, mC)); }
      finishSM_noexp(p0, p1, l_reg, pa0, pa1, pa2, pa3);
    } else {
    partialSM(p0, p1, m_reg, mn, al);
    if (__any(al < 1.f)) { if (hi == 0) al_l[r32] = al; WAIT_L(0); WSYNC();
#pragma unroll
      for (int d = 0; d < 8; ++d)
#pragma unroll
        for (int r = 0; r < 16; ++r) o[d][r] *= al_l[crow(r, hi)]; }
    finishSM(p0, p1, al, l_reg, pa0, pa1, pa2, pa3);
    }
    __syncthreads();
    if (t + 1 < NT) { A2_SWRITE((t + 1) & 1); if (t + 2 < NT) A2_SLOAD(t + 2); }
    const LAS unsigned char* vb = vb0 + (t & 1) * SHM_V;
    pv_one<0>(o[0], vb, pa0, pa1, pa2, pa3); pv_one<1>(o[1], vb, pa0, pa1, pa2, pa3); pv_one<2>(o[2], vb, pa0, pa1, pa2, pa3); pv_one<3>(o[3], vb, pa0, pa1, pa2, pa3);
    pv_one<4>(o[4], vb, pa0, pa1, pa2, pa3); pv_one<5>(o[5], vb, pa0, pa1, pa2, pa3); pv_one<6>(o[6], vb, pa0, pa1, pa2, pa3); pv_one<7>(o[7], vb, pa0, pa1, pa2, pa3);
  }
  if (hi == 0) li_l[r32] = l_reg; WAIT_L(0); WSYNC();
#pragma unroll
  for (int r = 0; r < 16; ++r) { const float rl = rcp_fast(li_l[crow(r, hi)]);
#pragma unroll
    for (int d = 0; d < 8; ++d) o[d][r] *= rl; }
  __syncthreads();
#undef A2_SLOAD
#undef A2_SWRITE
}
DEVI void attn256_pass_fixed(const bf16_t* __restrict__ Qb, const bf16_t* __restrict__ Kh, const bf16_t* __restrict__ Vh, int NT, LAS unsigned char* lds, int wid, f32x16 (&o)[8], float mref) {
  constexpr int ld = 4 * DM, FK = 0, FV = 2 * SHM_K, FQ = 2 * SHM_K + 2 * SHM_V;
  static_assert(FQ + 65536 <= LDS_BYTES, "att2 fixed lds");
  int lane = LANE_ID(); OPAQUE(lane);
  const int tid = wid * 64 + lane, r32 = lane & 31, hi = lane >> 5;
  LAS unsigned char* K_lds = lds + FK; LAS unsigned char* V_lds = lds + FV; LAS unsigned char* Q_lds = lds + FQ + wid * 8192;
#pragma unroll
  for (int i = 0; i < 8; ++i) { const int row = 4 * i + (lane >> 4), c = lane & 15; const bf16x8 v = *(const bf16x8*)(Qb + (long)(wid * 32 + row) * ld + 8 * c); *(LAS bf16x8*)(Q_lds + KSWZ(row, 16 * c)) = v; }
  float l_reg = 0;
#pragma unroll
  for (int d = 0; d < 8; ++d) o[d] = f32x16{};
  const int sr = tid >> 4, sc = (tid & 15) * 8;
  const LAS unsigned char* vb0 = V_lds + v_rd_base(lane);
  bf16x8 ks0, ks1, vs0, vs1, vs2, vs3;
#define A2_SLOAD(t) do { const long r0_ = 64L * (t); ks0 = *(const bf16x8*)(Kh + (r0_ + sr) * ld + sc); ks1 = *(const bf16x8*)(Kh + (r0_ + 32 + sr) * ld + sc); \
    vs0 = *(const bf16x8*)(Vh + (r0_ + (tid >> 5)) * ld + 8 * (tid & 31)); vs1 = *(const bf16x8*)(Vh + (r0_ + 16 + (tid >> 5)) * ld + 8 * (tid & 31)); \
    vs2 = *(const bf16x8*)(Vh + (r0_ + 32 + (tid >> 5)) * ld + 8 * (tid & 31)); vs3 = *(const bf16x8*)(Vh + (r0_ + 48 + (tid >> 5)) * ld + 8 * (tid & 31)); } while (0)
#define A2_SWRITE(b) do { const int kc_ = sc * 2; LAS unsigned char* kd_ = K_lds + (b) * SHM_K; *(LAS bf16x8*)(kd_ + KSWZ(sr, kc_)) = ks0; *(LAS bf16x8*)(kd_ + KSWZ(32 + sr, kc_)) = ks1; \
    LAS unsigned char* vd_ = V_lds + (b) * SHM_V; const int vr_ = tid >> 5, vc_ = 8 * (tid & 31); \
    *(LAS bf16x8*)(vd_ + v_st(vr_, vc_)) = vs0; *(LAS bf16x8*)(vd_ + v_st(16 + vr_, vc_)) = vs1; *(LAS bf16x8*)(vd_ + v_st(32 + vr_, vc_)) = vs2; *(LAS bf16x8*)(vd_ + v_st(48 + vr_, vc_)) = vs3; } while (0)
  constexpr float Cc = SCALE * 1.4426950408889634f; const float mC = -mref * 1.4426950408889634f;
  A2_SLOAD(0); A2_SWRITE(0); if (1 < NT) A2_SLOAD(1);
  for (int t = 0; t < NT; ++t) {
    __syncthreads();
    if (t + 1 < NT) { A2_SWRITE((t + 1) & 1); if (t + 2 < NT) A2_SLOAD(t + 2); }
    const LAS unsigned char* Kb = K_lds + (t & 1) * SHM_K;
    f32x16 p0 = f32x16{}, p1 = f32x16{};
#pragma unroll
    for (int d0 = 0; d0 < 8; ++d0) { const int cb = (d0 * 16 + hi * 8) * 2;
      const bf16x8 b0 = *(const LAS bf16x8*)(Kb + KSWZ(r32, cb)), b1 = *(const LAS bf16x8*)(Kb + KSWZ(32 + r32, cb)), q = *(const LAS bf16x8*)(Q_lds + KSWZ(r32, cb));
      p0 = mfma32(b0, q, p0); p1 = mfma32(b1, q, p1); }
#pragma unroll
    for (int r = 0; r < 16; ++r) { p0[r] = exp2_fast(fmaf(p0[r], Cc, mC)); p1[r] = exp2_fast(fmaf(p1[r], Cc, mC)); }
    bf16x8 pa0, pa1, pa2, pa3;
    finishSM_noexp(p0, p1, l_reg, pa0, pa1, pa2, pa3);
    const LAS unsigned char* vb = vb0 + (t & 1) * SHM_V;
    pv_one<0>(o[0], vb, pa0, pa1, pa2, pa3); pv_one<1>(o[1], vb, pa0, pa1, pa2, pa3); pv_one<2>(o[2], vb, pa0, pa1, pa2, pa3); pv_one<3>(o[3], vb, pa0, pa1, pa2, pa3);
    pv_one<4>(o[4], vb, pa0, pa1, pa2, pa3); pv_one<5>(o[5], vb, pa0, pa1, pa2, pa3); pv_one<6>(o[6], vb, pa0, pa1, pa2, pa3); pv_one<7>(o[7], vb, pa0, pa1, pa2, pa3);
  }
  __syncthreads();
  LAS float* li_l = (LAS float*)(lds + FK) + wid * 32;
  if (hi == 0) li_l[r32] = l_reg; WAIT_L(0); WSYNC();
#pragma unroll
  for (int r = 0; r < 16; ++r) { const float rl = rcp_fast(li_l[crow(r, hi)]);
#pragma unroll
    for (int d = 0; d < 8; ++d) o[d][r] *= rl; }
  __syncthreads();
#undef A2_SLOAD
#undef A2_SWRITE
}
}

DEVI void phase_diffattn(const Params& P, const Ctx& C) {
  unsigned char* ws = P.ws;
  const bf16_t* Pm = (const bf16_t*)(ws + WS_P); bf16_t* AO = (bf16_t*)(ws + WS_AO);
  constexpr int LDP = 4 * DM, NQB = SEQ / 256, NIT = NB * DIFFH * NQB;
  const float lam = ((const float*)(ws + WS_MISC))[0];
  const float mref = ((const float*)(ws + WS_MISC))[1]; const bool fixedref = mref < 40.f;
  for (int it = C.vcu; it < NIT; it += C.G) {
    const int qb = it % NQB, h = (it / NQB) % DIFFH, b = it / (NQB * DIFFH);
    const size_t R0 = (size_t)b * TPB + CTX + 256 * qb, RB = (size_t)b * TPB;
    const bf16_t* Vp = Pm + RB * LDP + 2 * DM + h * 256;
    f32x16 o[8];
    if (fixedref) att2::attn256_pass_fixed(Pm + R0 * LDP + (h * 2 + 1) * 128, Pm + RB * LDP + DM + (h * 2 + 1) * 128, Vp, TPB / 64, C.lds, C.wave, o, mref);
    else att2::attn256_pass<false>(Pm + R0 * LDP + (h * 2 + 1) * 128, Pm + RB * LDP + DM + (h * 2 + 1) * 128, Vp, TPB / 64, C.lds, C.wave, o, mref);
    int ln = LANE_ID(); OPAQUE(ln);
    f32x4* stash = (f32x4*)(ws + WS_STASH) + ((size_t)C.bid * NTHR + C.wave * 64 + ln) * 32;
#pragma unroll
    for (int d = 0; d < 8; ++d)
#pragma unroll
      for (int q4 = 0; q4 < 4; ++q4) stash[d * 4 + q4] = (f32x4){o[d][4 * q4], o[d][4 * q4 + 1], o[d][4 * q4 + 2], o[d][4 * q4 + 3]} * lam;
    if (fixedref) att2::attn256_pass_fixed(Pm + R0 * LDP + (h * 2) * 128, Pm + RB * LDP + DM + (h * 2) * 128, Vp, TPB / 64, C.lds, C.wave, o, mref);
    else att2::attn256_pass<false>(Pm + R0 * LDP + (h * 2) * 128, Pm + RB * LDP + DM + (h * 2) * 128, Vp, TPB / 64, C.lds, C.wave, o, mref);
    OPAQUE(ln); stash = (f32x4*)(ws + WS_STASH) + ((size_t)C.bid * NTHR + C.wave * 64 + ln) * 32;
    const int r32 = ln & 31, hi = ln >> 5;
#pragma unroll
    for (int d = 0; d < 8; ++d)
#pragma unroll
      for (int q4 = 0; q4 < 4; ++q4) { const f32x4 t = stash[d * 4 + q4]; o[d][4 * q4] -= t.x; o[d][4 * q4 + 1] -= t.y; o[d][4 * q4 + 2] -= t.z; o[d][4 * q4 + 3] -= t.w; }
    const float* sg = P.in[I_SUBG];
    bf16_t* Ob = AO + (R0 + C.wave * 32) * DM + h * 256;
#pragma unroll
    for (int r = 0; r < 16; ++r) {
      float v = 0.f;
#pragma unroll
      for (int d = 0; d < 8; ++d) v += o[d][r] * o[d][r];
      v += SHFL_XOR_LN(v, 1, ln); v += SHFL_XOR_LN(v, 2, ln); v += SHFL_XOR_LN(v, 4, ln); v += SHFL_XOR_LN(v, 8, ln); v += SHFL_XOR_LN(v, 16, ln);
      const float rinv = (1.0f - LAM_INIT) * rsq_fast(v * (1.0f / 256.0f) + EPS); const int orow = att::crow(r, hi);
#pragma unroll
      for (int d = 0; d < 8; ++d) { const int col = 32 * d + r32; Ob[(size_t)orow * DM + col] = f2bf1(o[d][r] * rinv * sg[col]); } }
  }
}

__global__ void __launch_bounds__(NTHR, 1) fwd_kernel(Params P) {
  SMEM_DECL;
  cg::grid_group grid = cg::this_grid();
  Ctx C; C.lds = (LAS unsigned char*)smem_raw; C.wave = RFL((int)threadIdx.x >> 6); C.G = gridDim.x; C.bid = blockIdx.x; C.vcu = (C.G % 8 == 0) ? (C.bid % 8) * (C.G / 8) + C.bid / 8 : C.bid;
  XcdBarrier xb = xcd_barrier_post((unsigned*)(P.ws + WS_CTL), C.wave);
  if (P.ph_lo < 0) grid.sync();
  int ph = 0;
#ifndef PROBE_REP
#define PROBE_REP 1
#endif
#ifndef PROBE_DUP
#define PROBE_DUP -1
#endif
  float* xdst = (float*)(P.ws + WS_XRES);
#define PHASE(...) do { if (ph >= P.ph_lo && ph < P.ph_hi) { \
    if (ph == PROBE_DUP) { xdst = (float*)(P.ws + WS_STASH); __VA_ARGS__; xcd_barrier(xb); if (PROBE_REP >= 2) { __VA_ARGS__; xcd_barrier(xb); } if (PROBE_REP >= 3) { __VA_ARGS__; xcd_barrier(xb); } xdst = (float*)(P.ws + WS_XRES); } \
    __VA_ARGS__; if (ph + 1 < P.ph_hi) xcd_barrier(xb); } ++ph; } while (0)
  PHASE(phase_prep(P, C));
  PHASE((phase_norm<true, false>(P, C, 0, 0, P.in[I_NMIXG])));
  unsigned char* ws = P.ws;
  const float* misc = (const float*)(ws + WS_MISC);
  const float* rcos = (const float*)(ws + WS_ROPE); const float* rsin = rcos + (size_t)SEQ * 64;
  LAS float* xch = (LAS float*)(C.lds + LDS_X);
  float* slab = (float*)(ws + WS_STASH); unsigned* cntb = (unsigned*)(ws + WS_CNT); unsigned* cnt0 = cntb + 2048 * 1; unsigned* cnt1 = cntb + 2048 * 3;
  PHASE({ pg8::Gemm g{(const bf16_t*)(ws + WS_XN), (const bf16_t*)(ws + WS_WT_EVIN), DM}; pg8::Order S; S.init(MTOK / 256, EVEN_IN / 256, C.G, C.bid, false, DM / 64);
          pg8::EpiProj<0> E{(bf16_t*)(ws + WS_P), 4 * DM, misc + 64, misc + 64 + 128, rcos, rsin, xch, slab, cntb + 0}; pg8::gemm_phase(C.lds, C.wave, g, S, E); pg8::combine_proj(S, E, C.wave); });
  PHASE({ hg::phase_hg2(P, C); phase_attn0(P, C); });
  PHASE(hg::phase_hg3(P, C));
  const float* mods0 = (const float*)(ws + WS_MODS); const float* mods1 = mods0 + (size_t)(NB + 1) * 6 * DM;
  float* xres = (float*)(ws + WS_XRES);
  PHASE({ pg8::Gemm g{(const bf16_t*)(ws + WS_AO), (const bf16_t*)(ws + WS_WT_EVOUT), DM}; pg8::Order S; S.init(NB * (TILES_PB - 1), DM / 256, C.G, C.bid, true, DM / 64, pg8::KSPLIT, 0, DM / 256);
          pg8::EpiResid E{xres, xdst, mods0 + 2 * DM, nullptr, slab, cnt0, P.in[I_X], P.in[I_CTX]}; pg8::gemm_phase(C.lds, C.wave, g, S, E); pg8::combine_slices(S, E, C.wave); });
  PHASE((phase_norm<false, false>(P, C, 0, 3, P.in[I_NMLPG])));
  PHASE({ pg8::Gemm g{(const bf16_t*)(ws + WS_XN), (const bf16_t*)(ws + WS_WT_W1), DM}; pg8::Order S; S.init(MTOK / 256, DFF / 256, C.G, C.bid, false, DM / 64);
          pg8::EpiProj<2> E{(bf16_t*)(ws + WS_P), 4 * DM, nullptr, nullptr, nullptr, nullptr, xch, slab, cntb + 2048 * 2}; pg8::gemm_phase(C.lds, C.wave, g, S, E); pg8::combine_proj(S, E, C.wave); });
  PHASE({ pg8::Gemm g{(const bf16_t*)(ws + WS_P), (const bf16_t*)(ws + WS_WT_W2), DFF}; pg8::Order S; S.init(NB * (TILES_PB - 1), DM / 256, C.G, C.bid, true, DFF / 64, pg8::KSPLIT, 0, DM / 256);
          pg8::EpiResid E{xres, xdst, mods0 + 5 * DM, nullptr, slab, cnt1, nullptr, nullptr}; pg8::gemm_phase(C.lds, C.wave, g, S, E); pg8::combine_slices(S, E, C.wave); });
  PHASE((phase_norm<false, false>(P, C, 1, 0, P.in[I_NMIXG] + DM)));
  PHASE({ pg8::Gemm g{(const bf16_t*)(ws + WS_XN), (const bf16_t*)(ws + WS_WT_ODIN), DM}; pg8::Order S; S.init(MTOK / 256, ODD_IN / 256, C.G, C.bid, false, DM / 64);
          pg8::EpiProj<1> E{(bf16_t*)(ws + WS_P), 4 * DM, misc + 64 + 256, misc + 64 + 384, rcos, rsin, xch, slab, cntb + 2048 * 4}; pg8::gemm_phase(C.lds, C.wave, g, S, E); pg8::combine_proj(S, E, C.wave); });
  PHASE(phase_diffattn(P, C));
  PHASE({ pg8::Gemm g{(const bf16_t*)(ws + WS_AO), (const bf16_t*)(ws + WS_WT_ODOUT), DM}; pg8::Order S; S.init(NB * (TILES_PB - 1), DM / 256, C.G, C.bid, true, DM / 64);
          pg8::EpiResid E{xres, xdst, mods1 + 2 * DM, nullptr, nullptr, nullptr, nullptr, nullptr}; pg8::gemm_phase(C.lds, C.wave, g, S, E); });
  PHASE((phase_norm<false, true>(P, C, 1, 3, P.in[I_NMLPG] + DM)));
  PHASE({ pg8::Gemm g{(const bf16_t*)(ws + WS_XN), (const bf16_t*)(ws + WS_WT_W1) + (size_t)DFF * DM, DM}; pg8::Order S; S.init(NB * (TILES_PB - 1), DFF / 256, C.G, C.bid, true, DM / 64);
          pg8::EpiProj<2> E{(bf16_t*)(ws + WS_P), 4 * DM, nullptr, nullptr, nullptr, nullptr, xch, nullptr, nullptr}; pg8::gemm_phase(C.lds, C.wave, g, S, E); });
  PHASE({ pg8::Gemm g{(const bf16_t*)(ws + WS_P), (const bf16_t*)(ws + WS_WT_W2) + (size_t)DM * DFF, DFF}; pg8::Order S; S.init(NB * (TILES_PB - 1), DM / 256, C.G, C.bid, true, DFF / 64);
          pg8::EpiResid E{xres, xdst, mods1 + 5 * DM, P.out, nullptr, nullptr, nullptr, nullptr}; pg8::gemm_phase(C.lds, C.wave, g, S, E); });
#undef PHASE
}

constexpr int N_PHASES = 16;
extern "C" void kernel_launch(void* const* d_in, const int* in_sizes, int n_in, void* d_out, int out_size, void* d_ws, size_t ws_size, hipStream_t stream) {
  static int grid_blocks = 0;
  if (grid_blocks == 0) {
    if (n_in != 23 || ws_size < WS_END) { fprintf(stderr, "kernel_launch: unexpected n_in %d or ws %zu < %zu\n", n_in, ws_size, (size_t)WS_END); grid_blocks = -1; return; }
    int dev = 0, cus = 0, per_cu = 0;
    (void)hipGetDevice(&dev); (void)hipDeviceGetAttribute(&cus, hipDeviceAttributeMultiprocessorCount, dev);
    (void)hipFuncSetAttribute((const void*)fwd_kernel, hipFuncAttributeMaxDynamicSharedMemorySize, LDS_BYTES);
    (void)hipOccupancyMaxActiveBlocksPerMultiprocessor(&per_cu, (const void*)fwd_kernel, NTHR, (size_t)LDS_BYTES);
    if (per_cu < 1) { fprintf(stderr, "kernel_launch: occupancy query says %d blocks per CU\n", per_cu); per_cu = 1; }
    grid_blocks = cus;
  }
  if (grid_blocks < 0) return;
  (void)hipMemsetAsync((char*)d_ws + WS_CTL, 0, WS_MODS, stream);
  Params p{};
  for (int i = 0; i < 23; ++i) p.in[i] = (const float*)d_in[i];
  p.out = (float*)d_out; p.ws = (unsigned char*)d_ws; p.ph_lo = 0; p.ph_hi = N_PHASES;
#ifdef EMU
  if (getenv("EMU_PH_HI")) p.ph_hi = atoi(getenv("EMU_PH_HI"));
#endif
#ifndef EMU
  void* args[] = {&p};
  hipError_t e = hipLaunchCooperativeKernel((void*)fwd_kernel, dim3(grid_blocks), dim3(NTHR), args, LDS_BYTES, stream);
  if (e != hipSuccess) fprintf(stderr, "cooperative launch failed: %s (grid %d)\n", hipGetErrorString(e), grid_blocks);
#else
  emu::launch([p]() { fwd_kernel(p); }, dim3(grid_blocks), dim3(NTHR), LDS_BYTES);
#endif
}
```

```cpp
#include <hip/hip_runtime.h>
#include <hip/hip_cooperative_groups.h>
#include <cstdio>
#include <cstdint>
#include <cmath>
namespace cg = cooperative_groups;

typedef unsigned short bf16_t;
typedef short bf16x8 __attribute__((ext_vector_type(8)));
typedef short s16x4 __attribute__((ext_vector_type(4)));
typedef float f32x2 __attribute__((ext_vector_type(2)));
typedef float f32x4 __attribute__((ext_vector_type(4)));
typedef float f32x16 __attribute__((ext_vector_type(16)));
typedef unsigned u32x2 __attribute__((ext_vector_type(2)));
typedef unsigned u32x4 __attribute__((ext_vector_type(4)));

#ifndef EMU
#define LAS __attribute__((address_space(3)))
#define SMEM_DECL extern __shared__ __attribute__((aligned(16))) unsigned char smem_raw[]
#define BAR() __builtin_amdgcn_s_barrier()
#define WAIT_V(n) asm volatile("s_waitcnt vmcnt(" #n ")" ::: "memory")
#define WAIT_L(n) asm volatile("s_waitcnt lgkmcnt(" #n ")" ::: "memory")
#define CFENCE() asm volatile("" ::: "memory")
#define SCHED() __builtin_amdgcn_sched_barrier(0)
#define SETPRIO(n) __builtin_amdgcn_s_setprio(n)
#define GLDS16(g, l) __builtin_amdgcn_global_load_lds((const unsigned*)(g), (LAS unsigned*)(l), 16, 0, 0)
#define RFL(x) __builtin_amdgcn_readfirstlane(x)
#define OPAQUE(x) asm volatile("" : "+v"(x))
#define WSYNC() __builtin_amdgcn_wave_barrier()
typedef unsigned ldsaddr_t;
#define LDSADDR(p) ((ldsaddr_t)(uintptr_t)(p))
#define AT_LD(p) __hip_atomic_load((p), __ATOMIC_RELAXED, __HIP_MEMORY_SCOPE_AGENT)
#define AT_ADD(p, v) __hip_atomic_fetch_add((p), (v), __ATOMIC_RELAXED, __HIP_MEMORY_SCOPE_AGENT)
#define FENCE_REL() __builtin_amdgcn_fence(__ATOMIC_RELEASE, "agent")
#define FENCE_ACQ() __builtin_amdgcn_fence(__ATOMIC_ACQUIRE, "agent")
#define SLEEP1() __builtin_amdgcn_s_sleep(1)
#define ST_WT16(p, v) asm volatile("global_store_dwordx4 %0, %1, off sc1\n\ts_nop 1" :: "v"(p), "v"(v) : "memory")
#define ST_WT16U(p, v) asm volatile("global_store_dwordx4 %0, %1, off sc1\n\ts_nop 1" :: "v"(p), "v"(v) : "memory")
#define ST_WT8(p, v) asm volatile("global_store_dwordx2 %0, %1, off sc1\n\ts_nop 1" :: "v"(p), "v"(v) : "memory")
#define XCC_ID() ((unsigned)__builtin_amdgcn_s_getreg((3 << 11) | 20) & 0xFu)
#define LANE_ID() ((int)(__builtin_amdgcn_mbcnt_hi(~0u, __builtin_amdgcn_mbcnt_lo(~0u, 0u)) & 63u))
#define SHFL_XOR_LN(v, m, ln) __builtin_bit_cast(float, __builtin_amdgcn_ds_bpermute(((ln) ^ (m)) << 2, __builtin_bit_cast(int, (v))))
__device__ __forceinline__ f32x4 mfma16(bf16x8 a, bf16x8 b, f32x4 c) { return __builtin_amdgcn_mfma_f32_16x16x32_bf16(a, b, c, 0, 0, 0); }
__device__ __forceinline__ f32x16 mfma32(bf16x8 a, bf16x8 b, f32x16 c) { return __builtin_amdgcn_mfma_f32_32x32x16_bf16(a, b, c, 0, 0, 0); }
typedef __bf16 bf16x2_t __attribute__((ext_vector_type(2)));
__device__ __forceinline__ unsigned cvtpk(float lo, float hi) { f32x2 v = {lo, hi}; bf16x2_t b = __builtin_convertvector(v, bf16x2_t); return __builtin_bit_cast(unsigned, b); }
template <int OFF> __device__ __forceinline__ s16x4 tr_read(ldsaddr_t vb) { s16x4 r; asm volatile("ds_read_b64_tr_b16 %0, %1 offset:%2" : "=&v"(r) : "v"(vb), "i"(OFF) : "memory"); return r; }
typedef short v4i16_t __attribute__((ext_vector_type(4)));
__device__ __forceinline__ s16x4 tr_read_p(const LAS void* p) { return __builtin_bit_cast(s16x4, __builtin_amdgcn_ds_read_tr16_b64_v4i16((LAS v4i16_t*)p)); }
__device__ __forceinline__ void plswap(unsigned a, unsigned b, unsigned& r0, unsigned& r1) { auto rr = __builtin_amdgcn_permlane32_swap(a, b, false, false); r0 = rr[0]; r1 = rr[1]; }
__device__ __forceinline__ float exp2_fast(float x) { return __builtin_amdgcn_exp2f(x); }
__device__ __forceinline__ float rcp_fast(float x) { return __builtin_amdgcn_rcpf(x); }
__device__ __forceinline__ float rsq_fast(float x) { return __builtin_amdgcn_rsqf(x); }
#else
#define LAS
#define SMEM_DECL unsigned char* smem_raw = emu::cur->blk->smem
#define BAR() __syncthreads()
#define WAIT_V(n) do { } while (0)
#define WAIT_L(n) do { } while (0)
#define CFENCE() do { } while (0)
#define SCHED() do { } while (0)
#define SETPRIO(n) do { } while (0)
#define GLDS16(g, l) memcpy((unsigned char*)(l) + 16 * emu::cur->lane, (const void*)(g), 16)
#define RFL(x) (x)
#define OPAQUE(x) do { } while (0)
#define WSYNC() do { int z_ = 0; (void)emu::collective(&z_, 4, 20, [](unsigned char (*)[160]) {}); } while (0)
typedef uintptr_t ldsaddr_t;
#define LDSADDR(p) ((ldsaddr_t)(uintptr_t)(p))
#define AT_LD(p) (*(volatile unsigned*)(p))
static inline unsigned emu_at_add(unsigned* p, unsigned v) { unsigned o = *p; *p = o + v; return o; }
#define AT_ADD(p, v) emu_at_add((p), (v))
#define FENCE_REL() do { } while (0)
#define FENCE_ACQ() do { } while (0)
#define SLEEP1() emu::poll_yield()
#define ST_WT16(p, v) (*(f32x4*)(p) = (v))
#define ST_WT8(p, v) (*(u32x2*)(p) = (v))
#define ST_WT16U(p, v) (*(u32x4*)(p) = (v))
#define XCC_ID() ((unsigned)(emu::cur->blk->bid.x & 7u))
#define LANE_ID() (emu::cur->lane)
#define SHFL_XOR_LN(v, m, ln) __shfl_xor((v), (m))
static inline float bf2f_(short s) { unsigned u = ((unsigned)(unsigned short)s) << 16; float f; memcpy(&f, &u, 4); return f; }
static inline unsigned f2bf_(float f) { unsigned u; memcpy(&u, &f, 4); if ((u & 0x7fffffffu) > 0x7f800000u) return 0x7fc0u; return (u + 0x7fffu + ((u >> 16) & 1u)) >> 16; }
static inline f32x4 mfma16(bf16x8 a, bf16x8 b, f32x4 c) {
  struct In { bf16x8 a, b; f32x4 c; } in{a, b, c};
  int p = emu::collective(&in, sizeof(in), 10, [](unsigned char (*buf)[160]) {
    static float A[16][32], B[32][16];
    for (int l = 0; l < 64; ++l) { In x; memcpy(&x, buf[l], sizeof(x)); for (int j = 0; j < 8; ++j) { A[l & 15][8 * (l >> 4) + j] = bf2f_(x.a[j]); B[8 * (l >> 4) + j][l & 15] = bf2f_(x.b[j]); } }
    for (int l = 0; l < 64; ++l) { In x; memcpy(&x, buf[l], sizeof(x)); f32x4 d;
      for (int r = 0; r < 4; ++r) { const int row = 4 * (l >> 4) + r, col = l & 15; float acc = x.c[r]; for (int k = 0; k < 32; ++k) acc += A[row][k] * B[k][col]; d[r] = acc; }
      memcpy(buf[l] + 64, &d, 16); } });
  f32x4 d; memcpy(&d, emu::cur->wave->xbuf[p][emu::cur->lane] + 64, 16); return d;
}
static inline f32x16 mfma32(bf16x8 a, bf16x8 b, f32x16 c) {
  struct In { bf16x8 a, b; f32x16 c; } in{a, b, c};
  int p = emu::collective(&in, sizeof(in), 11, [](unsigned char (*buf)[160]) {
    static float A[32][16], B[16][32];
    for (int l = 0; l < 64; ++l) { In x; memcpy(&x, buf[l], sizeof(x)); for (int j = 0; j < 8; ++j) { A[l & 31][8 * (l >> 5) + j] = bf2f_(x.a[j]); B[8 * (l >> 5) + j][l & 31] = bf2f_(x.b[j]); } }
    for (int l = 0; l < 64; ++l) { In x; memcpy(&x, buf[l], sizeof(x)); f32x16 d;
      for (int r = 0; r < 16; ++r) { const int row = (r & 3) + 8 * (r >> 2) + 4 * (l >> 5), col = l & 31; float acc = x.c[r]; for (int k = 0; k < 16; ++k) acc += A[row][k] * B[k][col]; d[r] = acc; }
      memcpy(buf[l] + 96, &d, 64); } });
  f32x16 d; memcpy(&d, emu::cur->wave->xbuf[p][emu::cur->lane] + 96, 64); return d;
}
static inline unsigned cvtpk(float lo, float hi) { return f2bf_(lo) | (f2bf_(hi) << 16); }
template <int OFF> static inline s16x4 tr_read(ldsaddr_t vb) {
  ldsaddr_t a = vb + OFF;
  if (a & 7) { fprintf(stderr, "emu: tr_read misaligned\n"); abort(); }
  int p = emu::collective(&a, sizeof(a), 12, [](unsigned char (*)[160]) {});
  const int lane = emu::cur->lane, g = lane >> 4, i = lane & 15; s16x4 r;
  for (int q = 0; q < 4; ++q) { ldsaddr_t h; memcpy(&h, emu::cur->wave->xbuf[p][16 * g + 4 * q + (i >> 2)], sizeof(h)); r[q] = *(const short*)(h + 2 * (i & 3)); }
  return r;
}
static inline s16x4 tr_read_p(const void* p) { return tr_read<0>((ldsaddr_t)(uintptr_t)p); }
static inline void plswap(unsigned a, unsigned b, unsigned& r0, unsigned& r1) {
  unsigned in[2] = {a, b};
  int p = emu::collective(in, 8, 13, [](unsigned char (*)[160]) {});
  const int lane = emu::cur->lane; unsigned o[2]; memcpy(o, emu::cur->wave->xbuf[p][lane ^ 32], 8);
  if (lane < 32) { r0 = a; r1 = o[0]; } else { r0 = o[1]; r1 = b; }
}
static inline float exp2_fast(float x) { return exp2f(x); }
static inline float rcp_fast(float x) { return 1.0f / x; }
static inline float rsq_fast(float x) { return 1.0f / sqrtf(x); }
#endif

#define DEVI __device__ __forceinline__
DEVI float silu_f(float x) { return x * rcp_fast(1.0f + __expf(-x)); }
DEVI float bflo(unsigned w) { return __builtin_bit_cast(float, w << 16); }
DEVI float bfhi(unsigned w) { return __builtin_bit_cast(float, w & 0xffff0000u); }
DEVI float bf1(bf16_t h) { return __builtin_bit_cast(float, ((unsigned)h) << 16); }
DEVI bf16_t f2bf1(float f) { return (bf16_t)(cvtpk(f, 0.f) & 0xffffu); }
DEVI float wave_sum(float v) {
#pragma unroll
  for (int o = 1; o < 64; o <<= 1) v += __shfl_xor(v, o);
  return v;
}

#ifndef CFG_D
#define CFG_D 2048
#endif
#ifndef CFG_B
#define CFG_B 4
#endif
#ifndef CFG_SEQ
#define CFG_SEQ 2048
#endif
constexpr int DM = CFG_D, NB = CFG_B, SEQ = CFG_SEQ, CTX = 256, GW = 64;
constexpr int NAH = DM / 256, HGH = DM / 256, DIFFH = DM / 256;
constexpr int NAW = DM / 2;
constexpr int EVEN_IN = 4 * DM, ODD_IN = 3 * DM, DFF = 4 * DM;
constexpr int TPB = CTX + SEQ;
constexpr int MTOK = NB * TPB, TILES_PB = TPB / 256, GROWS = SEQ / GW;
constexpr int CHUNK = 64, NCH = TPB / CHUNK, NCH_CTX = CTX / CHUNK;
constexpr float EPS = 1e-6f;
constexpr float LAM_INIT = 0.35550906759f;
constexpr int C_QA = 0, C_KA = NAW, C_VA = 2 * NAW, C_QB = 3 * NAW, C_ZF = 4 * NAW, C_ZB = 5 * NAW, C_IB = 6 * NAW, C_GB = 7 * NAW;
static_assert(SEQ % 256 == 0 && DM % 256 == 0 && GROWS >= 8, "shape");

constexpr size_t al256(size_t x) { return (x + 255) / 256 * 256; }
constexpr size_t WS_CTL = 0;
constexpr size_t WS_CNT = 16384;
constexpr size_t WS_MODS = 16384 + 5 * 2048 * 4;
constexpr size_t WS_LB = WS_MODS + al256((size_t)2 * (NB + 1) * 6 * DM * 4);
constexpr size_t WS_ROPE = WS_LB + al256((size_t)2 * NAW * 4);
constexpr size_t WS_MISC = WS_ROPE + al256((size_t)2 * SEQ * 64 * 4);
constexpr size_t WS_WT_EVIN = WS_MISC + 4096;
constexpr size_t WS_WT_EVOUT = WS_WT_EVIN + (size_t)EVEN_IN * DM * 2;
constexpr size_t WS_WT_ODIN = WS_WT_EVOUT + (size_t)DM * DM * 2;
constexpr size_t WS_WT_ODOUT = WS_WT_ODIN + (size_t)ODD_IN * DM * 2;
constexpr size_t WS_WT_W1 = WS_WT_ODOUT + (size_t)DM * DM * 2;
constexpr size_t WS_WT_W2 = WS_WT_W1 + (size_t)2 * DFF * DM * 2;
constexpr size_t WS_XRES = WS_WT_W2 + (size_t)2 * DFF * DM * 2;
constexpr size_t WS_XN = WS_XRES + (size_t)MTOK * DM * 4;
constexpr size_t WS_P = WS_XN + (size_t)MTOK * DM * 2;
constexpr size_t WS_AO = WS_P + (size_t)MTOK * 4 * DM * 2;
constexpr size_t WS_HGS = WS_AO + (size_t)MTOK * DM * 2;
constexpr size_t WS_STASH = WS_HGS + (size_t)NB * HGH * 2 * NCH * 128 * 128 * 2;
constexpr size_t WS_END = WS_STASH + (size_t)512 * 512 * 128 * 4;

constexpr int LDS_RING = 131072;
constexpr int LDS_X = LDS_RING;
constexpr int LDS_BYTES = 163840;
constexpr int LDS_CTLW = LDS_BYTES;
constexpr int NTHR = 512, NWAVE = 8;

struct Params {
  const float* in[23];
  float* out;
  unsigned char* ws;
  int ph_lo, ph_hi;
};
enum { I_X = 0, I_C, I_CTX, I_CCTX, I_ADAW, I_ADAB, I_NMIXG, I_NMLPG, I_W1, I_W2, I_EVIN, I_EVOUT, I_NAQG, I_NAKG, I_RPB, I_LBL, I_GNG, I_ODIN, I_ODOUT, I_DFQG, I_DFKG, I_DFLAM, I_SUBG };

struct Ctx {
  LAS unsigned char* lds;
  int wave, G, bid, vcu;
};
#define CTX_IDS const int lane = LANE_ID(); const int tid = C.wave * 64 + lane; (void)tid

#define XB_TMO      128
#define XB_XCNT(j)  (256  + 64 * (j))
#define XB_XSUB(j)  (1280 + 64 * (j))
#define XB_XGEN(j)  (2304 + 64 * (j))
#define XB_TOP      3328
#define XB_TOPGEN   3392
#define XCD_BAR_WORDS 3456
#define XB_SPIN_CAP (1u << 22)
#define XB_SPIN(cond, bar) do { unsigned _sp = 0; while (cond) { SLEEP1(); \
    if ((++_sp & 255u) == 0u) { if (AT_LD(&(bar)[XB_TMO])) break; if (_sp > XB_SPIN_CAP) { AT_ADD(&(bar)[XB_TMO], 1u); break; } } } } while (0)
struct XcdBarrier { unsigned* bar; unsigned x; unsigned nloc, nx; int wave; };
DEVI XcdBarrier xcd_barrier_post(unsigned* bar, int wave) {
  XcdBarrier b; b.bar = bar; b.x = XCC_ID(); b.nloc = 0u; b.nx = 0u; b.wave = wave;
  if (wave == 0 && LANE_ID() == 0) (void)AT_ADD(&bar[XB_XCNT(b.x)], 1u);
  return b;
}
DEVI void xcd_barrier_complete(unsigned* bar, unsigned x, unsigned& nloc, unsigned& nx) {
  const unsigned G = gridDim.x;
  unsigned sum, cnt, mine, sp = 0u;
  for (;;) {
    sum = 0u; cnt = 0u; mine = 0u;
#pragma unroll
    for (unsigned j = 0; j < 16; ++j) { const unsigned c = AT_LD(&bar[XB_XCNT(j)]); sum += c; cnt += (c > 0u) ? 1u : 0u; mine = (j == x) ? c : mine; }
    if (sum == G) break;
    SLEEP1();
    if ((++sp & 255u) == 0u) { if (AT_LD(&bar[XB_TMO])) break; if (sp > XB_SPIN_CAP) { AT_ADD(&bar[XB_TMO], 1u); break; } }
  }
  nloc = mine > 0u ? mine : 1u; nx = cnt > 0u ? cnt : 1u;
}
DEVI void xcd_barrier(XcdBarrier& b) {
  WAIT_V(0);
  __syncthreads();
  unsigned nloc = b.nloc, nx = b.nx;
  if (b.wave == 0 && LANE_ID() == 0) {
    unsigned* bar = b.bar;
    if (nloc == 0u) xcd_barrier_complete(bar, b.x, nloc, nx);
    const unsigned old = AT_ADD(&bar[XB_XSUB(b.x)], 1u);
    const unsigned gen = old / nloc;
    if (old + 1u == (gen + 1u) * nloc) {
      FENCE_REL();
      WAIT_V(0);
      const unsigned og = AT_ADD(&bar[XB_TOP], 1u);
      const unsigned tg = og / nx;
      FENCE_ACQ();
      if (og + 1u == (tg + 1u) * nx) AT_ADD(&bar[XB_TOPGEN], 1u);
      else XB_SPIN(AT_LD(&bar[XB_TOPGEN]) == tg, bar);
      AT_ADD(&bar[XB_XGEN(b.x)], 1u);
      WAIT_V(0);
    } else {
      FENCE_ACQ();
      XB_SPIN(AT_LD(&bar[XB_XGEN(b.x)]) == gen, bar);
      WAIT_V(0);
    }
  }
  b.nloc = (unsigned)RFL((int)nloc); b.nx = (unsigned)RFL((int)nx);
  __syncthreads();
}

DEVI int pdim(int p) { const int c = p >> 3, e = p & 7; return e < 4 ? 4 * c + e : 64 + 4 * c + (e - 4); }
DEVI int ppos(int d) { return d < 64 ? 8 * (d >> 2) + (d & 3) : 8 * ((d - 64) >> 2) + 4 + (d & 3); }

struct TItem { const float* W; bf16_t* WT; int K, N, perm_cols, item; };
DEVI TItem t_resolve(const Params& P, int it) {
  unsigned char* ws = P.ws;
  constexpr int I_A = (DM / 64) * (EVEN_IN / 32), I_B = (DM / 64) * (DM / 32), I_C2 = (DM / 64) * (ODD_IN / 32), I_D = I_B, I_E = (DM / 64) * (DFF / 32), I_F = (DFF / 64) * (DM / 32);
  int r = it;
  if (r < I_A) return TItem{P.in[I_EVIN], (bf16_t*)(ws + WS_WT_EVIN), DM, EVEN_IN, 0, r}; r -= I_A;
  if (r < I_B) return TItem{P.in[I_EVOUT], (bf16_t*)(ws + WS_WT_EVOUT), DM, DM, 0, r}; r -= I_B;
  if (r < I_C2) return TItem{P.in[I_ODIN], (bf16_t*)(ws + WS_WT_ODIN), DM, ODD_IN, 2 * DM, r}; r -= I_C2;
  if (r < I_D) return TItem{P.in[I_ODOUT], (bf16_t*)(ws + WS_WT_ODOUT), DM, DM, 0, r}; r -= I_D;
  if (r < 2 * I_E) { const int l = r / I_E; return TItem{P.in[I_W1] + (size_t)l * DM * DFF, (bf16_t*)(ws + WS_WT_W1) + (size_t)l * DFF * DM, DM, DFF, 0, r % I_E}; } r -= 2 * I_E;
  { const int l = r / I_F; return TItem{P.in[I_W2] + (size_t)l * DFF * DM, (bf16_t*)(ws + WS_WT_W2) + (size_t)l * DM * DFF, DFF, DM, 0, r % I_F}; }
}
constexpr int T_NITEMS = (DM / 64) * (EVEN_IN / 32) + 2 * (DM / 64) * (DM / 32) + (DM / 64) * (ODD_IN / 32) + 2 * (DM / 64) * (DFF / 32) + 2 * (DFF / 64) * (DM / 32);
DEVI void t_load(const TItem& d, f32x4 (&tv)[8], int lane) {
  const int nblk = d.N / 32, kb = d.item / nblk, nb = d.item % nblk, k0 = 64 * kb, n0 = 32 * nb;
#pragma unroll
  for (int i = 0; i < 8; ++i) tv[i] = *(const f32x4*)(d.W + (size_t)(k0 + 8 * i + (lane >> 3)) * d.N + n0 + 4 * (lane & 7));
}
DEVI void t_finish(const TItem& d, const f32x4 (&tv)[8], LAS float* scr, int lane) {
  const int nblk = d.N / 32, kb = d.item / nblk, nb = d.item % nblk, k0 = 64 * kb, n0 = 32 * nb;
#pragma unroll
  for (int i = 0; i < 8; ++i) { LAS float* p = scr + (8 * i + (lane >> 3)) * 33 + 4 * (lane & 7); p[0] = tv[i].x; p[1] = tv[i].y; p[2] = tv[i].z; p[3] = tv[i].w; }
  WAIT_L(0); CFENCE(); WSYNC();
  const int c = lane & 7;
#pragma unroll
  for (int j = 0; j < 4; ++j) { const int n = (lane >> 3) + 8 * j; const LAS float* s2 = scr + (8 * c) * 33 + n;
    u32x4 o; o.x = cvtpk(s2[0 * 33], s2[1 * 33]); o.y = cvtpk(s2[2 * 33], s2[3 * 33]); o.z = cvtpk(s2[4 * 33], s2[5 * 33]); o.w = cvtpk(s2[6 * 33], s2[7 * 33]);
    int nn = n0 + n; if (nn < d.perm_cols) nn = (nn & ~127) + ppos(nn & 127);
    *(u32x4*)(d.WT + (size_t)nn * d.K + k0 + 8 * c) = o; }
  WAIT_L(0); CFENCE(); WSYNC();
}

DEVI void phase_prep(const Params& P, const Ctx& C) {
  CTX_IDS;
  unsigned char* ws = P.ws;
  {
    LAS float* sv = (LAS float*)(C.lds);
    for (int i = tid; i < (NB + 1) * DM; i += NTHR) { const int bb = i / DM, k = i % DM; const float v = bb < NB ? P.in[I_C][bb * DM + k] : P.in[I_CCTX][k]; sv[i] = silu_f(v); }
    __syncthreads();
    LAS float* red = (LAS float*)(C.lds + (NB + 1) * DM * 4);
    constexpr int NCHK = 6 * DM / 32, KW = DM / NWAVE;
    const int nitems = 2 * NCHK, rr = lane >> 3, c4 = lane & 7;
    for (int it = C.bid; it < nitems; it += C.G) {
      const int l = it / NCHK, j0 = (it % NCHK) * 32;
      const float* w = P.in[I_ADAW] + (size_t)l * DM * 6 * DM + (size_t)(C.wave * KW + rr) * 6 * DM + j0 + 4 * c4;
      f32x4 acc[NB + 1];
#pragma unroll
      for (int bb = 0; bb <= NB; ++bb) acc[bb] = (f32x4){0.f, 0.f, 0.f, 0.f};
#pragma unroll 1
      for (int k = 0; k < KW; k += 64) {
        f32x4 wv[8];
#pragma unroll
        for (int u = 0; u < 8; ++u) wv[u] = *(const f32x4*)(w + (size_t)(k + 8 * u) * 6 * DM);
#pragma unroll
        for (int u = 0; u < 8; ++u)
#pragma unroll
          for (int bb = 0; bb <= NB; ++bb) acc[bb] += wv[u] * sv[bb * DM + C.wave * KW + k + 8 * u + rr];
      }
#pragma unroll
      for (int bb = 0; bb <= NB; ++bb) {
#pragma unroll
        for (int o2 = 8; o2 < 64; o2 <<= 1) { acc[bb].x += __shfl_xor(acc[bb].x, o2); acc[bb].y += __shfl_xor(acc[bb].y, o2); acc[bb].z += __shfl_xor(acc[bb].z, o2); acc[bb].w += __shfl_xor(acc[bb].w, o2); }
        if (rr == 0) *(LAS f32x4*)(red + (C.wave * (NB + 1) + bb) * 32 + 4 * c4) = acc[bb]; }
      __syncthreads();
      if (tid < (NB + 1) * 32) { const int bb = tid / 32, ln = tid % 32; float s2 = 0.f;
#pragma unroll
        for (int w8 = 0; w8 < NWAVE; ++w8) s2 += red[(w8 * (NB + 1) + bb) * 32 + ln];
        ((float*)(ws + WS_MODS))[((size_t)l * (NB + 1) + bb) * 6 * DM + j0 + ln] = s2 + P.in[I_ADAB][(size_t)l * 6 * DM + j0 + ln]; }
      __syncthreads();
    }
  }
  {
    const int gt = C.bid * NTHR + tid, GT = C.G * NTHR;
    float* lb = (float*)(ws + WS_LB);
    for (int i = gt; i < 2 * NAW; i += GT) { const int d = i / NAW, ch = i % NAW; const float* lg = P.in[I_LBL] + (size_t)d * 3 * NAW + ch;
      const float a = lg[0], b = lg[NAW], c = lg[2 * NAW], m = fmaxf(a, fmaxf(b, c)); const float ea = expf(a - m), eb = expf(b - m), ec = expf(c - m); lb[i] = ea / (ea + eb + ec); }
    float* rc = (float*)(ws + WS_ROPE); float* rs = rc + (size_t)SEQ * 64;
    for (int i = gt; i < SEQ * 64; i += GT) { const int t = i / 64, f = i % 64; const float pos = (float)(f < 32 ? t / GW : t % GW);
      const float inv = powf(10000.0f, -(float)(f & 31) / 32.0f); const float ang = pos * inv; rc[i] = cosf(ang); rs[i] = sinf(ang); }
    float* misc = (float*)(ws + WS_MISC);
    if (gt < 128) { misc[64 + gt] = P.in[I_NAQG][gt]; misc[64 + 128 + gt] = P.in[I_NAKG][gt]; misc[64 + 256 + gt] = P.in[I_DFQG][pdim(gt)]; misc[64 + 384 + gt] = P.in[I_DFKG][pdim(gt)]; }
    if (C.bid == 0 && C.wave == 0) { const float* lp = P.in[I_DFLAM]; float s1 = 0.f, s2 = 0.f;
      for (int i = lane; i < 128; i += 64) { s1 += lp[i] * lp[128 + i]; s2 += lp[256 + i] * lp[384 + i]; }
      s1 = wave_sum(s1); s2 = wave_sum(s2); if (lane == 0) misc[0] = expf(s1) - expf(s2) + LAM_INIT; }
    if (C.bid == 0 && C.wave == 1) { float mq = 0.f, mk = 0.f;
      for (int i = lane; i < 128; i += 64) { mq = fmaxf(mq, fabsf(P.in[I_DFQG][i])); mk = fmaxf(mk, fabsf(P.in[I_DFKG][i])); }
#pragma unroll
      for (int o2 = 1; o2 < 64; o2 <<= 1) { mq = fmaxf(mq, __shfl_xor(mq, o2)); mk = fmaxf(mk, __shfl_xor(mk, o2)); }
      if (lane == 0) misc[1] = 11.3137085f * mq * mk * 1.0001f; }
  }
  {
    LAS float* scr = (LAS float*)(C.lds + C.wave * 16384);
    __syncthreads();
    const int gw = C.bid * NWAVE + C.wave, NGW = C.G * NWAVE;
    f32x4 ta[8], tb[8];
    int it = gw;
    if (it < T_NITEMS) { TItem da = t_resolve(P, it); t_load(da, ta, lane);
      for (;;) {
        const int itb = it + NGW; TItem db = da; const bool hb = itb < T_NITEMS;
        if (hb) { db = t_resolve(P, itb); t_load(db, tb, lane); }
        t_finish(da, ta, scr, lane);
        if (!hb) break;
        const int ita = itb + NGW; const bool ha = ita < T_NITEMS;
        if (ha) { da = t_resolve(P, ita); t_load(da, ta, lane); }
        t_finish(db, tb, scr, lane);
        if (!ha) break;
        it = ita;
      } }
  }
}

template <bool FIRST, bool LAT_ONLY>
DEVI void phase_norm(const Params& P, const Ctx& C, int layer, int modi, const float* g) {
  CTX_IDS;
  unsigned char* ws = P.ws;
  float* xres = (float*)(ws + WS_XRES); bf16_t* xn = (bf16_t*)(ws + WS_XN);
  const float* mods = (const float*)(ws + WS_MODS) + (size_t)layer * (NB + 1) * 6 * DM;
  const int gw = C.bid * NWAVE + C.wave, NGW = C.G * NWAVE;
  constexpr int NV = DM / 256;
  for (int R = gw; R < MTOK; R += NGW) {
    const int b = R / TPB, r = R % TPB; const bool isc = r < CTX;
    if (LAT_ONLY && isc) continue;
    const float* src = FIRST ? (isc ? P.in[I_CTX] + ((size_t)b * CTX + r) * DM : P.in[I_X] + ((size_t)b * SEQ + (r - CTX)) * DM) : xres + (size_t)R * DM;
    const float* md = mods + (size_t)(isc ? NB : b) * 6 * DM + (size_t)modi * DM;
    f32x4 v[NV]; float s = 0.f;
#pragma unroll
    for (int j = 0; j < NV; ++j) { v[j] = *(const f32x4*)(src + 256 * j + 4 * lane); s += (v[j].x * v[j].x + v[j].y * v[j].y) + (v[j].z * v[j].z + v[j].w * v[j].w); }
    const float rinv = 1.0f / sqrtf(wave_sum(s) * (1.0f / DM) + EPS);
#pragma unroll
    for (int j = 0; j < NV; j += 2) {
      u32x2 o[2];
#pragma unroll
      for (int q = 0; q < 2; ++q) { const int c0 = 256 * (j + q) + 4 * lane; const f32x4 gg = *(const f32x4*)(g + c0), sh = *(const f32x4*)(md + c0), sc = *(const f32x4*)(md + DM + c0);
        const f32x4 h = (v[j + q] * rinv) * gg * (sc + 1.0f) + sh; o[q].x = cvtpk(h.x, h.y); o[q].y = cvtpk(h.z, h.w); }
      const bool odd = lane & 1; const u32x2 snd = odd ? o[0] : o[1]; u32x2 rcv; rcv.x = (unsigned)__shfl_xor((int)snd.x, 1); rcv.y = (unsigned)__shfl_xor((int)snd.y, 1);
      const u32x4 w = odd ? (u32x4){rcv.x, rcv.y, o[1].x, o[1].y} : (u32x4){o[0].x, o[0].y, rcv.x, rcv.y};
      ST_WT16U(xn + (size_t)R * DM + 256 * (j + (odd ? 1 : 0)) + 4 * (lane & ~1), w); }
  }
}

namespace pg8 {
constexpr int BM = 256, BK = 64, HALF = 128, HTB = HALF * BK * 2, STAGE_BYTES = 8 * HTB, NXCD = 8, WGM = 4;
static_assert(STAGE_BYTES <= LDS_RING, "ring");
DEVI int lds_byte(int r, int c) { const int st = (r >> 4) * 2 + (c >> 5), rr = r & 15, cc = c & 31, ob = rr * 64 + cc * 2; return st * 1024 + (ob ^ (((ob >> 9) & 1) << 5)); }
DEVI void stage_rc(int b, int& R, int& C) { const int st = b / 1024, sb = b % 1024, swz = sb ^ (((sb >> 9) & 1) << 5); R = (st >> 1) * 16 + swz / 64; C = (st & 1) * 32 + (swz % 64) / 2; }
DEVI int perm32(int rho) { const int n = rho >> 4, i = rho & 15; return 8 * (i >> 2) + 4 * n + (i & 3); }
struct Unit { int pm, pn, kt0, nkt, slice, tile, ks; };
struct Gemm { const bf16_t* A; const bf16_t* Bt; int K; };
constexpr int KSPLIT = (DM / 64 >= 16) ? 8 : 4;
struct Order {
  int nM, nN, nwg, G, c, nkt, nsl, ks, pn0c, nNc; bool lat_only;
  DEVI void init(int nM_, int nN_, int G_, int c_, bool lat, int nkt_, int ks_ = 0, int pn0c_ = 0, int nNc_ = 0) { nM = nM_; nN = nN_; nwg = nM * nN; G = G_; c = c_; lat_only = lat; nkt = nkt_; ks = ks_; pn0c = pn0c_; nNc = nNc_; nsl = NB * nNc_ * ks_; }
  DEVI bool next(int i, Unit& u) const {
    int ii = i; if (ks > 0 && nwg == G && (c & 1) && i < 2 && (long)G + c < (long)nwg + nsl) ii = 1 - i;
    const long L = (long)ii * G + c; if (L >= nwg + nsl) return false;
    u.ks = ks;
    if (L >= nwg) { const int j = (int)L - nwg; u.tile = j / ks; u.slice = j % ks; u.pm = (u.tile / nNc) * TILES_PB; u.pn = pn0c + u.tile % nNc; u.nkt = nkt / ks; u.kt0 = u.slice * u.nkt; return true; }
    u.kt0 = 0; u.nkt = nkt; u.slice = -1; u.tile = 0;
    int wgid = (int)L; { const int q = nwg / NXCD, r = nwg % NXCD, xcd = wgid % NXCD, off = wgid / NXCD; wgid = (xcd < r ? xcd * (q + 1) : r * (q + 1) + (xcd - r) * q) + off; }
    const int nig = WGM * nN, gid = wgid / nig, fm = gid * WGM, gsz = (nM - fm) < WGM ? (nM - fm) : WGM;
    int pm = fm + ((wgid % nig) % gsz); u.pn = (wgid % nig) / gsz;
    if (lat_only) pm = (pm / (TILES_PB - 1)) * TILES_PB + 1 + pm % (TILES_PB - 1);
    u.pm = pm; return true;
  }
};
enum { EM_RAW = 0, EM_SILU = 1, EM_RELU2 = 2, EM_HNORM = 3 };
template <int kind> struct EpiProj {
  static constexpr bool PERM = true;
  bf16_t* O; int ldc;
  const float* gq; const float* gk; const float* rcos; const float* rsin; LAS float* xch; float* slab; unsigned* cnt;
  DEVI int tile_mode(int pn, const float*& g) const {
    const int colt = pn * BM; g = gq;
    if (kind == 0) { const int seg = colt / NAW; g = seg == 1 ? gk : gq; return seg <= 1 ? EM_HNORM : (seg == 3 || seg == 7) ? EM_SILU : EM_RAW; }
    if (kind == 1) { g = colt < DM ? gq : gk; return colt < 2 * DM ? EM_HNORM : EM_RAW; }
    return EM_RELU2;
  }
  DEVI void operator()(f32x4 (&acc)[2][2][4][2], const Unit& u, int wr, int wc, int fr, int fq) const {
    OPAQUE(fr); OPAQUE(fq);
    if (u.slice >= 0) {
      float* sp = slab + (size_t)(u.tile * u.ks + u.slice) * 65536 + (((wr * 4 + wc) * 64 + fq * 16 + fr) * 4);
#pragma unroll
      for (int ai = 0; ai < 2; ++ai)
#pragma unroll
        for (int bj = 0; bj < 2; ++bj)
#pragma unroll
          for (int m = 0; m < 4; ++m)
#pragma unroll
            for (int n = 0; n < 2; ++n) { float* q_ = sp + (((ai * 2 + bj) * 4 + m) * 2 + n) * 2048; ST_WT16(q_, acc[ai][bj][m][n]); }
      WAIT_V(0); BAR(); CFENCE();
      if (wr == 0 && wc == 0 && LANE_ID() == 0) (void)AT_ADD(cnt + 16 * u.tile, 1u);
      return;
    }
    int mode = EM_RAW; const float* g = gq; bool rope = false;
    const int colt = u.pn * BM;
    if (kind == 0) { const int seg = colt / NAW; mode = seg == 0 ? EM_HNORM : seg == 1 ? EM_HNORM : (seg == 3 || seg == 7) ? EM_SILU : EM_RAW; g = seg == 1 ? gk : gq; }
    else if (kind == 1) { if (colt < 2 * DM) { mode = EM_HNORM; g = colt < DM ? gq : gk; rope = (u.pm % TILES_PB) != 0; } }
    else mode = EM_RELU2;
    bf16_t* base = O + (size_t)(u.pm * BM) * ldc + colt;
    if (mode == EM_HNORM) {
#pragma unroll
      for (int ai = 0; ai < 2; ++ai)
#pragma unroll
        for (int m = 0; m < 4; ++m)
#pragma unroll
          for (int bj = 0; bj < 2; ++bj) { const f32x4 a = acc[ai][bj][m][0], b = acc[ai][bj][m][1];
            float s = (a.x * a.x + a.y * a.y) + (a.z * a.z + a.w * a.w) + (b.x * b.x + b.y * b.y) + (b.z * b.z + b.w * b.w);
            s += __shfl_xor(s, 16); s += __shfl_xor(s, 32);
            if (fq == 0) xch[(ai * HALF + wr * 64 + m * 16 + fr) * 8 + bj * 4 + wc] = s; }
      WAIT_L(0); BAR(); CFENCE();
      const int lt0 = (u.pm % TILES_PB - 1) * 256;
#pragma unroll
      for (int ai = 0; ai < 2; ++ai)
#pragma unroll
        for (int m = 0; m < 4; ++m) { const int lr = ai * HALF + wr * 64 + m * 16 + fr;
          f32x4 cs = {1.f, 1.f, 1.f, 1.f}, sn = {0.f, 0.f, 0.f, 0.f};
          if (rope) { cs = *(const f32x4*)(rcos + (size_t)(lt0 + lr) * 64 + 16 * wc + 4 * fq); sn = *(const f32x4*)(rsin + (size_t)(lt0 + lr) * 64 + 16 * wc + 4 * fq); }
#pragma unroll
          for (int bj = 0; bj < 2; ++bj) { const f32x4 t = *(const LAS f32x4*)(xch + lr * 8 + bj * 4);
            const float rinv = rsq_fast(((t.x + t.y) + (t.z + t.w)) * (1.0f / 128.0f) + EPS);
            const f32x4 g0 = *(const f32x4*)(g + 32 * wc + 8 * fq), g1 = *(const f32x4*)(g + 32 * wc + 8 * fq + 4);
            const f32x4 x1 = acc[ai][bj][m][0] * rinv * g0, x2 = acc[ai][bj][m][1] * rinv * g1;
            const f32x4 o1 = x1 * cs - x2 * sn, o2 = x1 * sn + x2 * cs;
            u32x4 w; w.x = cvtpk(o1.x, o1.y); w.y = cvtpk(o1.z, o1.w); w.z = cvtpk(o2.x, o2.y); w.w = cvtpk(o2.z, o2.w);
            *(u32x4*)(base + (size_t)lr * ldc + bj * HALF + wc * 32 + 8 * fq) = w; } }
    } else {
#pragma unroll
      for (int ai = 0; ai < 2; ++ai)
#pragma unroll
        for (int m = 0; m < 4; ++m) { const int lr = ai * HALF + wr * 64 + m * 16 + fr;
#pragma unroll
          for (int bj = 0; bj < 2; ++bj) { f32x4 v0 = acc[ai][bj][m][0], v1 = acc[ai][bj][m][1];
            if (mode == EM_SILU) {
#pragma unroll
              for (int e = 0; e < 4; ++e) { v0[e] = silu_f(v0[e]); v1[e] = silu_f(v1[e]); } }
            else if (mode == EM_RELU2) {
#pragma unroll
              for (int e = 0; e < 4; ++e) { const float a = fmaxf(v0[e], 0.f), b = fmaxf(v1[e], 0.f); v0[e] = a * a; v1[e] = b * b; } }
            u32x4 w; w.x = cvtpk(v0.x, v0.y); w.y = cvtpk(v0.z, v0.w); w.z = cvtpk(v1.x, v1.y); w.w = cvtpk(v1.z, v1.w);
            *(u32x4*)(base + (size_t)lr * ldc + bj * HALF + wc * 32 + 8 * fq) = w; } }
    }
  }
};
struct EpiResid {
  static constexpr bool PERM = false;
  float* xres; float* xdst; const float* gate; float* fin; float* slab; unsigned* cnt; const float* in_x; const float* in_ctx;
  DEVI void operator()(f32x4 (&acc)[2][2][4][2], const Unit& u, int wr, int wc, int fr, int fq) const {
    OPAQUE(fr); OPAQUE(fq);
    if (u.slice >= 0) {
      float* sp = slab + (size_t)(u.tile * u.ks + u.slice) * 65536 + (((wr * 4 + wc) * 64 + fq * 16 + fr) * 4);
#pragma unroll
      for (int ai = 0; ai < 2; ++ai)
#pragma unroll
        for (int bj = 0; bj < 2; ++bj)
#pragma unroll
          for (int m = 0; m < 4; ++m)
#pragma unroll
            for (int n = 0; n < 2; ++n) { float* q_ = sp + (((ai * 2 + bj) * 4 + m) * 2 + n) * 2048; ST_WT16(q_, acc[ai][bj][m][n]); }
      WAIT_V(0); BAR(); CFENCE();
      if (wr == 0 && wc == 0 && LANE_ID() == 0) (void)AT_ADD(cnt + 16 * u.tile, 1u);
      return;
    }
    const int b = u.pm / TILES_PB, within = u.pm % TILES_PB; const bool isc = within == 0;
    const float* gp = gate + (size_t)(isc ? NB : b) * 6 * DM + u.pn * BM + wc * 32 + 4 * fq;
    f32x4 gv[2][2];
#pragma unroll
    for (int bj = 0; bj < 2; ++bj)
#pragma unroll
      for (int n = 0; n < 2; ++n) gv[bj][n] = *(const f32x4*)(gp + bj * HALF + n * 16);
    const size_t toff = (size_t)(u.pm * BM) * DM + u.pn * BM + wc * 32 + 4 * fq;
    const float* src = in_x ? (isc ? in_ctx + (size_t)b * CTX * DM : in_x + ((size_t)b * SEQ + (size_t)(within - 1) * 256) * DM) + u.pn * BM + wc * 32 + 4 * fq : xres + toff;
    float* dst = (fin && !isc) ? fin + ((size_t)b * SEQ + (size_t)(within - 1) * 256) * DM + u.pn * BM + wc * 32 + 4 * fq : xdst + toff;
#pragma unroll
    for (int ai = 0; ai < 2; ++ai)
#pragma unroll
      for (int m = 0; m < 4; ++m) { const size_t ro = (size_t)(ai * HALF + wr * 64 + m * 16 + fr) * DM;
#pragma unroll
        for (int bj = 0; bj < 2; ++bj)
#pragma unroll
          for (int n = 0; n < 2; ++n) { const f32x4 bs = *(const f32x4*)(src + ro + bj * HALF + n * 16); *(f32x4*)(dst + ro + bj * HALF + n * 16) = bs + gv[bj][n] * acc[ai][bj][m][n]; } }
  }
};

DEVI const float* slab_piece(const float* unit, int row, int bj, int wc, int fq, int n) {
  const int ai = row >> 7, wr = (row >> 6) & 1, m = (row >> 4) & 3, fr = row & 15;
  return unit + ((((ai * 2 + bj) * 4 + m) * 2 + n) * 512 + (wr * 4 + wc) * 64 + fq * 16 + fr) * 4;
}
DEVI void combine_slices(const Order& S, const EpiResid& E, int wid) {
  int lane = LANE_ID(); OPAQUE(lane);
  const int wr = wid >> 2, wc = wid & 3, fr = lane & 15, fq = lane >> 4;
  constexpr int RPR = 32 / KSPLIT;
  Unit u;
  for (int i = 0; S.next(i, u); ++i) {
    if (u.slice < 0) continue;
    if (wid == 0) { FENCE_ACQ(); unsigned sp = 0; while (AT_LD(E.cnt + 16 * u.tile) < (unsigned)u.ks) { SLEEP1(); if (++sp > (1u << 24)) break; } WAIT_V(0); }
    __syncthreads();
    const float* sp = E.slab + (size_t)u.tile * u.ks * 65536 + (wid * 64 + lane) * 4;
    const float* gp = E.gate + (size_t)NB * 6 * DM + u.pn * BM + wc * 32 + 4 * fq;
    const size_t toff = (size_t)(u.pm * BM) * DM + u.pn * BM + wc * 32 + 4 * fq;
    const float* src = E.in_ctx ? E.in_ctx + (size_t)(u.pm / TILES_PB) * CTX * DM + u.pn * BM + wc * 32 + 4 * fq : E.xres + toff;
    float* dst = E.xdst + toff;
#pragma unroll
    for (int k = 0; k < RPR; ++k) {
      const int idx = u.slice * RPR + k, n = idx & 1, m = (idx >> 1) & 3, bj = (idx >> 3) & 1, ai = idx >> 4;
      f32x4 a = (f32x4){0.f, 0.f, 0.f, 0.f};
#pragma unroll
      for (int s2 = 0; s2 < KSPLIT; ++s2) a += *(const f32x4*)(sp + (size_t)s2 * 65536 + idx * 2048);
      const size_t ro = (size_t)(ai * HALF + wr * 64 + m * 16 + fr) * DM + bj * HALF + n * 16;
      *(f32x4*)(dst + ro) = *(const f32x4*)(src + ro) + *(const f32x4*)(gp + bj * HALF + n * 16) * a;
    }
    __syncthreads();
  }
}
template <int kind>
DEVI void combine_proj(const Order& S, const EpiProj<kind>& E, int wid) {
  const int lane = LANE_ID(), tid = wid * 64 + lane;
  Unit u;
  for (int i = 0; S.next(i, u); ++i) {
    if (u.slice < 0) continue;
    if (wid == 0) { FENCE_ACQ(); unsigned sp = 0; while (AT_LD(E.cnt + 16 * u.tile) < (unsigned)u.ks) { SLEEP1(); if (++sp > (1u << 24)) break; } WAIT_V(0); }
    __syncthreads();
    const float* g; const int mode = E.tile_mode(u.pn, g);
    const int RPS = 256 / u.ks;
    for (int rr = tid >> 4; rr < RPS; rr += 32) {
      const int row = RPS * u.slice + rr, col = (tid & 15) * 16;
      const float* sp = E.slab + (size_t)u.tile * u.ks * 65536;
      f32x4 a[4];
#pragma unroll
      for (int q = 0; q < 4; ++q) a[q] = (f32x4){0.f, 0.f, 0.f, 0.f};
      for (int s2 = 0; s2 < u.ks; ++s2)
#pragma unroll
        for (int q = 0; q < 4; ++q) a[q] += *(const f32x4*)slab_piece(sp + (size_t)s2 * 65536, row, col >> 7, (col >> 5) & 3, ((col & 31) >> 3) + (q >> 1), q & 1);
      if (mode == EM_HNORM) {
        float ss = 0.f;
#pragma unroll
        for (int q = 0; q < 4; ++q) ss += (a[q].x * a[q].x + a[q].y * a[q].y) + (a[q].z * a[q].z + a[q].w * a[q].w);
        ss += __shfl_xor(ss, 1); ss += __shfl_xor(ss, 2); ss += __shfl_xor(ss, 4);
        const float rinv = rsq_fast(ss * (1.0f / 128.0f) + EPS);
#pragma unroll
        for (int q = 0; q < 4; ++q) a[q] = a[q] * rinv * *(const f32x4*)(g + (col & 127) + 4 * q);
      } else if (mode == EM_SILU) {
#pragma unroll
        for (int q = 0; q < 4; ++q)
#pragma unroll
          for (int e = 0; e < 4; ++e) a[q][e] = silu_f(a[q][e]);
      } else if (mode == EM_RELU2) {
#pragma unroll
        for (int q = 0; q < 4; ++q)
#pragma unroll
          for (int e = 0; e < 4; ++e) { const float t = fmaxf(a[q][e], 0.f); a[q][e] = t * t; }
      }
      bf16_t* dst = E.O + (size_t)(u.pm * BM + row) * E.ldc + u.pn * BM + col;
      u32x4 w0, w1; w0.x = cvtpk(a[0].x, a[0].y); w0.y = cvtpk(a[0].z, a[0].w); w0.z = cvtpk(a[1].x, a[1].y); w0.w = cvtpk(a[1].z, a[1].w);
      w1.x = cvtpk(a[2].x, a[2].y); w1.y = cvtpk(a[2].z, a[2].w); w1.z = cvtpk(a[3].x, a[3].y); w1.w = cvtpk(a[3].z, a[3].w);
      *(u32x4*)dst = w0; *(u32x4*)(dst + 8) = w1;
    }
    __syncthreads();
  }
}
template <class Epi>
DEVI void gemm_phase(LAS unsigned char* lds, int wid, const Gemm g, const Order& S, const Epi& E) {
  const int lane = LANE_ID(), tid = wid * 64 + lane, wr = wid >> 2, wc = wid & 3, fr = lane & 15, fq = lane >> 4;
  const int K = g.K;
  unsigned voffA[2], voffB[2];
#pragma unroll
  for (int i = 0; i < 2; ++i) { int R, C; stage_rc(tid * 16 + i * 8192, R, C); const int Rb = Epi::PERM ? ((R & ~31) + perm32(R & 31)) : R;
    voffA[i] = (unsigned)(R * K + C) * 2u; voffB[i] = (unsigned)(Rb * K + C) * 2u; }
  const size_t kstep = (size_t)(BK * 2);
  const size_t hstep = (size_t)HALF * K * 2;
  const size_t tstep = 2 * hstep;
  const unsigned ldsw = (unsigned)wid * 1024u;
  const int aoff = lds_byte(wr * 64 + fr, fq * 8), boff = lds_byte(wc * 32 + fr, fq * 8);
#define PG8_SA(b, h) (((b) * 2 + (h)) * HTB)
#define PG8_SB(b, h) ((4 + (b) * 2 + (h)) * HTB)
#define PG8_STAGE(bufoff, gbase, voff) do { _Pragma("unroll") for (int _i = 0; _i < 2; ++_i) \
    GLDS16((const char*)(gbase) + (voff)[_i], lds + (bufoff) + ldsw + _i * 8192); } while (0)
#define PG8_LDA(dst, b, h) do { _Pragma("unroll") for (int m = 0; m < 4; ++m) _Pragma("unroll") for (int k = 0; k < 2; ++k) dst[m][k] = *(const LAS bf16x8*)(lds + PG8_SA(b, h) + aoff + m * 2048 + k * 1024); } while (0)
#define PG8_LDB(dst, b, h) do { _Pragma("unroll") for (int n = 0; n < 2; ++n) _Pragma("unroll") for (int k = 0; k < 2; ++k) dst[n][k] = *(const LAS bf16x8*)(lds + PG8_SB(b, h) + boff + n * 2048 + k * 1024); } while (0)
#define PG8_MMA(ai, bj, At, Bt) do { SETPRIO(1); _Pragma("unroll") for (int m = 0; m < 4; ++m) _Pragma("unroll") for (int n = 0; n < 2; ++n) _Pragma("unroll") for (int k = 0; k < 2; ++k) \
    acc[ai][bj][m][n] = mfma16(Bt[n][k], At[m][k], acc[ai][bj][m][n]); SETPRIO(0); } while (0)
  Unit cur, nxt; int ui = 0;
  if (!S.next(0, cur)) return;
  f32x4 acc[2][2][4][2];
#pragma unroll
  for (int a = 0; a < 2; ++a)
#pragma unroll
    for (int b = 0; b < 2; ++b)
#pragma unroll
      for (int m = 0; m < 4; ++m)
#pragma unroll
        for (int n = 0; n < 2; ++n) acc[a][b][m][n] = (f32x4){0.f, 0.f, 0.f, 0.f};
  bf16x8 At[4][2], B0[2][2], B1[2][2];
  const char* cA = (const char*)g.A + (size_t)cur.pm * tstep + (size_t)cur.kt0 * kstep; const char* cB = (const char*)g.Bt + (size_t)cur.pn * tstep + (size_t)cur.kt0 * kstep;
  int nt = cur.nkt;
  PG8_STAGE(PG8_SB(0, 0), cB, voffB); PG8_STAGE(PG8_SB(0, 1), cB + hstep, voffB); PG8_STAGE(PG8_SA(0, 0), cA, voffA); PG8_STAGE(PG8_SA(0, 1), cA + hstep, voffA);
  if (wr == 1) BAR();
  WAIT_V(2); BAR();
  PG8_STAGE(PG8_SB(1, 0), cB + kstep, voffB); PG8_STAGE(PG8_SA(1, 0), cA + kstep, voffA); PG8_STAGE(PG8_SB(1, 1), cB + hstep + kstep, voffB);
  WAIT_V(6); BAR();
  for (;;) {
    const bool has_next = S.next(ui + 1, nxt);
    const char* nA = has_next ? (const char*)g.A + (size_t)nxt.pm * tstep + (size_t)nxt.kt0 * kstep : cA; const char* nB = has_next ? (const char*)g.Bt + (size_t)nxt.pn * tstep + (size_t)nxt.kt0 * kstep : cB;
    for (int t = 0; t < nt; t += 2) {
      const bool last = (t == nt - 2);
      const char* a1 = cA + (size_t)(t + 1) * kstep;
      const char* a2 = last ? nA : cA + (size_t)(t + 2) * kstep; const char* b2 = last ? nB : cB + (size_t)(t + 2) * kstep;
      const char* a3 = a2 + kstep; const char* b3 = b2 + kstep;
      PG8_LDB(B0, 0, 0); PG8_LDB(B1, 0, 1); SCHED(); PG8_LDA(At, 0, 0); PG8_STAGE(PG8_SA(1, 1), a1 + hstep, voffA);
      WAIT_V(8); WAIT_L(0); BAR(); PG8_MMA(0, 0, At, B0); PG8_MMA(0, 1, At, B1); BAR(); SCHED();
      PG8_LDA(At, 0, 1); PG8_STAGE(PG8_SB(0, 0), b2, voffB); PG8_STAGE(PG8_SB(0, 1), b2 + hstep, voffB); PG8_STAGE(PG8_SA(0, 0), a2, voffA);
      WAIT_V(8); WAIT_L(0); BAR(); PG8_MMA(1, 0, At, B0); PG8_MMA(1, 1, At, B1); BAR(); SCHED();
      PG8_LDB(B0, 1, 0); PG8_LDB(B1, 1, 1); SCHED(); PG8_LDA(At, 1, 0); PG8_STAGE(PG8_SA(0, 1), a2 + hstep, voffA);
      WAIT_V(8); WAIT_L(0); BAR(); PG8_MMA(0, 0, At, B0); PG8_MMA(0, 1, At, B1); BAR(); SCHED();
      PG8_LDA(At, 1, 1); PG8_STAGE(PG8_SB(1, 0), b3, voffB); PG8_STAGE(PG8_SB(1, 1), b3 + hstep, voffB); PG8_STAGE(PG8_SA(1, 0), a3, voffA);
      WAIT_V(8); WAIT_L(0); BAR(); PG8_MMA(1, 0, At, B0); PG8_MMA(1, 1, At, B1); BAR(); SCHED();
    }
    if (wr == 0) BAR();
    E(acc, cur, wr, wc, fr, fq);
    if (!has_next) break;
#pragma unroll
    for (int a = 0; a < 2; ++a)
#pragma unroll
      for (int b = 0; b < 2; ++b)
#pragma unroll
        for (int m = 0; m < 4; ++m)
#pragma unroll
          for (int n = 0; n < 2; ++n) acc[a][b][m][n] = (f32x4){0.f, 0.f, 0.f, 0.f};
    cur = nxt; cA = nA; cB = nB; ++ui; nt = cur.nkt;
    if (wr == 1) BAR();
  }
  WAIT_V(0);
  BAR();
#undef PG8_SA
#undef PG8_SB
#undef PG8_STAGE
#undef PG8_LDA
#undef PG8_LDB
#undef PG8_MMA
}
}

namespace att {
constexpr int D = 128, NW = 8, QBLK = 32, KVBLK = 64;
constexpr float SCALE = 0.088388347648318440f, THR = 8.f;
constexpr int SHM_V = KVBLK * D * 2, SHM_K = KVBLK * D * 2, SHM_ATTN = 2 * SHM_V + 2 * SHM_K + NW * 64 * 4;
#define KSWZ(row, colB) ((row) * 256 + ((colB) ^ (((row) & 15) << 4)))
DEVI int crow(int r, int hi) { return (r & 3) + 8 * (r >> 2) + 4 * hi; }
DEVI void partialSM(f32x16& p0, f32x16& p1, float& m_reg, float& mn, float& alpha) {
  constexpr float Cc = SCALE * 1.4426950408889634f;
  float pmax = p0[0];
#pragma unroll
  for (int r = 1; r < 16; ++r) pmax = fmaxf(pmax, p0[r]);
#pragma unroll
  for (int r = 0; r < 16; ++r) pmax = fmaxf(pmax, p1[r]);
  { unsigned a, b; plswap(__builtin_bit_cast(unsigned, pmax), __builtin_bit_cast(unsigned, pmax), a, b); pmax = fmaxf(__builtin_bit_cast(float, a), __builtin_bit_cast(float, b)); }
  if (__builtin_expect(__all(pmax - m_reg <= THR / SCALE), 1)) { mn = m_reg; alpha = 1.f; }
  else { mn = fmaxf(m_reg, pmax); alpha = exp2_fast((m_reg - mn) * Cc); m_reg = mn; }
  const float mnC = -mn * Cc;
#pragma unroll
  for (int r = 0; r < 16; ++r) p0[r] = fmaf(p0[r], Cc, mnC);
#pragma unroll
  for (int r = 0; r < 16; ++r) p1[r] = fmaf(p1[r], Cc, mnC);
#pragma unroll
  for (int r = 0; r < 16; ++r) p0[r] = exp2_fast(p0[r]);
}
DEVI void finishSM(f32x16& p0, f32x16& p1, float alpha, float& l_reg, bf16x8& pa0, bf16x8& pa1, bf16x8& pa2, bf16x8& pa3) {
#pragma unroll
  for (int r = 0; r < 16; ++r) p1[r] = exp2_fast(p1[r]);
  float ps = 0;
#pragma unroll
  for (int r = 0; r < 16; ++r) ps += p0[r];
#pragma unroll
  for (int r = 0; r < 16; ++r) ps += p1[r];
  { unsigned a, b; plswap(__builtin_bit_cast(unsigned, ps), __builtin_bit_cast(unsigned, ps), a, b); ps = __builtin_bit_cast(float, a) + __builtin_bit_cast(float, b); }
  l_reg = l_reg * alpha + ps;
#define PK4(P, BASE, OUT) do { unsigned a0 = cvtpk(P[BASE + 0], P[BASE + 1]), a1 = cvtpk(P[BASE + 2], P[BASE + 3]);   \
    unsigned b0 = cvtpk(P[BASE + 4], P[BASE + 5]), b1 = cvtpk(P[BASE + 6], P[BASE + 7]);                              \
    unsigned r00, r01, r10, r11; plswap(a0, b0, r00, r01); plswap(a1, b1, r10, r11); \
    u32x4 w = {r00, r10, r01, r11}; OUT = __builtin_bit_cast(bf16x8, w); } while (0)
  PK4(p0, 0, pa0); PK4(p0, 8, pa1); PK4(p1, 0, pa2); PK4(p1, 8, pa3);
#undef PK4
}
DEVI void finishSM_noexp(f32x16& p0, f32x16& p1, float& l_reg, bf16x8& pa0, bf16x8& pa1, bf16x8& pa2, bf16x8& pa3) {
  float ps = 0;
#pragma unroll
  for (int r = 0; r < 16; ++r) ps += p0[r];
#pragma unroll
  for (int r = 0; r < 16; ++r) ps += p1[r];
  { unsigned a, b; plswap(__builtin_bit_cast(unsigned, ps), __builtin_bit_cast(unsigned, ps), a, b); ps = __builtin_bit_cast(float, a) + __builtin_bit_cast(float, b); }
  l_reg += ps;
#define PK4(P, BASE, OUT) do { unsigned a0 = cvtpk(P[BASE + 0], P[BASE + 1]), a1 = cvtpk(P[BASE + 2], P[BASE + 3]);   \
    unsigned b0 = cvtpk(P[BASE + 4], P[BASE + 5]), b1 = cvtpk(P[BASE + 6], P[BASE + 7]);                              \
    unsigned r00, r01, r10, r11; plswap(a0, b0, r00, r01); plswap(a1, b1, r10, r11); \
    u32x4 w = {r00, r10, r01, r11}; OUT = __builtin_bit_cast(bf16x8, w); } while (0)
  PK4(p0, 0, pa0); PK4(p0, 8, pa1); PK4(p1, 0, pa2); PK4(p1, 8, pa3);
#undef PK4
}
template <class Mask> DEVI void qkt(f32x16& p0, f32x16& p1, const LAS unsigned char* Ks, const bf16x8* qr, int r32, int hi, const Mask& mask, int t) {
  mask.init(p0, p1, t);
  if constexpr (Mask::OPQ) OPAQUE(r32);
#pragma unroll
  for (int d0 = 0; d0 < 8; ++d0) { const int cb = (d0 * 16 + hi * 8) * 2;
    const bf16x8 b0 = *(const LAS bf16x8*)(Ks + KSWZ(r32, cb));
    const bf16x8 b1 = *(const LAS bf16x8*)(Ks + KSWZ(32 + r32, cb));
    p0 = mfma32(b0, qr[d0], p0);
    p1 = mfma32(b1, qr[d0], p1); }
}
DEVI int v_st(int k, int c) { const int kk = (k & ~0xC) | ((k & 4) << 1) | ((k & 8) >> 1); return ((kk >> 3) * 4 + (c >> 5)) * 512 + ((kk & 7) * 32 + (c & 31)) * 2; }
DEVI int v_rd_base(int lane) { return ((lane & 3) << 3) | (((lane >> 2) & 3) << 6) | (((lane >> 4) & 1) << 5) | (((lane >> 5) & 1) << 8); }
constexpr int v_rd_off(int d0, int ks, int half) { return d0 * 512 + ks * 4096 + half * 2048; }
template <int D0> DEVI void pv_one(f32x16& od, const LAS unsigned char* vb, bf16x8 pa0, bf16x8 pa1, bf16x8 pa2, bf16x8 pa3) {
  const s16x4 l0 = tr_read_p(vb + v_rd_off(D0, 0, 0)), h0 = tr_read_p(vb + v_rd_off(D0, 0, 1)), l1 = tr_read_p(vb + v_rd_off(D0, 1, 0)), h1 = tr_read_p(vb + v_rd_off(D0, 1, 1));
  const s16x4 l2 = tr_read_p(vb + v_rd_off(D0, 2, 0)), h2 = tr_read_p(vb + v_rd_off(D0, 2, 1)), l3 = tr_read_p(vb + v_rd_off(D0, 3, 0)), h3 = tr_read_p(vb + v_rd_off(D0, 3, 1));
#define PK(L, H) (bf16x8){L[0], L[1], L[2], L[3], H[0], H[1], H[2], H[3]}
  od = mfma32(pa0, PK(l0, h0), od);
  od = mfma32(pa1, PK(l1, h1), od);
  od = mfma32(pa2, PK(l2, h2), od);
  od = mfma32(pa3, PK(l3, h3), od);
#undef PK
}
DEVI void pv_d0(f32x16 (&o)[4], const LAS unsigned char* vb, bf16x8 pa0, bf16x8 pa1, bf16x8 pa2, bf16x8 pa3) {
  pv_one<0>(o[0], vb, pa0, pa1, pa2, pa3); pv_one<1>(o[1], vb, pa0, pa1, pa2, pa3); pv_one<2>(o[2], vb, pa0, pa1, pa2, pa3); pv_one<3>(o[3], vb, pa0, pa1, pa2, pa3);
}
struct NoMask { static constexpr bool OPQ = false; DEVI void init(f32x16& p0, f32x16& p1, int) const { p0 = f32x16{}; p1 = f32x16{}; } };
constexpr int NA_TABW = 128, NA_TABOFF = 48;
struct NaMask {
  static constexpr bool OPQ = true;
  const LAS float* tb0;
  int wb;
  int kr0, r0w;
  DEVI void init(f32x16& p0, f32x16& p1, int t) const {
    if (t < 4) { p0 = f32x16{}; p1 = f32x16{}; return; }
    const int kr = kr0 + t - 4;
    if (kr < r0w || kr >= r0w + 8) {
#pragma unroll
      for (int rg = 0; rg < 16; ++rg) { p0[rg] = -INFINITY; p1[rg] = -INFINITY; }
      return; }
    const LAS float* tb = tb0 + kr * NA_TABW;
#pragma unroll
    for (int rg = 0; rg < 16; ++rg) {
      const int k = (rg & 3) + 8 * (rg >> 2);
      const float b1 = tb[k], b2 = tb[k + 32];
      p0[rg] = (unsigned)(k + wb) < 16u ? b1 : -INFINITY; p1[rg] = (unsigned)(k + 32 + wb) < 16u ? b2 : -INFINITY;
      if ((rg & 3) == 3) CFENCE(); }
  }
};
template <bool DEEP, class Mask>
DEVI void attn_body(const bf16_t* __restrict__ Qb, const bf16_t* __restrict__ Kh, const bf16_t* __restrict__ Vh, int NT, int kshift, const Mask& mask, LAS unsigned char* lds, int wid, f32x16 (&o)[4]) {
  constexpr int ldq = 4 * DM, ldk = 4 * DM;
  int lane = LANE_ID(); OPAQUE(lane);
  const int tid = wid * 64 + lane, r32 = lane & 31, hi = lane >> 5;
  LAS unsigned char* V_lds = lds; LAS unsigned char* K_lds = lds + 2 * SHM_V;
  LAS float* wsf = (LAS float*)(lds + 2 * SHM_V + 2 * SHM_K) + wid * 64; LAS float* li_l = wsf; LAS float* al_l = wsf + 32;
  float m_reg = -1e30f, l_reg = 0; bf16x8 qr[8];
#pragma unroll
  for (int d = 0; d < 4; ++d) o[d] = f32x16{};
  const bf16_t* Qw = Qb + (long)(wid * QBLK + r32) * ldq + hi * 8;
#pragma unroll
  for (int d0 = 0; d0 < 8; ++d0) qr[d0] = *(const bf16x8*)(Qw + d0 * 16);
  const int sr = tid >> 4, sc = (tid & 15) * 8, vst0 = v_st(sr, sc), vst1 = v_st(32 + sr, sc);
  const LAS unsigned char* vb0 = V_lds + v_rd_base(lane);
  bf16x8 vsA0, vsA1, ksA0, ksA1, vsB0, vsB1, ksB0, ksB1;
#define ROW0(t) (64L * ((t) < 4 ? (t) : (t) + kshift))
#define SLOAD(S, t) do { const long r0_ = ROW0(t); vs##S##0 = *(const bf16x8*)(Vh + (r0_ + sr) * ldk + sc); vs##S##1 = *(const bf16x8*)(Vh + (r0_ + 32 + sr) * ldk + sc); \
    ks##S##0 = *(const bf16x8*)(Kh + (r0_ + sr) * ldk + sc); ks##S##1 = *(const bf16x8*)(Kh + (r0_ + 32 + sr) * ldk + sc); } while (0)
#define SWRITE(b, S) do { *(LAS bf16x8*)(V_lds + (b) * SHM_V + vst0) = vs##S##0; *(LAS bf16x8*)(V_lds + (b) * SHM_V + vst1) = vs##S##1; const int kc_ = sc * 2; \
    *(LAS bf16x8*)(K_lds + (b) * SHM_K + KSWZ(sr, kc_)) = ks##S##0; *(LAS bf16x8*)(K_lds + (b) * SHM_K + KSWZ(32 + sr, kc_)) = ks##S##1; } while (0)
#define SWAIT() WAIT_V(4)
#define RESC(a) do { if (__any((a) < 1.f)) { if (hi == 0) al_l[r32] = (a); WAIT_L(0); WSYNC(); \
    _Pragma("unroll") for (int d = 0; d < 4; ++d) _Pragma("unroll") for (int r = 0; r < 16; ++r) o[d][r] *= al_l[crow(r, hi)]; } } while (0)
  f32x16 pA0, pA1, pB0, pB1; float mnA, mnB, alA, alB; bf16x8 pa0, pa1, pa2, pa3;
  SLOAD(A, 0); WAIT_V(0); SWRITE(0, A); __syncthreads();
  qkt(pA0, pA1, K_lds, qr, r32, hi, mask, 0); partialSM(pA0, pA1, m_reg, mnA, alA);
  if constexpr (DEEP) { SLOAD(B, 1); if (2 < NT) SLOAD(A, 2); SWAIT(); SWRITE(1, B); } else { SLOAD(A, 1); WAIT_V(0); SWRITE(1, A); }
  __syncthreads();
  for (int j = 1; j + 1 < NT; j += 2) {
    SCHED(); qkt(pB0, pB1, K_lds + SHM_K, qr, r32, hi, mask, j);
    finishSM(pA0, pA1, alA, l_reg, pa0, pa1, pa2, pa3); SCHED();
    if constexpr (DEEP) SLOAD(B, j + 2); else SLOAD(A, j + 1);
    SCHED();
    pv_d0(o, vb0, pa0, pa1, pa2, pa3); partialSM(pB0, pB1, m_reg, mnB, alB);
    __syncthreads(); if constexpr (DEEP) SWAIT(); else WAIT_V(0);
    SWRITE(0, A);
    RESC(alB); __syncthreads();
    SCHED(); qkt(pA0, pA1, K_lds, qr, r32, hi, mask, j + 1);
    finishSM(pB0, pB1, alB, l_reg, pa0, pa1, pa2, pa3); SCHED();
    if constexpr (DEEP) { if (j + 3 < NT) SLOAD(A, j + 3); } else SLOAD(A, j + 2);
    SCHED();
    pv_d0(o, vb0 + SHM_V, pa0, pa1, pa2, pa3); partialSM(pA0, pA1, m_reg, mnA, alA);
    __syncthreads(); if constexpr (DEEP) { SWAIT(); SWRITE(1, B); } else { WAIT_V(0); SWRITE(1, A); }
    RESC(alA); __syncthreads();
  }
  SCHED(); qkt(pB0, pB1, K_lds + SHM_K, qr, r32, hi, mask, NT - 1);
  finishSM(pA0, pA1, alA, l_reg, pa0, pa1, pa2, pa3); SCHED();
  pv_d0(o, vb0, pa0, pa1, pa2, pa3); partialSM(pB0, pB1, m_reg, mnB, alB);
  __syncthreads(); RESC(alB);
  finishSM(pB0, pB1, alB, l_reg, pa0, pa1, pa2, pa3); SCHED();
  pv_d0(o, vb0 + SHM_V, pa0, pa1, pa2, pa3);
  if (hi == 0) li_l[r32] = l_reg; WAIT_L(0); WSYNC();
#pragma unroll
  for (int r = 0; r < 16; ++r) { const float rl = rcp_fast(li_l[crow(r, hi)]);
#pragma unroll
    for (int d = 0; d < 4; ++d) o[d][r] *= rl; }
  __syncthreads();
#undef ROW0
#undef SLOAD
#undef SWRITE
#undef SWAIT
#undef RESC
}
}

DEVI void phase_attn0(const Params& P, const Ctx& C) {
  CTX_IDS;
  unsigned char* ws = P.ws;
  const bf16_t* Pm = (const bf16_t*)(ws + WS_P); bf16_t* AO = (bf16_t*)(ws + WS_AO);
  constexpr int LDP = 4 * DM, NQB = SEQ / 256, N_NA = NB * NAH * NQB, N_CX = NB * NAH;
  LAS float* tab = (LAS float*)(C.lds + att::SHM_ATTN);
  const int r32 = lane & 31, hi = lane >> 5;
  for (int it0 = C.vcu; it0 < N_NA; it0 += C.G)
  for (int sub = 0; sub < 2; ++sub) {
    if (sub == 1 && (it0 % NQB) != 0) break;
    const int it = sub == 0 ? it0 : N_NA + it0 / NQB;
    f32x16 o[4]; size_t R0; int h;
    if (it < N_NA) {
      const int g = it % NQB; h = (it / NQB) % NAH; const int b = it / (NQB * NAH);
      for (int i = tid; i < 15 * att::NA_TABW; i += NTHR) { const int dr = i / att::NA_TABW, dc = i % att::NA_TABW - att::NA_TABOFF; tab[i] = (dc >= 0 && dc < 31) ? P.in[I_RPB][((size_t)h * 15 + dr) * 31 + dc] * (1.0f / att::SCALE) : 0.f; }
      __syncthreads();
      auto r0f = [](int r) { int v = r - 4; return v < 0 ? 0 : (v > GROWS - 8 ? GROWS - 8 : v); };
      int kr0 = r0f(4 * g), nrows = r0f(4 * g + 3) + 8 - kr0;
      if (nrows & 1) { if (kr0 + nrows < GROWS) ++nrows; else { --kr0; ++nrows; } }
      const int rq = 4 * g + (C.wave >> 1), qc = 32 * (C.wave & 1) + r32; int c0 = qc - 8; c0 = c0 < 0 ? 0 : (c0 > GW - 16 ? GW - 16 : c0);
      att::NaMask mk{tab + (7 - rq) * att::NA_TABW + 4 * hi - qc + 15 + att::NA_TABOFF, 4 * hi - c0, kr0, r0f(rq)};
      R0 = (size_t)b * TPB + CTX + 256 * g;
      att::attn_body<false>(Pm + R0 * LDP + C_QA + h * 128, Pm + (size_t)b * TPB * LDP + C_KA + h * 128, Pm + (size_t)b * TPB * LDP + C_VA + h * 128, 4 + nrows, kr0, mk, C.lds, C.wave, o);
    } else {
      const int i2 = it - N_NA; h = i2 % NAH; const int b = i2 / NAH;
      R0 = (size_t)b * TPB;
      att::attn_body<true>(Pm + R0 * LDP + C_QA + h * 128, Pm + R0 * LDP + C_KA + h * 128, Pm + R0 * LDP + C_VA + h * 128, 4, 0, att::NoMask(), C.lds, C.wave, o);
    }
    bf16_t* Ob = AO + (R0 + C.wave * 32) * DM + h * 128;
#pragma unroll
    for (int r = 0; r < 16; ++r) { const int orow = att::crow(r, hi);
#pragma unroll
      for (int d0 = 0; d0 < 4; ++d0) Ob[(size_t)orow * DM + d0 * 32 + r32] = f2bf1(o[d0][r]); }
  }
}

namespace hg {
constexpr int KS = 72;
constexpr int CS = 136;
constexpr int LDP = 4 * DM;
DEVI int chunk_of(int dir, int j) { return dir == 0 ? j : (j < NCH_CTX ? NCH_CTX - 1 - j : NCH + NCH_CTX - 1 - j); }

template <int RSB> DEVI bf16x8 frag_T(const LAS unsigned char* p0, int lane) {
  const LAS unsigned char* a = p0 + (8 * (lane >> 4) + ((lane >> 2) & 3)) * RSB + 8 * (lane & 3);
  const s16x4 lo = tr_read_p(a), hi = tr_read_p(a + 4 * RSB);
  return (bf16x8){lo[0], lo[1], lo[2], lo[3], hi[0], hi[1], hi[2], hi[3]};
}
constexpr int G2 = 4;
static_assert(NCH % G2 == 0, "chunk groups");
constexpr int KRS = 80, VRS = 272;
DEVI void phase_hg2(const Params& P, const Ctx& C) {
  CTX_IDS;
  unsigned char* ws = P.ws;
  const bf16_t* Pm = (const bf16_t*)(ws + WS_P); bf16_t* HGS = (bf16_t*)(ws + WS_HGS); const float* lbt = (const float*)(ws + WS_LB);
  LAS unsigned char* KR = C.lds;
  LAS unsigned char* VR = C.lds + G2 * 64 * KRS;
  LAS float* segt = (LAS float*)(C.lds + G2 * 64 * (KRS + VRS));
  LAS float* gv = segt + G2 * 512;
  static_assert(G2 * 64 * (KRS + VRS) + G2 * 2048 + G2 * 128 <= LDS_RING, "hg2 lds");
  const int ch = tid & 31, seg = tid >> 5, l15 = lane & 15, l4 = lane >> 4;
  constexpr int NIT = NB * HGH * 2 * 4;
  for (int it = C.vcu; it < NIT; it += C.G) {
    const int dkq = it & 3, dir = (it >> 2) & 1, h = (it >> 3) % HGH, b = it / (8 * HGH);
    const int scan = (b * HGH + h) * 2 + dir;
    const float lb = lbt[dir * NAW + h * 128 + dkq * 32 + ch];
    const bf16_t* zp = Pm + (size_t)b * TPB * LDP + (dir ? C_ZB : C_ZF) + h * 128 + dkq * 32 + ch;
    const bf16_t* vp = Pm + (size_t)b * TPB * LDP + C_IB + h * 128;
    f32x4 acc[2]; acc[0] = (f32x4){0.f, 0.f, 0.f, 0.f}; acc[1] = acc[0];
    bf16_t zr[G2][4]; bf16x8 vr[G2][2];
#define HG2_LOADZ(grp) do { _Pragma("unroll") for (int g = 0; g < G2; ++g) { const int c_ = chunk_of(dir, (grp) * G2 + g); \
      _Pragma("unroll") for (int i = 0; i < 4; ++i) { const int u = 4 * seg + i, tok = dir ? 63 - u : u; zr[g][i] = zp[(size_t)(64 * c_ + tok) * LDP]; } } } while (0)
#define HG2_LOADV(grp) do { _Pragma("unroll") for (int g = 0; g < G2; ++g) { const int c_ = chunk_of(dir, (grp) * G2 + g); \
      _Pragma("unroll") for (int i = 0; i < 2; ++i) { const int idx = tid + 512 * i; vr[g][i] = *(const bf16x8*)(vp + (size_t)(64 * c_ + (idx >> 4)) * LDP + 8 * (idx & 15)); } } } while (0)
    HG2_LOADZ(0); HG2_LOADV(0);
    for (int grp = 0; grp < NCH / G2; ++grp) {
      float fk[G2][4], pl[G2][4];
#pragma unroll
      for (int g = 0; g < G2; ++g) { float run = 0.f;
#pragma unroll
        for (int i = 0; i < 4; ++i) { const float z = bf1(zr[g][i]), e = __expf(-z), sg = rcp_fast(1.0f + e); const float f = lb + (1.0f - lb) * sg; fk[g][i] = (1.0f - lb) * e * sg; run += __log2f(f); pl[g][i] = run; }
        segt[(g * 16 + seg) * 32 + ch] = run; }
      const int gnx = grp + 1 < NCH / G2 ? grp + 1 : grp;
      HG2_LOADZ(gnx);
      __syncthreads();
#pragma unroll
      for (int g = 0; g < G2; ++g) { float off = 0.f, tot = 0.f;
#pragma unroll
        for (int s2 = 0; s2 < 16; ++s2) { const float v = segt[(g * 16 + s2) * 32 + ch]; tot += v; off += (s2 < seg) ? v : 0.f; }
#pragma unroll
        for (int i = 0; i < 4; ++i) { const int u = 4 * seg + i, tok = dir ? 63 - u : u; *(LAS bf16_t*)(KR + (g * 64 + tok) * KRS + 2 * ch) = f2bf1(fk[g][i] * exp2_fast(tot - (off + pl[g][i]))); }
        if (seg == 0) gv[g * 32 + ch] = exp2_fast(tot);
#pragma unroll
        for (int i = 0; i < 2; ++i) { const int idx = tid + 512 * i; *(LAS bf16x8*)(VR + (g * 64 + (idx >> 4)) * VRS + 16 * (idx & 15)) = vr[g][i]; } }
      HG2_LOADV(gnx);
      __syncthreads();
      f32x4 U[G2][2];
#pragma unroll
      for (int g = 0; g < G2; ++g) {
        bf16x8 bb[2];
#pragma unroll
        for (int ks = 0; ks < 2; ++ks) bb[ks] = frag_T<VRS>(VR + (g * 64 + 32 * ks) * VRS + 32 * C.wave, lane);
#pragma unroll
        for (int mt = 0; mt < 2; ++mt) { f32x4 u4 = (f32x4){0.f, 0.f, 0.f, 0.f};
#pragma unroll
          for (int ks = 0; ks < 2; ++ks) u4 = mfma16(frag_T<KRS>(KR + (g * 64 + 32 * ks) * KRS + 32 * mt, lane), bb[ks], u4);
          U[g][mt] = u4; } }
      const int dv = C.wave * 16 + l15;
#pragma unroll
      for (int g = 0; g < G2; ++g) { const int c = chunk_of(dir, grp * G2 + g);
        { u32x2 w0, w1; w0.x = cvtpk(acc[0][0], acc[0][1]); w0.y = cvtpk(acc[0][2], acc[0][3]); w1.x = cvtpk(acc[1][0], acc[1][1]); w1.y = cvtpk(acc[1][2], acc[1][3]);
          const bool odd = l4 & 1; const u32x2 snd = odd ? w0 : w1; u32x2 rcv; rcv.x = (unsigned)__shfl_xor((int)snd.x, 16); rcv.y = (unsigned)__shfl_xor((int)snd.y, 16);
          const u32x4 w = odd ? (u32x4){rcv.x, rcv.y, w1.x, w1.y} : (u32x4){w0.x, w0.y, rcv.x, rcv.y};
          ST_WT16U(HGS + (((size_t)scan * NCH + c) * 128 + dv) * 128 + dkq * 32 + (odd ? 16 : 0) + 4 * (l4 & ~1), w); }
#pragma unroll
        for (int mt = 0; mt < 2; ++mt) { const f32x4 g4 = *(const LAS f32x4*)(gv + g * 32 + mt * 16 + 4 * l4); acc[mt] = acc[mt] * g4 + U[g][mt]; } }
    }
    __syncthreads();
#undef HG2_LOADZ
#undef HG2_LOADV
  }
}

DEVI void phase_hg3(const Params& P, const Ctx& C) {
  CTX_IDS;
  unsigned char* ws = P.ws;
  const bf16_t* Pm = (const bf16_t*)(ws + WS_P); const bf16_t* HGS = (const bf16_t*)(ws + WS_HGS); const float* lbt = (const float*)(ws + WS_LB); bf16_t* AO = (bf16_t*)(ws + WS_AO);
  constexpr int SZ_T = 64 * CS * 2;
  LAS bf16_t* QA = (LAS bf16_t*)(C.lds); LAS bf16_t* KA = (LAS bf16_t*)(C.lds + SZ_T); LAS bf16_t* QI = (LAS bf16_t*)(C.lds + 2 * SZ_T);
  LAS unsigned char* VR = C.lds + 3 * SZ_T;
  LAS bf16_t* AT = (LAS bf16_t*)(C.lds + 3 * SZ_T + 64 * VRS);
  LAS float* segt = (LAS float*)(C.lds + 3 * SZ_T + 64 * VRS + 64 * KS * 2);
  LAS float* OS = segt + 512;
  static_assert(3 * SZ_T + 64 * VRS + 64 * KS * 2 + 2048 + 64 * 132 * 4 <= LDS_RING, "hg3 lds");
  const int ch = tid & 127, seg = tid >> 7, l15 = lane & 15, l4 = lane >> 4;
  constexpr int NIT = NB * HGH * NCH;
  int it = C.bid; if (it >= NIT) return;
  bf16_t zr[16], qr[16]; bf16x8 sfn[4], vr[2], gr[2];
#define HG3_PRE(it_, dir_) do { const int c_ = (it_) % NCH, h_ = ((it_) / NCH) % HGH, b_ = (it_) / (NCH * HGH); const size_t R0_ = (size_t)b_ * TPB + 64 * c_; \
    const bf16_t* zp_ = Pm + R0_ * LDP + ((dir_) ? C_ZB : C_ZF) + h_ * 128 + ch; const bf16_t* qp_ = Pm + R0_ * LDP + C_QB + h_ * 128 + ch; \
    _Pragma("unroll") for (int i = 0; i < 16; ++i) { const int u = 16 * seg + i, tok = (dir_) ? 63 - u : u; zr[i] = zp_[(size_t)tok * LDP]; qr[i] = qp_[(size_t)tok * LDP]; } \
    const bf16_t* Sb_ = HGS + (((size_t)((b_ * HGH + h_) * 2 + (dir_)) * NCH + c_) * 128 + C.wave * 16 + l15) * 128 + 8 * l4; \
    _Pragma("unroll") for (int ks = 0; ks < 4; ++ks) sfn[ks] = *(const bf16x8*)(Sb_ + 32 * ks); } while (0)
#define HG3_PREV(it_) do { const int c_ = (it_) % NCH, h_ = ((it_) / NCH) % HGH, b_ = (it_) / (NCH * HGH); const size_t R0_ = (size_t)b_ * TPB + 64 * c_; \
    _Pragma("unroll") for (int i = 0; i < 2; ++i) { const int idx = tid + 512 * i; vr[i] = *(const bf16x8*)(Pm + (R0_ + (idx >> 4)) * LDP + C_IB + h_ * 128 + 8 * (idx & 15)); } } while (0)
  HG3_PRE(it, 0); HG3_PREV(it);
  for (;;) {
    const int c = it % NCH, h = (it / NCH) % HGH, b = it / (NCH * HGH);
    const size_t R0 = (size_t)b * TPB + 64 * c;
    f32x4 acc[4];
#pragma unroll
    for (int mt = 0; mt < 4; ++mt) acc[mt] = (f32x4){0.f, 0.f, 0.f, 0.f};
#pragma unroll
    for (int dir = 0; dir < 2; ++dir) {
      const float lb = lbt[dir * NAW + h * 128 + ch];
      float fk[16], pl[16], qv[16]; float run = 0.f;
#pragma unroll
      for (int i = 0; i < 16; ++i) { const float z = bf1(zr[i]); qv[i] = bf1(qr[i]);
        const float e = __expf(-z), sg = rcp_fast(1.0f + e), f = lb + (1.0f - lb) * sg; fk[i] = (1.0f - lb) * e * sg; run += __log2f(f); pl[i] = run; }
      bf16x8 sf[4];
#pragma unroll
      for (int ks = 0; ks < 4; ++ks) sf[ks] = sfn[ks];
      segt[ch * 4 + seg] = run;
      if (dir == 0) {
#pragma unroll
        for (int i = 0; i < 2; ++i) { const int idx = tid + 512 * i; *(LAS bf16x8*)(VR + (idx >> 4) * VRS + 16 * (idx & 15)) = vr[i]; } }
      __syncthreads();
      if (dir == 0) { HG3_PRE(it, 1);
        const bf16_t* gp = Pm + (R0 + (tid >> 3)) * LDP + C_GB + h * 128 + (tid & 7) * 16; gr[0] = *(const bf16x8*)gp; gr[1] = *(const bf16x8*)(gp + 8); }
      else if (it + C.G < NIT) { HG3_PRE(it + C.G, 0); HG3_PREV(it + C.G); }
      const f32x4 st = *(const LAS f32x4*)(segt + ch * 4);
      const float off = (seg > 0 ? st.x : 0.f) + (seg > 1 ? st.y : 0.f) + (seg > 2 ? st.z : 0.f), mid = st.x + st.y;
#pragma unroll
      for (int i = 0; i < 16; ++i) { const int u = 16 * seg + i, tok = dir ? 63 - u : u; const float cu = off + pl[i];
        QI[tok * CS + ch] = f2bf1(qv[i] * exp2_fast(cu)); QA[tok * CS + ch] = f2bf1(qv[i] * exp2_fast(cu - mid)); KA[tok * CS + ch] = f2bf1(fk[i] * exp2_fast(mid - cu)); }
      __syncthreads();
      { const int mt = C.wave >> 1;
#pragma unroll
        for (int q2 = 0; q2 < 2; ++q2) { const int nt = 2 * (C.wave & 1) + q2; f32x4 a4 = (f32x4){0.f, 0.f, 0.f, 0.f};
#pragma unroll
          for (int ks = 0; ks < 4; ++ks) { const bf16x8 a = *(const LAS bf16x8*)(QA + (16 * mt + l15) * CS + 32 * ks + 8 * l4), bb = *(const LAS bf16x8*)(KA + (16 * nt + l15) * CS + 32 * ks + 8 * l4); a4 = mfma16(a, bb, a4); }
#pragma unroll
          for (int r = 0; r < 4; ++r) { const int t = 16 * mt + 4 * l4 + r, s2 = 16 * nt + l15; const bool keep = dir ? (s2 >= t) : (s2 <= t); AT[t * KS + s2] = keep ? f2bf1(a4[r]) : (bf16_t)0; } } }
      __syncthreads();
      { bf16x8 vb[2];
#pragma unroll
        for (int ks = 0; ks < 2; ++ks) vb[ks] = frag_T<VRS>(VR + (32 * ks) * VRS + 32 * C.wave, lane);
#pragma unroll
        for (int mt = 0; mt < 4; ++mt) {
#pragma unroll
          for (int ks = 0; ks < 2; ++ks) { const bf16x8 a = *(const LAS bf16x8*)(AT + (16 * mt + l15) * KS + 32 * ks + 8 * l4); acc[mt] = mfma16(a, vb[ks], acc[mt]); }
#pragma unroll
          for (int ks = 0; ks < 4; ++ks) { const bf16x8 a = *(const LAS bf16x8*)(QI + (16 * mt + l15) * CS + 32 * ks + 8 * l4); acc[mt] = mfma16(a, sf[ks], acc[mt]); } } }
      __syncthreads();
    }
#pragma unroll
    for (int mt = 0; mt < 4; ++mt)
#pragma unroll
      for (int r = 0; r < 4; ++r) OS[(16 * mt + 4 * l4 + r) * 132 + C.wave * 16 + l15] = acc[mt][r];
    __syncthreads();
    { const int t = tid >> 3, part = tid & 7; const LAS float* op = OS + t * 132 + part * 16; float v[16]; float ss = 0.f;
#pragma unroll
      for (int e = 0; e < 16; ++e) { v[e] = op[e]; ss += v[e] * v[e]; }
      ss += __shfl_xor(ss, 1); ss += __shfl_xor(ss, 2); ss += __shfl_xor(ss, 4);
      const float rinv = rsq_fast(ss * (1.0f / 128.0f) + EPS);
      const float* gn = P.in[I_GNG] + part * 16;
      unsigned w[8];
#pragma unroll
      for (int e = 0; e < 8; e += 2) { w[e >> 1] = cvtpk(v[e] * rinv * gn[e] * bf1((bf16_t)gr[0][e]), v[e + 1] * rinv * gn[e + 1] * bf1((bf16_t)gr[0][e + 1]));
        w[4 + (e >> 1)] = cvtpk(v[8 + e] * rinv * gn[8 + e] * bf1((bf16_t)gr[1][e]), v[9 + e] * rinv * gn[9 + e] * bf1((bf16_t)gr[1][e + 1])); }
      bf16_t* dst = AO + (R0 + t) * DM + NAW + h * 128 + part * 16;
      *(u32x4*)dst = (u32x4){w[0], w[1], w[2], w[3]}; *(u32x4*)(dst + 8) = (u32x4){w[4], w[5], w[6], w[7]}; }
    __syncthreads();
    it += C.G; if (it >= NIT) break;
  }
#undef HG3_PRE
#undef HG3_PREV
}
}

namespace att2 {
using att::crow; using att::partialSM; using att::finishSM; using att::finishSM_noexp; using att::v_rd_base; using att::SCALE;
constexpr int SHM_K = 16384, SHM_V = 32768, OFF_V = SHM_K, OFF_Q = SHM_K + 2 * SHM_V, OFF_WS = OFF_Q + 65536, SHM_TOTAL = OFF_WS + 8 * 64 * 4;
static_assert(SHM_TOTAL <= LDS_CTLW, "att2 lds");
DEVI int v_st(int k, int c) { const int kk = (k & ~0xC) | ((k & 4) << 1) | ((k & 8) >> 1); return ((kk >> 3) * 8 + (c >> 5)) * 512 + ((kk & 7) * 32 + (c & 31)) * 2; }
constexpr int v_rd_off(int d0, int ks, int half) { return d0 * 512 + ks * 8192 + half * 4096; }
template <int D0> DEVI void pv_one(f32x16& od, const LAS unsigned char* vb, bf16x8 pa0, bf16x8 pa1, bf16x8 pa2, bf16x8 pa3) {
  const s16x4 l0 = tr_read_p(vb + v_rd_off(D0, 0, 0)), h0 = tr_read_p(vb + v_rd_off(D0, 0, 1)), l1 = tr_read_p(vb + v_rd_off(D0, 1, 0)), h1 = tr_read_p(vb + v_rd_off(D0, 1, 1));
  const s16x4 l2 = tr_read_p(vb + v_rd_off(D0, 2, 0)), h2 = tr_read_p(vb + v_rd_off(D0, 2, 1)), l3 = tr_read_p(vb + v_rd_off(D0, 3, 0)), h3 = tr_read_p(vb + v_rd_off(D0, 3, 1));
#define PK(L, H) (bf16x8){L[0], L[1], L[2], L[3], H[0], H[1], H[2], H[3]}
  od = mfma32(pa0, PK(l0, h0), od);
  od = mfma32(pa1, PK(l1, h1), od);
  od = mfma32(pa2, PK(l2, h2), od);
  od = mfma32(pa3, PK(l3, h3), od);
#undef PK
}
template <bool FIXEDREF>
DEVI void attn256_pass(const bf16_t* __restrict__ Qb, const bf16_t* __restrict__ Kh, const bf16_t* __restrict__ Vh, int NT, LAS unsigned char* lds, int wid, f32x16 (&o)[8], float mref) {
  constexpr int ld = 4 * DM;
  int lane = LANE_ID(); OPAQUE(lane);
  const int tid = wid * 64 + lane, r32 = lane & 31, hi = lane >> 5;
  LAS unsigned char* K_lds = lds; LAS unsigned char* V_lds = lds + OFF_V; LAS unsigned char* Q_lds = lds + OFF_Q + wid * 8192;
  LAS float* wsf = (LAS float*)(lds + OFF_WS) + wid * 64; LAS float* li_l = wsf; LAS float* al_l = wsf + 32;
  {
#pragma unroll
    for (int i = 0; i < 8; ++i) { const int row = 4 * i + (lane >> 4), c = lane & 15; const bf16x8 v = *(const bf16x8*)(Qb + (long)(wid * 32 + row) * ld + 8 * c); *(LAS bf16x8*)(Q_lds + KSWZ(row, 16 * c)) = v; }
  }
  float m_reg = -1e30f, l_reg = 0;
#pragma unroll
  for (int d = 0; d < 8; ++d) o[d] = f32x16{};
  const int sr = tid >> 4, sc = (tid & 15) * 8;
  const LAS unsigned char* vb0 = V_lds + v_rd_base(lane);
  bf16x8 ks0, ks1, vs0, vs1, vs2, vs3;
#define A2_SLOAD(t) do { const long r0_ = 64L * (t); ks0 = *(const bf16x8*)(Kh + (r0_ + sr) * ld + sc); ks1 = *(const bf16x8*)(Kh + (r0_ + 32 + sr) * ld + sc); \
    vs0 = *(const bf16x8*)(Vh + (r0_ + (tid >> 5)) * ld + 8 * (tid & 31)); vs1 = *(const bf16x8*)(Vh + (r0_ + 16 + (tid >> 5)) * ld + 8 * (tid & 31)); \
    vs2 = *(const bf16x8*)(Vh + (r0_ + 32 + (tid >> 5)) * ld + 8 * (tid & 31)); vs3 = *(const bf16x8*)(Vh + (r0_ + 48 + (tid >> 5)) * ld + 8 * (tid & 31)); } while (0)
#define A2_SWRITE(b) do { const int kc_ = sc * 2; *(LAS bf16x8*)(K_lds + KSWZ(sr, kc_)) = ks0; *(LAS bf16x8*)(K_lds + KSWZ(32 + sr, kc_)) = ks1; \
    LAS unsigned char* vd_ = V_lds + (b) * SHM_V; const int vr_ = tid >> 5, vc_ = 8 * (tid & 31); \
    *(LAS bf16x8*)(vd_ + v_st(vr_, vc_)) = vs0; *(LAS bf16x8*)(vd_ + v_st(16 + vr_, vc_)) = vs1; *(LAS bf16x8*)(vd_ + v_st(32 + vr_, vc_)) = vs2; *(LAS bf16x8*)(vd_ + v_st(48 + vr_, vc_)) = vs3; } while (0)
  A2_SLOAD(0); A2_SWRITE(0); if (1 < NT) A2_SLOAD(1);
  for (int t = 0; t < NT; ++t) {
    __syncthreads();
    f32x16 p0 = f32x16{}, p1 = f32x16{};
#pragma unroll
    for (int d0 = 0; d0 < 8; ++d0) { const int cb = (d0 * 16 + hi * 8) * 2;
      const bf16x8 b0 = *(const LAS bf16x8*)(K_lds + KSWZ(r32, cb)), b1 = *(const LAS bf16x8*)(K_lds + KSWZ(32 + r32, cb)), q = *(const LAS bf16x8*)(Q_lds + KSWZ(r32, cb));
      p0 = mfma32(b0, q, p0); p1 = mfma32(b1, q, p1); }
    float mn, al; bf16x8 pa0, pa1, pa2, pa3;
    if constexpr (FIXEDREF) {
      constexpr float Cc = SCALE * 1.4426950408889634f; const float mC = -mref * 1.4426950408889634f;
#pragma unroll
      for (int r = 0; r < 16; ++r) { p0[r] = exp2_fast(fmaf(p0[r], Cc, mC)); p1[r] = exp2_fast(fmaf(p1[r], Cc, mC)); }
      finishSM_noexp(p0, p1, l_reg, pa0, pa1, pa2, pa3);
    } else {
    partialSM(p0, p1, m_reg, mn, al);
    if (__any(al < 1.f)) { if (hi == 0) al_l[r32] = al; WAIT_L(0); WSYNC();
#pragma unroll
      for (int d = 0; d < 8; ++d)
#pragma unroll
        for (int r = 0; r < 16; ++r) o[d][r] *= al_l[crow(r, hi)]; }
    finishSM(p0, p1, al, l_reg, pa0, pa1, pa2, pa3);
    }
    __syncthreads();
    if (t + 1 < NT) { A2_SWRITE((t + 1) & 1); if (t + 2 < NT) A2_SLOAD(t + 2); }
    const LAS unsigned char* vb = vb0 + (t & 1) * SHM_V;
    pv_one<0>(o[0], vb, pa0, pa1, pa2, pa3); pv_one<1>(o[1], vb, pa0, pa1, pa2, pa3); pv_one<2>(o[2], vb, pa0, pa1, pa2, pa3); pv_one<3>(o[3], vb, pa0, pa1, pa2, pa3);
    pv_one<4>(o[4], vb, pa0, pa1, pa2, pa3); pv_one<5>(o[5], vb, pa0, pa1, pa2, pa3); pv_one<6>(o[6], vb, pa0, pa1, pa2, pa3); pv_one<7>(o[7], vb, pa0, pa1, pa2, pa3);
  }
  if (hi == 0) li_l[r32] = l_reg; WAIT_L(0); WSYNC();
#pragma unroll
  for (int r = 0; r < 16; ++r) { const float rl = rcp_fast(li_l[crow(r, hi)]);
#pragma unroll
    for (int d = 0; d < 8; ++d) o[d][r] *= rl; }
  __syncthreads();
#undef A2_SLOAD
#undef A2_SWRITE
}
DEVI void attn256_pass_fixed(const bf16_t* __restrict__ Qb, const bf16_t* __restrict__ Kh, const bf16_t* __restrict__ Vh, int NT, LAS unsigned char* lds, int wid, f32x16 (&o)[8], float mref) {
  constexpr int ld = 4 * DM, FK = 0, FV = 3 * SHM_K;
  static_assert(FV + 3 * SHM_V <= LDS_BYTES, "att2 fixed lds");
  int lane = LANE_ID(); OPAQUE(lane);
  const int tid = wid * 64 + lane, r32 = lane & 31, hi = lane >> 5;
  LAS unsigned char* K_lds = lds + FK; LAS unsigned char* V_lds = lds + FV;
  bf16x8 qr[8];
  { const bf16_t* Qw = Qb + (long)(wid * 32 + r32) * ld + hi * 8;
#pragma unroll
    for (int d0 = 0; d0 < 8; ++d0) qr[d0] = *(const bf16x8*)(Qw + d0 * 16); }
  float l_reg = 0;
#pragma unroll
  for (int d = 0; d < 8; ++d) o[d] = f32x16{};
  const LAS unsigned char* vb0 = V_lds + v_rd_base(lane);
  int koff[2], voff[4];
#pragma unroll
  for (int i = 0; i < 2; ++i) { const int s_ = (i * 8 + wid) * 64 + lane, row = s_ >> 4, c = (s_ & 15) ^ (row & 15); koff[i] = row * ld + c * 8; }
#pragma unroll
  for (int i = 0; i < 4; ++i) { const int s_ = (i * 8 + wid) * 64 + lane, kk = 8 * (s_ >> 8) + ((s_ & 31) >> 2), k = (kk & ~0xC) | ((kk & 4) << 1) | ((kk & 8) >> 1), c = 32 * ((s_ >> 5) & 7) + 8 * (s_ & 3); voff[i] = k * ld + c; }
#define A2_DMA(b, t) do { const bf16_t* kt_ = Kh + 64L * (t) * ld; const bf16_t* vt_ = Vh + 64L * (t) * ld; \
    _Pragma("unroll") for (int i = 0; i < 2; ++i) GLDS16(kt_ + koff[i], K_lds + (b) * SHM_K + (i * 8 + wid) * 1024); \
    _Pragma("unroll") for (int i = 0; i < 4; ++i) GLDS16(vt_ + voff[i], V_lds + (b) * SHM_V + (i * 8 + wid) * 1024); } while (0)
  constexpr float Cc = SCALE * 1.4426950408889634f; const float mC = -mref * 1.4426950408889634f;
  A2_DMA(0, 0); if (1 < NT) A2_DMA(1, 1);
  int bt = 0;
  for (int t = 0; t < NT; ++t) {
    if (t + 1 < NT) WAIT_V(6); else WAIT_V(0);
    CFENCE(); WAIT_L(0); BAR(); CFENCE();
    const int bn2 = bt == 0 ? 2 : bt - 1;
    if (t + 2 < NT) A2_DMA(bn2, t + 2);
    const LAS unsigned char* Kb = K_lds + bt * SHM_K;
    f32x16 p0 = f32x16{}, p1 = f32x16{};
#pragma unroll
    for (int d0 = 0; d0 < 8; ++d0) { const int cb = (d0 * 16 + hi * 8) * 2;
      const bf16x8 b0 = *(const LAS bf16x8*)(Kb + KSWZ(r32, cb)), b1 = *(const LAS bf16x8*)(Kb + KSWZ(32 + r32, cb));
      p0 = mfma32(b0, qr[d0], p0); p1 = mfma32(b1, qr[d0], p1); }
#pragma unroll
    for (int r = 0; r < 16; ++r) { p0[r] = exp2_fast(fmaf(p0[r], Cc, mC)); p1[r] = exp2_fast(fmaf(p1[r], Cc, mC)); }
    bf16x8 pa0, pa1, pa2, pa3;
    finishSM_noexp(p0, p1, l_reg, pa0, pa1, pa2, pa3);
    const LAS unsigned char* vb = vb0 + bt * SHM_V;
    pv_one<0>(o[0], vb, pa0, pa1, pa2, pa3); pv_one<1>(o[1], vb, pa0, pa1, pa2, pa3); pv_one<2>(o[2], vb, pa0, pa1, pa2, pa3); pv_one<3>(o[3], vb, pa0, pa1, pa2, pa3);
    pv_one<4>(o[4], vb, pa0, pa1, pa2, pa3); pv_one<5>(o[5], vb, pa0, pa1, pa2, pa3); pv_one<6>(o[6], vb, pa0, pa1, pa2, pa3); pv_one<7>(o[7], vb, pa0, pa1, pa2, pa3);
    bt = bt == 2 ? 0 : bt + 1;
  }
  __syncthreads();
  LAS float* li_l = (LAS float*)(lds + FK) + wid * 32;
  if (hi == 0) li_l[r32] = l_reg; WAIT_L(0); WSYNC();
#pragma unroll
  for (int r = 0; r < 16; ++r) { const float rl = rcp_fast(li_l[crow(r, hi)]);
#pragma unroll
    for (int d = 0; d < 8; ++d) o[d][r] *= rl; }
  __syncthreads();
#undef A2_DMA
}
}

DEVI void phase_diffattn(const Params& P, const Ctx& C) {
  unsigned char* ws = P.ws;
  const bf16_t* Pm = (const bf16_t*)(ws + WS_P); bf16_t* AO = (bf16_t*)(ws + WS_AO);
  constexpr int LDP = 4 * DM, NQB = SEQ / 256, NIT = NB * DIFFH * NQB;
  const float lam = ((const float*)(ws + WS_MISC))[0];
  const float mref = ((const float*)(ws + WS_MISC))[1]; const bool fixedref = mref < 40.f;
  for (int it = C.vcu; it < NIT; it += C.G) {
    const int qb = it % NQB, h = (it / NQB) % DIFFH, b = it / (NQB * DIFFH);
    const size_t R0 = (size_t)b * TPB + CTX + 256 * qb, RB = (size_t)b * TPB;
    const bf16_t* Vp = Pm + RB * LDP + 2 * DM + h * 256;
    f32x16 o[8];
    if (fixedref) att2::attn256_pass_fixed(Pm + R0 * LDP + (h * 2 + 1) * 128, Pm + RB * LDP + DM + (h * 2 + 1) * 128, Vp, TPB / 64, C.lds, C.wave, o, mref);
    else att2::attn256_pass<false>(Pm + R0 * LDP + (h * 2 + 1) * 128, Pm + RB * LDP + DM + (h * 2 + 1) * 128, Vp, TPB / 64, C.lds, C.wave, o, mref);
    int ln = LANE_ID(); OPAQUE(ln);
    const unsigned char* stb = ws + WS_STASH + (size_t)C.bid * (32 * NTHR * 16); unsigned sto = (unsigned)(C.wave * 64 + ln) * 16u;
#pragma unroll
    for (int d = 0; d < 8; ++d)
#pragma unroll
      for (int q4 = 0; q4 < 4; ++q4) { const f32x4 pv_ = (f32x4){o[d][4 * q4], o[d][4 * q4 + 1], o[d][4 * q4 + 2], o[d][4 * q4 + 3]} * lam; ST_WT16((unsigned char*)stb + (size_t)(d * 4 + q4) * (NTHR * 16) + sto, pv_); }
    if (fixedref) att2::attn256_pass_fixed(Pm + R0 * LDP + (h * 2) * 128, Pm + RB * LDP + DM + (h * 2) * 128, Vp, TPB / 64, C.lds, C.wave, o, mref);
    else att2::attn256_pass<false>(Pm + R0 * LDP + (h * 2) * 128, Pm + RB * LDP + DM + (h * 2) * 128, Vp, TPB / 64, C.lds, C.wave, o, mref);
    OPAQUE(ln); sto = (unsigned)(C.wave * 64 + ln) * 16u;
    const int r32 = ln & 31, hi = ln >> 5;
#pragma unroll
    for (int d = 0; d < 8; ++d)
#pragma unroll
      for (int q4 = 0; q4 < 4; ++q4) { const f32x4 t = *(const f32x4*)(stb + (size_t)(d * 4 + q4) * (NTHR * 16) + sto); o[d][4 * q4] -= t.x; o[d][4 * q4 + 1] -= t.y; o[d][4 * q4 + 2] -= t.z; o[d][4 * q4 + 3] -= t.w; }
    const float* sg = P.in[I_SUBG];
    constexpr int OTP = 528;
    LAS unsigned char* ot = C.lds + C.wave * (32 * OTP);
#pragma unroll
    for (int r = 0; r < 16; ++r) {
      float v = 0.f;
#pragma unroll
      for (int d = 0; d < 8; ++d) v += o[d][r] * o[d][r];
      v += SHFL_XOR_LN(v, 1, ln); v += SHFL_XOR_LN(v, 2, ln); v += SHFL_XOR_LN(v, 4, ln); v += SHFL_XOR_LN(v, 8, ln); v += SHFL_XOR_LN(v, 16, ln);
      const float rinv = (1.0f - LAM_INIT) * rsq_fast(v * (1.0f / 256.0f) + EPS); const int orow = att::crow(r, hi);
#pragma unroll
      for (int d = 0; d < 8; ++d) { const int col = 32 * d + r32; *(LAS bf16_t*)(ot + orow * OTP + col * 2) = f2bf1(o[d][r] * rinv * sg[col]); } }
    WAIT_L(0); CFENCE(); WSYNC();
    { bf16_t* Ob = AO + (R0 + C.wave * 32) * DM + h * 256;
#pragma unroll
      for (int i = 0; i < 16; ++i) { const int q = ln + 64 * i, row = q >> 5, ch = q & 31; const u32x4 w = *(const LAS u32x4*)(ot + row * OTP + ch * 16); ST_WT16U(Ob + (size_t)row * DM + ch * 8, w); } }
    __syncthreads();
  }
}

__global__ void __launch_bounds__(NTHR, 1) fwd_kernel(Params P) {
  SMEM_DECL;
  cg::grid_group grid = cg::this_grid();
  Ctx C; C.lds = (LAS unsigned char*)smem_raw; C.wave = RFL((int)threadIdx.x >> 6); C.G = gridDim.x; C.bid = blockIdx.x; C.vcu = (C.G % 8 == 0) ? (C.bid % 8) * (C.G / 8) + C.bid / 8 : C.bid;
  XcdBarrier xb = xcd_barrier_post((unsigned*)(P.ws + WS_CTL), C.wave);
  if (P.ph_lo < 0) grid.sync();
  int ph = 0;
#ifndef PROBE_REP
#define PROBE_REP 1
#endif
#ifndef PROBE_DUP
#define PROBE_DUP -1
#endif
  float* xdst = (float*)(P.ws + WS_XRES);
#define PHASE(...) do { if (ph >= P.ph_lo && ph < P.ph_hi) { \
    if (ph == PROBE_DUP) { xdst = (float*)(P.ws + WS_STASH); __VA_ARGS__; xcd_barrier(xb); if (PROBE_REP >= 2) { __VA_ARGS__; xcd_barrier(xb); } if (PROBE_REP >= 3) { __VA_ARGS__; xcd_barrier(xb); } xdst = (float*)(P.ws + WS_XRES); } \
    __VA_ARGS__; if (ph + 1 < P.ph_hi) xcd_barrier(xb); } ++ph; } while (0)
  PHASE(phase_prep(P, C));
  PHASE((phase_norm<true, false>(P, C, 0, 0, P.in[I_NMIXG])));
  unsigned char* ws = P.ws;
  const float* misc = (const float*)(ws + WS_MISC);
  const float* rcos = (const float*)(ws + WS_ROPE); const float* rsin = rcos + (size_t)SEQ * 64;
  LAS float* xch = (LAS float*)(C.lds + LDS_X);
  float* slab = (float*)(ws + WS_STASH); unsigned* cntb = (unsigned*)(ws + WS_CNT); unsigned* cnt0 = cntb + 2048 * 1; unsigned* cnt1 = cntb + 2048 * 3;
  PHASE({ pg8::Gemm g{(const bf16_t*)(ws + WS_XN), (const bf16_t*)(ws + WS_WT_EVIN), DM}; pg8::Order S; S.init(MTOK / 256, EVEN_IN / 256, C.G, C.bid, false, DM / 64);
          pg8::EpiProj<0> E{(bf16_t*)(ws + WS_P), 4 * DM, misc + 64, misc + 64 + 128, rcos, rsin, xch, slab, cntb + 0}; pg8::gemm_phase(C.lds, C.wave, g, S, E); pg8::combine_proj(S, E, C.wave); });
  PHASE({ hg::phase_hg2(P, C); phase_attn0(P, C); });
  PHASE(hg::phase_hg3(P, C));
  const float* mods0 = (const float*)(ws + WS_MODS); const float* mods1 = mods0 + (size_t)(NB + 1) * 6 * DM;
  float* xres = (float*)(ws + WS_XRES);
  PHASE({ pg8::Gemm g{(const bf16_t*)(ws + WS_AO), (const bf16_t*)(ws + WS_WT_EVOUT), DM}; pg8::Order S; S.init(NB * (TILES_PB - 1), DM / 256, C.G, C.bid, true, DM / 64, pg8::KSPLIT, 0, DM / 256);
          pg8::EpiResid E{xres, xdst, mods0 + 2 * DM, nullptr, slab, cnt0, P.in[I_X], P.in[I_CTX]}; pg8::gemm_phase(C.lds, C.wave, g, S, E); pg8::combine_slices(S, E, C.wave); });
  PHASE((phase_norm<false, false>(P, C, 0, 3, P.in[I_NMLPG])));
  PHASE({ pg8::Gemm g{(const bf16_t*)(ws + WS_XN), (const bf16_t*)(ws + WS_WT_W1), DM}; pg8::Order S; S.init(MTOK / 256, DFF / 256, C.G, C.bid, false, DM / 64);
          pg8::EpiProj<2> E{(bf16_t*)(ws + WS_P), 4 * DM, nullptr, nullptr, nullptr, nullptr, xch, slab, cntb + 2048 * 2}; pg8::gemm_phase(C.lds, C.wave, g, S, E); pg8::combine_proj(S, E, C.wave); });
  PHASE({ pg8::Gemm g{(const bf16_t*)(ws + WS_P), (const bf16_t*)(ws + WS_WT_W2), DFF}; pg8::Order S; S.init(NB * (TILES_PB - 1), DM / 256, C.G, C.bid, true, DFF / 64, pg8::KSPLIT, 0, DM / 256);
          pg8::EpiResid E{xres, xdst, mods0 + 5 * DM, nullptr, slab, cnt1, nullptr, nullptr}; pg8::gemm_phase(C.lds, C.wave, g, S, E); pg8::combine_slices(S, E, C.wave); });
  PHASE((phase_norm<false, false>(P, C, 1, 0, P.in[I_NMIXG] + DM)));
  PHASE({ pg8::Gemm g{(const bf16_t*)(ws + WS_XN), (const bf16_t*)(ws + WS_WT_ODIN), DM}; pg8::Order S; S.init(MTOK / 256, ODD_IN / 256, C.G, C.bid, false, DM / 64);
          pg8::EpiProj<1> E{(bf16_t*)(ws + WS_P), 4 * DM, misc + 64 + 256, misc + 64 + 384, rcos, rsin, xch, slab, cntb + 2048 * 4}; pg8::gemm_phase(C.lds, C.wave, g, S, E); pg8::combine_proj(S, E, C.wave); });
  PHASE(phase_diffattn(P, C));
  PHASE({ pg8::Gemm g{(const bf16_t*)(ws + WS_AO), (const bf16_t*)(ws + WS_WT_ODOUT), DM}; pg8::Order S; S.init(NB * (TILES_PB - 1), DM / 256, C.G, C.bid, true, DM / 64);
          pg8::EpiResid E{xres, xdst, mods1 + 2 * DM, nullptr, nullptr, nullptr, nullptr, nullptr}; pg8::gemm_phase(C.lds, C.wave, g, S, E); });
  PHASE((phase_norm<false, true>(P, C, 1, 3, P.in[I_NMLPG] + DM)));
  PHASE({ pg8::Gemm g{(const bf16_t*)(ws + WS_XN), (const bf16_t*)(ws + WS_WT_W1) + (size_t)DFF * DM, DM}; pg8::Order S; S.init(NB * (TILES_PB - 1), DFF / 256, C.G, C.bid, true, DM / 64);
          pg8::EpiProj<2> E{(bf16_t*)(ws + WS_P), 4 * DM, nullptr, nullptr, nullptr, nullptr, xch, nullptr, nullptr}; pg8::gemm_phase(C.lds, C.wave, g, S, E); });
  PHASE({ pg8::Gemm g{(const bf16_t*)(ws + WS_P), (const bf16_t*)(ws + WS_WT_W2) + (size_t)DM * DFF, DFF}; pg8::Order S; S.init(NB * (TILES_PB - 1), DM / 256, C.G, C.bid, true, DFF / 64);
          pg8::EpiResid E{xres, xdst, mods1 + 5 * DM, P.out, nullptr, nullptr, nullptr, nullptr}; pg8::gemm_phase(C.lds, C.wave, g, S, E); });
#undef PHASE
}

constexpr int N_PHASES = 16;
extern "C" void kernel_launch(void* const* d_in, const int* in_sizes, int n_in, void* d_out, int out_size, void* d_ws, size_t ws_size, hipStream_t stream) {
  static int grid_blocks = 0;
  if (grid_blocks == 0) {
    if (n_in != 23 || ws_size < WS_END) { fprintf(stderr, "kernel_launch: unexpected n_in %d or ws %zu < %zu\n", n_in, ws_size, (size_t)WS_END); grid_blocks = -1; return; }
    int dev = 0, cus = 0, per_cu = 0;
    (void)hipGetDevice(&dev); (void)hipDeviceGetAttribute(&cus, hipDeviceAttributeMultiprocessorCount, dev);
    (void)hipFuncSetAttribute((const void*)fwd_kernel, hipFuncAttributeMaxDynamicSharedMemorySize, LDS_BYTES);
    (void)hipOccupancyMaxActiveBlocksPerMultiprocessor(&per_cu, (const void*)fwd_kernel, NTHR, (size_t)LDS_BYTES);
    if (per_cu < 1) { fprintf(stderr, "kernel_launch: occupancy query says %d blocks per CU\n", per_cu); per_cu = 1; }
    grid_blocks = cus;
  }
  if (grid_blocks < 0) return;
  (void)hipMemsetAsync((char*)d_ws + WS_CTL, 0, WS_MODS, stream);
  Params p{};
  for (int i = 0; i < 23; ++i) p.in[i] = (const float*)d_in[i];
  p.out = (float*)d_out; p.ws = (unsigned char*)d_ws; p.ph_lo = 0; p.ph_hi = N_PHASES;
#ifdef EMU
  if (getenv("EMU_PH_HI")) p.ph_hi = atoi(getenv("EMU_PH_HI"));
#endif
#ifndef EMU
  void* args[] = {&p};
  hipError_t e = hipLaunchCooperativeKernel((void*)fwd_kernel, dim3(grid_blocks), dim3(NTHR), args, LDS_BYTES, stream);
  if (e != hipSuccess) fprintf(stderr, "cooperative launch failed: %s (grid %d)\n", hipGetErrorString(e), grid_blocks);
#else
  emu::launch([p]() { fwd_kernel(p); }, dim3(grid_blocks), dim3(NTHR), LDS_BYTES);
#endif
}
```
